# Optimizing an MI355X kernel written in HIP

```python
import jax, jax.numpy as jnp
from jax import lax
import numpy as np

D_MODEL = 1024
BATCH = 2
SEQ = 16384
DEPTH = 2

GLA_HEADS = 4
GLA_KEY_DIM = D_MODEL // 2
GLA_VALUE_DIM = D_MODEL
GLA_HEAD_K = GLA_KEY_DIM // GLA_HEADS
GLA_HEAD_V = GLA_VALUE_DIM // GLA_HEADS
GATE_RANK = 16
GATE_NORMALIZER = 16.0
CHUNK = 64
POOL_GROUPS = 4
POOL_WIDTH = D_MODEL // 2
POOL_GROUP_W = POOL_WIDTH // POOL_GROUPS
POOL_OUT_GROUP_W = D_MODEL // POOL_GROUPS
POOL_WINDOWS = (2, 4, 8, 16)
N_BRANCHES = 2
D_FF = -(-8 * D_MODEL // (3 * 256)) * 256
IN_WIDTH = 2 * GLA_KEY_DIM + 2 * GLA_VALUE_DIM + 2 * GATE_RANK + POOL_WIDTH + N_BRANCHES * D_MODEL
EPS = 1e-6

kernel_name = "bidir_gla_pool_hybrid_block"


def rmsnorm(x, g):
    xf = x.astype(jnp.float32)
    y = xf * lax.rsqrt(jnp.mean(xf * xf, axis=-1, keepdims=True) + EPS)
    return (y * g.astype(jnp.float32)).astype(x.dtype)


def gla_chunked(q, k, v, log_a, include_diag):
    bsz, heads, length, dk = q.shape
    dv = v.shape[-1]
    n = length // CHUNK
    q = q.reshape(bsz, heads, n, CHUNK, dk).astype(jnp.float32)
    k = k.reshape(bsz, heads, n, CHUNK, dk).astype(jnp.float32)
    v = v.reshape(bsz, heads, n, CHUNK, dv).astype(jnp.float32)
    b = jnp.cumsum(log_a.reshape(bsz, heads, n, CHUNK, dk).astype(jnp.float32), axis=3)
    b_last = b[:, :, :, -1:, :]
    q_e = q * jnp.exp(b)
    k_e = k * jnp.exp(-b)
    k_d = k * jnp.exp(b_last - b)
    mask = jnp.tril(jnp.ones((CHUNK, CHUNK), dtype=bool), 0 if include_diag else -1)
    scores = jnp.einsum('bhncd,bhnsd->bhncs', q_e, k_e)
    scores = jnp.where(mask, scores, 0.0)
    o_intra = jnp.einsum('bhncs,bhnse->bhnce', scores, v)
    kv = jnp.einsum('bhnsd,bhnse->bhnde', k_d, v)
    decay = jnp.exp(b_last[:, :, :, 0, :])

    def step(state, inp):
        kv_n, dec_n = inp
        return dec_n[..., None] * state + kv_n, state

    s0 = jnp.zeros((bsz, heads, dk, dv), jnp.float32)
    _, s_in = lax.scan(step, s0, (jnp.moveaxis(kv, 2, 0), jnp.moveaxis(decay, 2, 0)))
    s_in = jnp.moveaxis(s_in, 0, 2)
    o_inter = jnp.einsum('bhncd,bhnde->bhnce', q_e, s_in)
    return (o_intra + o_inter).reshape(bsz, heads, length, dv)


def to_heads(t, heads):
    bsz, length, width = t.shape
    return t.reshape(bsz, length, heads, width // heads).transpose(0, 2, 1, 3)


def multiscale_pool(u):
    bsz, length, _ = u.shape
    ug = u.reshape(bsz, length, POOL_GROUPS, POOL_GROUP_W).astype(jnp.float32)
    cs = jnp.concatenate([jnp.zeros((bsz, 1, POOL_GROUPS, POOL_GROUP_W), jnp.float32),
                          jnp.cumsum(ug, axis=1)], axis=1)
    pos = jnp.arange(length)[:, None]
    win = jnp.array(POOL_WINDOWS, dtype=jnp.int32)[None, :]
    lo = jnp.clip(pos - win // 2, 0, length)
    hi = jnp.clip(pos + win - win // 2, 0, length)
    gi = jnp.arange(POOL_GROUPS)[None, :]
    window_sum = cs[:, hi, gi] - cs[:, lo, gi]
    count = (hi - lo).astype(jnp.float32)[None, :, :, None]
    return window_sum / count - ug


def setup_inputs(seed: int = 0) -> dict:
    key = jax.random.key(seed)
    ks = jax.random.split(key, 16)

    def nrm(k, shape, scale):
        return jax.random.normal(k, shape, jnp.float32) * scale

    return {
        'x': nrm(ks[0], (BATCH, SEQ, D_MODEL), 1.0),
        'norm_mix': 1.0 + nrm(ks[1], (DEPTH, D_MODEL), 0.05),
        'w_in': nrm(ks[2], (DEPTH, D_MODEL, IN_WIDTH), D_MODEL ** -0.5),
        'w_decay_up_fwd': nrm(ks[3], (DEPTH, GATE_RANK, GLA_KEY_DIM), GATE_RANK ** -0.5),
        'b_decay_fwd': nrm(ks[4], (DEPTH, GLA_KEY_DIM), 0.1),
        'w_decay_up_bwd': nrm(ks[5], (DEPTH, GATE_RANK, GLA_KEY_DIM), GATE_RANK ** -0.5),
        'b_decay_bwd': nrm(ks[6], (DEPTH, GLA_KEY_DIM), 0.1),
        'gla_norm': 1.0 + nrm(ks[7], (DEPTH, GLA_VALUE_DIM), 0.05),
        'w_branch_gla': nrm(ks[8], (DEPTH, GLA_VALUE_DIM, D_MODEL), GLA_VALUE_DIM ** -0.5),
        'w_pool_group': nrm(ks[9], (DEPTH, POOL_GROUPS, POOL_GROUP_W, POOL_OUT_GROUP_W), POOL_GROUP_W ** -0.5),
        'pool_scale': 1.0 + nrm(ks[10], (DEPTH, D_MODEL), 0.05),
        'w_out': nrm(ks[11], (DEPTH, D_MODEL, D_MODEL), D_MODEL ** -0.5),
        'norm_ffn': 1.0 + nrm(ks[12], (DEPTH, D_MODEL), 0.05),
        'w_ffn_in': nrm(ks[13], (DEPTH, D_MODEL, 2 * D_FF), D_MODEL ** -0.5),
        'w_ffn_out': nrm(ks[14], (DEPTH, D_FF, D_MODEL), D_FF ** -0.5),
        'norm_final': 1.0 + nrm(ks[15], (D_MODEL,), 0.05),
    }


def reference(x, norm_mix, w_in, w_decay_up_fwd, b_decay_fwd, w_decay_up_bwd, b_decay_bwd,
              gla_norm, w_branch_gla, w_pool_group, pool_scale, w_out, norm_ffn,
              w_ffn_in, w_ffn_out, norm_final):
    bsz, length, _ = x.shape
    split_sizes = [GLA_KEY_DIM, GLA_KEY_DIM, GLA_VALUE_DIM, GLA_VALUE_DIM, GATE_RANK, GATE_RANK,
                   POOL_WIDTH, D_MODEL, D_MODEL]
    split_points = [int(p) for p in np.cumsum(split_sizes)[:-1]]
    for l in range(DEPTH):
        h = rmsnorm(x, norm_mix[l])
        proj = h @ w_in[l]
        q, k, v, r, lr_f, lr_b, u, g_a, g_b = jnp.split(proj, split_points, axis=-1)

        log_a_f = jax.nn.log_sigmoid((lr_f @ w_decay_up_fwd[l] + b_decay_fwd[l]).astype(jnp.float32)) / GATE_NORMALIZER
        log_a_b = jax.nn.log_sigmoid((lr_b @ w_decay_up_bwd[l] + b_decay_bwd[l]).astype(jnp.float32)) / GATE_NORMALIZER
        qh = to_heads(q, GLA_HEADS) * (GLA_HEAD_K ** -0.5)
        kh = to_heads(k, GLA_HEADS)
        vh = to_heads(v, GLA_HEADS)
        af = to_heads(log_a_f, GLA_HEADS)
        ab = to_heads(log_a_b, GLA_HEADS)
        o_fwd = gla_chunked(qh, kh, vh, af, include_diag=True)
        o_bwd = jnp.flip(gla_chunked(jnp.flip(qh, 2), jnp.flip(kh, 2), jnp.flip(vh, 2), jnp.flip(ab, 2),
                                     include_diag=False), 2)
        o = o_fwd + o_bwd
        o = o * lax.rsqrt(jnp.mean(o * o, axis=-1, keepdims=True) + EPS)
        o = o.transpose(0, 2, 1, 3).reshape(bsz, length, GLA_VALUE_DIM) * gla_norm[l].astype(jnp.float32)
        o = (o * jax.nn.silu(r.astype(jnp.float32))).astype(x.dtype)
        y_a = o @ w_branch_gla[l]

        pooled = multiscale_pool(u)
        y_b = jnp.einsum('blgc,gcd->blgd', pooled, w_pool_group[l]).reshape(bsz, length, D_MODEL)
        y_b = (y_b * pool_scale[l]).astype(x.dtype)

        merged = jax.nn.sigmoid(g_a) * y_a + jax.nn.sigmoid(g_b) * y_b
        x = x + merged @ w_out[l]

        h2 = rmsnorm(x, norm_ffn[l])
        gate, up = jnp.split(h2 @ w_ffn_in[l], 2, axis=-1)
        x = x + (jax.nn.silu(gate) * up) @ w_ffn_out[l]
    return rmsnorm(x, norm_final)
```

```cpp
#include <hip/hip_runtime.h>
#include <hip/hip_cooperative_groups.h>
namespace cg = cooperative_groups;

#ifndef MK_SINGLE_LAUNCH
#define MK_SINGLE_LAUNCH 1
#endif

#define LAS __attribute__((address_space(3)))
typedef unsigned short bf16_t;
typedef short bf16x8 __attribute__((ext_vector_type(8)));
typedef float f32x4 __attribute__((ext_vector_type(4)));
typedef unsigned u32x4 __attribute__((ext_vector_type(4)));
typedef unsigned u32x2 __attribute__((ext_vector_type(2)));

constexpr int T_TOK = 32768, SEQL = 16384, DM = 1024, PW = 3584, NA = 3840, NB = 2048, DFF = 2816, INW = 5664;
constexpr int LDS_BYTES = 155136;

constexpr size_t SZ_WA = (size_t)NA * 1024 * 2, SZ_WB = (size_t)NB * 1024 * 2, SZ_WGA = (size_t)1024 * 1024 * 2, SZ_WPOOL = (size_t)1024 * 512 * 2,
                 SZ_WOUT = (size_t)1024 * 1024 * 2, SZ_WF1 = (size_t)2 * DFF * 1024 * 2, SZ_WF2 = (size_t)1024 * DFF * 2;
constexpr size_t WO_A = 0, WO_B = WO_A + SZ_WA, WO_GA = WO_B + SZ_WB, WO_POOL = WO_GA + SZ_WGA, WO_OUT = WO_POOL + SZ_WPOOL, WO_F1 = WO_OUT + SZ_WOUT,
                 WO_F2 = WO_F1 + SZ_WF1, SZ_WLAYER = WO_F2 + SZ_WF2;
constexpr size_t OFF_W = 0;
constexpr size_t OFF_XB = OFF_W + 2 * SZ_WLAYER;
constexpr size_t OFF_PROJ = OFF_XB + (size_t)T_TOK * 1024 * 2;
constexpr size_t OFF_LR = OFF_PROJ + (size_t)T_TOK * PW * 2;
constexpr size_t OFF_E = OFF_LR + (size_t)T_TOK * 32 * 4;
constexpr size_t OFF_DLOG = OFF_E + (size_t)16 * 32 * 32768 * 4;
constexpr size_t OFF_O = OFF_DLOG + (size_t)16 * 32 * 128 * 4;
constexpr size_t OFF_SSQ = OFF_O + (size_t)T_TOK * 1024 * 2;
constexpr size_t OFF_BAR = OFF_SSQ + (size_t)T_TOK * 16 * 4;
constexpr size_t WS_NEEDED = OFF_BAR + 128 * 256;

struct Params {
    const float* x_in; const float* norm_mix; const float* w_in; const float* wdu_f; const float* bd_f; const float* wdu_b; const float* bd_b;
    const float* gla_norm; const float* w_ga; const float* w_pool; const float* pool_scale; const float* w_out; const float* norm_ffn;
    const float* w_f1; const float* w_f2; const float* norm_final;
    float* xf; char* ws;
    int phase_lo, phase_hi;
};

typedef float f32x2 __attribute__((ext_vector_type(2)));
typedef __bf16 bf16x2_t __attribute__((ext_vector_type(2)));
__device__ __forceinline__ unsigned cvt_pk_bf16(float lo, float hi) { const f32x2 v = {lo, hi}; const bf16x2_t b = __builtin_convertvector(v, bf16x2_t); return __builtin_bit_cast(unsigned, b); }
__device__ __forceinline__ float bf2f(unsigned short b) { return __uint_as_float(((unsigned)b) << 16); }
__device__ __forceinline__ float bflo(unsigned w) { return __uint_as_float(w << 16); }
__device__ __forceinline__ float bfhi(unsigned w) { return __uint_as_float(w & 0xffff0000u); }
__device__ __forceinline__ unsigned short f2bf(float f) { return (unsigned short)(cvt_pk_bf16(f, 0.f) & 0xffffu); }
__device__ __forceinline__ float sigmoidf_(float x) { return __builtin_amdgcn_rcpf(1.f + __expf(-x)); }

namespace pg8 {
constexpr int BM = 256, BK = 64, HALF = 128, HTB = HALF * BK * 2, STAGE_BYTES = 8 * HTB, NXCD = 8, WGM = 8;
__device__ __forceinline__ int lds_byte(int r, int c) { const int st = (r >> 4) * 2 + (c >> 5), rr = r & 15, cc = c & 31, ob = rr * 64 + cc * 2; return st * 1024 + (ob ^ (((ob >> 9) & 1) << 5)); }
__device__ __forceinline__ void stage_rc(int b, int& R, int& C) { const int st = b / 1024, sb = b % 1024, swz = sb ^ (((sb >> 9) & 1) << 5); R = (st >> 1) * 16 + swz / 64; C = (st & 1) * 32 + (swz % 64) / 2; }
__device__ __forceinline__ int perm32(int rho) { const int n = rho >> 4, i = rho & 15; return 8 * (i >> 2) + 4 * n + (i & 3); }
struct Unit { int pm, pn; };
struct Gemm { const bf16_t* A; const bf16_t* Bt; int M, N, K, lda; };
struct StaticOrder {
    int nM, nN, nwg, G, c;
    __device__ void init(int M, int N, int G_, int c_) { nM = M / BM; nN = N / BM; nwg = nM * nN; G = G_; c = c_; }
    __device__ bool next(int i, Unit& u) const {
        const long L = (long)i * G + c; if (L >= nwg) return false;
        int wgid = (int)L; { const int q = nwg / NXCD, r = nwg % NXCD, xcd = wgid % NXCD, off = wgid / NXCD; wgid = (xcd < r ? xcd * (q + 1) : r * (q + 1) + (xcd - r) * q) + off; }
        const int nig = WGM * nN, gid = wgid / nig, fm = gid * WGM, gsz = (nM - fm) < WGM ? (nM - fm) : WGM;
        u.pm = fm + ((wgid % nig) % gsz); u.pn = (wgid % nig) / gsz; return true;
    }
};

template <class Epi, int APN = 0, bool ALIGN_EPI = true, bool SP2 = true>
__device__ __forceinline__ void gemm_phase(LAS unsigned char* lds, const Gemm g, const StaticOrder& S, const Epi& E) {
    int tid = threadIdx.x; asm volatile("" : "+v"(tid));
    const int wid = __builtin_amdgcn_readfirstlane(tid >> 6), lane = tid & 63, wr = wid >> 2, wc = wid & 3, fr = lane & 15, fq = lane >> 4;
    int K = g.K; asm volatile("" : "+s"(K));
    const int nt = K / BK;
    unsigned voffA[2], voffB[2];
#pragma unroll
    for (int i = 0; i < 2; ++i) { int R, C; stage_rc(tid * 16 + i * 8192, R, C); const int Rb = Epi::PERM ? ((R & ~31) + perm32(R & 31)) : R;
        voffA[i] = (unsigned)(R * g.lda + C) * 2u; voffB[i] = (unsigned)(Rb * K + C) * 2u; }
    const size_t kstep = (size_t)(BK * 2);
    const size_t hstepA = (size_t)HALF * g.lda * 2, hstepB = (size_t)HALF * K * 2;
    const size_t tstepA = 2 * hstepA, tstepB = 2 * hstepB;
    const unsigned ldsw = (unsigned)wid * 1024u;
    const int aoff = lds_byte(wr * 64 + fr, fq * 8), boff = lds_byte(wc * 32 + fr, fq * 8);
#define PG8_SA(b, h) (((b) * 2 + (h)) * HTB)
#define PG8_SB(b, h) ((4 + (b) * 2 + (h)) * HTB)
#define PG8_STAGE(bufoff, gbase, voff) do { _Pragma("unroll") for (int _i = 0; _i < 2; ++_i) \
        __builtin_amdgcn_global_load_lds((const unsigned*)((const char*)(gbase) + (voff)[_i]), (LAS unsigned*)(lds + (bufoff) + ldsw + _i * 8192), 16, 0, 0); } while (0)
#define PG8_LDA(dst, b, h) do { _Pragma("unroll") for (int m = 0; m < 4; ++m) _Pragma("unroll") for (int k = 0; k < 2; ++k) dst[m][k] = *(const LAS bf16x8*)(lds + PG8_SA(b, h) + aoff + m * 2048 + k * 1024); } while (0)
#define PG8_LDB(dst, b, h) do { _Pragma("unroll") for (int n = 0; n < 2; ++n) _Pragma("unroll") for (int k = 0; k < 2; ++k) dst[n][k] = *(const LAS bf16x8*)(lds + PG8_SB(b, h) + boff + n * 2048 + k * 1024); } while (0)
#define PG8_MMA(ai, bj, At, Bt) do { __builtin_amdgcn_s_setprio(1); _Pragma("unroll") for (int m = 0; m < 4; ++m) _Pragma("unroll") for (int n = 0; n < 2; ++n) _Pragma("unroll") for (int k = 0; k < 2; ++k) \
        acc[ai][bj][m][n] = __builtin_amdgcn_mfma_f32_16x16x32_bf16(Bt[n][k], At[m][k], acc[ai][bj][m][n], 0, 0, 0); __builtin_amdgcn_s_setprio(0); } while (0)
#define PG8_WAIT_V(n) asm volatile("s_waitcnt vmcnt(" #n ")" ::: "memory")
#define PG8_WAIT_L(n) asm volatile("s_waitcnt lgkmcnt(" #n ")" ::: "memory")
#define PG8_BAR __builtin_amdgcn_s_barrier()
#define PG8_SCHED __builtin_amdgcn_sched_barrier(0)
    Unit cur, nxt; int ui = 0;
    if (!S.next(0, cur)) return;
    f32x4 acc[2][2][4][2];
#pragma unroll
    for (int a = 0; a < 2; ++a)
#pragma unroll
        for (int b = 0; b < 2; ++b)
#pragma unroll
            for (int m = 0; m < 4; ++m)
#pragma unroll
                for (int n = 0; n < 2; ++n) acc[a][b][m][n] = (f32x4){0.f, 0.f, 0.f, 0.f};
    bf16x8 At[4][2], B0[2][2], B1[2][2];
    const char* cA = (const char*)g.A + (size_t)cur.pm * tstepA + (size_t)cur.pn * APN; const char* cB = (const char*)g.Bt + (size_t)cur.pn * tstepB;
    if constexpr (SP2) {
        PG8_STAGE(PG8_SB(0, 0), cB, voffB); PG8_STAGE(PG8_SB(0, 1), cB + hstepB, voffB); PG8_STAGE(PG8_SA(0, 0), cA, voffA); PG8_STAGE(PG8_SA(0, 1), cA + hstepA, voffA);
        if (wr == 1) PG8_BAR;
        PG8_WAIT_V(2); PG8_BAR;
        PG8_STAGE(PG8_SB(1, 0), cB + kstep, voffB); PG8_STAGE(PG8_SA(1, 0), cA + kstep, voffA); PG8_STAGE(PG8_SB(1, 1), cB + hstepB + kstep, voffB);
        PG8_WAIT_V(6); PG8_BAR;
    } else {
        PG8_STAGE(PG8_SB(0, 0), cB, voffB); PG8_STAGE(PG8_SA(0, 0), cA, voffA); PG8_STAGE(PG8_SB(0, 1), cB + hstepB, voffB); PG8_STAGE(PG8_SA(0, 1), cA + hstepA, voffA);
        if (wr == 1) PG8_BAR;
        PG8_WAIT_V(4); PG8_BAR;
        PG8_STAGE(PG8_SB(1, 0), cB + kstep, voffB); PG8_STAGE(PG8_SA(1, 0), cA + kstep, voffA); PG8_STAGE(PG8_SB(1, 1), cB + hstepB + kstep, voffB);
        PG8_WAIT_V(6); PG8_BAR;
    }
    for (;;) {
        const bool has_next = S.next(ui + 1, nxt);
        const char* nA = has_next ? (const char*)g.A + (size_t)nxt.pm * tstepA + (size_t)nxt.pn * APN : cA; const char* nB = has_next ? (const char*)g.Bt + (size_t)nxt.pn * tstepB : cB;
        for (int t = 0; t < nt; t += 2) {
            const bool last = (t == nt - 2);
            const char* a1 = cA + (size_t)(t + 1) * kstep;
            const char* a2 = last ? nA : cA + (size_t)(t + 2) * kstep; const char* b2 = last ? nB : cB + (size_t)(t + 2) * kstep;
            const char* a3 = a2 + kstep; const char* b3 = b2 + kstep;
            if constexpr (SP2) {
            PG8_LDB(B0, 0, 0); PG8_LDB(B1, 0, 1); PG8_SCHED; PG8_LDA(At, 0, 0); PG8_STAGE(PG8_SA(1, 1), a1 + hstepA, voffA);
            PG8_WAIT_V(8); PG8_WAIT_L(0); PG8_BAR; PG8_MMA(0, 0, At, B0); PG8_MMA(0, 1, At, B1); PG8_BAR; PG8_SCHED;
            PG8_LDA(At, 0, 1); PG8_STAGE(PG8_SB(0, 0), b2, voffB); PG8_STAGE(PG8_SB(0, 1), b2 + hstepB, voffB); PG8_STAGE(PG8_SA(0, 0), a2, voffA);
            PG8_WAIT_V(8); PG8_WAIT_L(0); PG8_BAR; PG8_MMA(1, 0, At, B0); PG8_MMA(1, 1, At, B1); PG8_BAR; PG8_SCHED;
            PG8_LDB(B0, 1, 0); PG8_LDB(B1, 1, 1); PG8_SCHED; PG8_LDA(At, 1, 0); PG8_STAGE(PG8_SA(0, 1), a2 + hstepA, voffA);
            PG8_WAIT_V(8); PG8_WAIT_L(0); PG8_BAR; PG8_MMA(0, 0, At, B0); PG8_MMA(0, 1, At, B1); PG8_BAR; PG8_SCHED;
            PG8_LDA(At, 1, 1); PG8_STAGE(PG8_SB(1, 0), b3, voffB); PG8_STAGE(PG8_SB(1, 1), b3 + hstepB, voffB); PG8_STAGE(PG8_SA(1, 0), a3, voffA);
            PG8_WAIT_V(8); PG8_WAIT_L(0); PG8_BAR; PG8_MMA(1, 0, At, B0); PG8_MMA(1, 1, At, B1); PG8_BAR; PG8_SCHED;
            } else {
            PG8_LDB(B0, 0, 0); PG8_SCHED; PG8_LDA(At, 0, 0); PG8_STAGE(PG8_SA(1, 1), a1 + hstepA, voffA);
            PG8_WAIT_L(8); PG8_BAR; PG8_WAIT_L(0); PG8_MMA(0, 0, At, B0); PG8_BAR; PG8_SCHED;
            PG8_LDB(B1, 0, 1); PG8_STAGE(PG8_SB(0, 0), b2, voffB);
            PG8_BAR; PG8_WAIT_L(0); PG8_MMA(0, 1, At, B1); PG8_BAR;
            PG8_LDA(At, 0, 1); PG8_STAGE(PG8_SA(0, 0), a2, voffA);
            PG8_BAR; PG8_WAIT_L(0); PG8_MMA(1, 0, At, B0); PG8_BAR; PG8_SCHED;
            PG8_STAGE(PG8_SB(0, 1), b2 + hstepB, voffB);
            PG8_WAIT_V(6); PG8_BAR; PG8_MMA(1, 1, At, B1); PG8_BAR;
            PG8_LDB(B0, 1, 0); PG8_SCHED; PG8_LDA(At, 1, 0); PG8_STAGE(PG8_SA(0, 1), a2 + hstepA, voffA);
            PG8_WAIT_L(8); PG8_BAR; PG8_WAIT_L(0); PG8_MMA(0, 0, At, B0); PG8_BAR; PG8_SCHED;
            PG8_LDB(B1, 1, 1); PG8_STAGE(PG8_SB(1, 0), b3, voffB);
            PG8_BAR; PG8_WAIT_L(0); PG8_MMA(0, 1, At, B1); PG8_BAR;
            PG8_LDA(At, 1, 1); PG8_STAGE(PG8_SA(1, 0), a3, voffA);
            PG8_BAR; PG8_WAIT_L(0); PG8_MMA(1, 0, At, B0); PG8_BAR; PG8_SCHED;
            PG8_STAGE(PG8_SB(1, 1), b3 + hstepB, voffB);
            PG8_WAIT_V(6); PG8_BAR; PG8_MMA(1, 1, At, B1); PG8_BAR;
            }
        }
        if constexpr (ALIGN_EPI) { if (wr == 0) PG8_BAR; }
        E(acc, cur, wr, wc, fr, fq);
        if (!has_next) break;
#pragma unroll
        for (int a = 0; a < 2; ++a)
#pragma unroll
            for (int b = 0; b < 2; ++b)
#pragma unroll
                for (int m = 0; m < 4; ++m)
#pragma unroll
                    for (int n = 0; n < 2; ++n) acc[a][b][m][n] = (f32x4){0.f, 0.f, 0.f, 0.f};
        cur = nxt; cA = nA; cB = nB; ++ui;
        if constexpr (ALIGN_EPI) { if (wr == 1) PG8_BAR; }
    }
    PG8_WAIT_V(0);
    if constexpr (!ALIGN_EPI) { if (wr == 0) PG8_BAR; }
    PG8_BAR;
#undef PG8_SA
#undef PG8_SB
#undef PG8_STAGE
#undef PG8_LDA
#undef PG8_LDB
#undef PG8_MMA
#undef PG8_WAIT_V
#undef PG8_WAIT_L
#undef PG8_BAR
#undef PG8_SCHED
}
}
using pg8::Unit;

__device__ __forceinline__ float rowscale(const float* ssq, int row) {
    const f32x4* s = (const f32x4*)(ssq + (size_t)row * 16);
    const f32x4 a = s[0], b = s[1], c = s[2], d = s[3];
    const float t = ((a[0] + a[1]) + (a[2] + a[3])) + ((b[0] + b[1]) + (b[2] + b[3])) + ((c[0] + c[1]) + (c[2] + c[3])) + ((d[0] + d[1]) + (d[2] + d[3]));
    return rsqrtf(t * (1.f / 1024.f) + 1e-6f);
}
__device__ __forceinline__ u32x4 pack8(const f32x4 v0, const f32x4 v1) {
    u32x4 w; w.x = cvt_pk_bf16(v0[0], v0[1]); w.y = cvt_pk_bf16(v0[2], v0[3]); w.z = cvt_pk_bf16(v1[0], v1[1]); w.w = cvt_pk_bf16(v1[2], v1[3]); return w;
}

struct EpiA {
    static constexpr bool PERM = true;
    bf16_t* P; bf16_t* lr; const float* ssq;
    __device__ __forceinline__ void operator()(const f32x4 (&acc)[2][2][4][2], const Unit& u, int wr, int wc, int fr, int fq) const {
        const int row0 = u.pm * 256 + wr * 64 + fr;
#pragma unroll
        for (int ai = 0; ai < 2; ++ai)
#pragma unroll
            for (int m = 0; m < 4; ++m) {
                const int row = row0 + ai * 128 + m * 16; const float rs = rowscale(ssq, row);
                if (u.pn < 14) {
#pragma unroll
                    for (int bj = 0; bj < 2; ++bj) {
                        const f32x4 v0 = acc[ai][bj][m][0] * rs, v1 = acc[ai][bj][m][1] * rs;
                        *(u32x4*)(P + (size_t)row * PW + u.pn * 256 + bj * 128 + wc * 32 + 8 * fq) = pack8(v0, v1);
                    }
                } else if (wc == 0) {
                    const f32x4 v0 = acc[ai][0][m][0] * rs, v1 = acc[ai][0][m][1] * rs;
                    const u32x4 hi = pack8(v0, v1);
                    const f32x4 d0 = (f32x4){v0[0] - bflo(hi.x), v0[1] - bfhi(hi.x), v0[2] - bflo(hi.y), v0[3] - bfhi(hi.y)};
                    const f32x4 d1 = (f32x4){v1[0] - bflo(hi.z), v1[1] - bfhi(hi.z), v1[2] - bflo(hi.w), v1[3] - bfhi(hi.w)};
                    bf16_t* lp = lr + (size_t)row * 64 + (fq >> 1) * 32 + (fq & 1) * 8;
                    *(u32x4*)lp = hi; *(u32x4*)(lp + 16) = pack8(d0, d1);
                }
            }
    }
};
struct EpiGate {
    static constexpr bool PERM = true;
    bf16_t* P; const float* ssq;
    __device__ __forceinline__ void operator()(const f32x4 (&acc)[2][2][4][2], const Unit& u, int wr, int wc, int fr, int fq) const {
        const int row0 = u.pm * 256 + wr * 64 + fr;
#pragma unroll
        for (int ai = 0; ai < 2; ++ai)
#pragma unroll
            for (int m = 0; m < 4; ++m) {
                const int row = row0 + ai * 128 + m * 16; const float rs = rowscale(ssq, row);
#pragma unroll
                for (int bj = 0; bj < 2; ++bj) {
                    f32x4 v0 = acc[ai][bj][m][0] * rs, v1 = acc[ai][bj][m][1] * rs;
#pragma unroll
                    for (int j = 0; j < 4; ++j) { v0[j] = sigmoidf_(v0[j]); v1[j] = sigmoidf_(v1[j]); }
                    *(u32x4*)(P + (size_t)row * PW + u.pn * 256 + bj * 128 + wc * 32 + 8 * fq) = pack8(v0, v1);
                }
            }
    }
};
struct EpiPool {
    static constexpr bool PERM = true;
    bf16_t* P; const float* pscale;
    __device__ __forceinline__ void operator()(const f32x4 (&acc)[2][2][4][2], const Unit& u, int wr, int wc, int fr, int fq) const {
        const int row0 = u.pm * 256 + wr * 64 + fr;
#pragma unroll
        for (int bj = 0; bj < 2; ++bj) {
            const int col = u.pn * 256 + bj * 128 + wc * 32 + 8 * fq;
            const f32x4 p0 = *(const f32x4*)(pscale + col), p1 = *(const f32x4*)(pscale + col + 4);
#pragma unroll
            for (int ai = 0; ai < 2; ++ai)
#pragma unroll
                for (int m = 0; m < 4; ++m) {
                    const int row = row0 + ai * 128 + m * 16;
                    bf16_t* ptr = P + (size_t)row * PW + 1024 + col;
                    const u32x4 g = *(const u32x4*)ptr;
                    f32x4 v0 = acc[ai][bj][m][0] * p0, v1 = acc[ai][bj][m][1] * p1;
                    v0[0] *= bflo(g.x); v0[1] *= bfhi(g.x); v0[2] *= bflo(g.y); v0[3] *= bfhi(g.y);
                    v1[0] *= bflo(g.z); v1[1] *= bfhi(g.z); v1[2] *= bflo(g.w); v1[3] *= bfhi(g.w);
                    *(u32x4*)ptr = pack8(v0, v1);
                    if (m & 1) asm volatile("" ::: "memory");
                }
        }
    }
};
struct EpiMerge {
    static constexpr bool PERM = true;
    bf16_t* P;
    __device__ __forceinline__ void operator()(const f32x4 (&acc)[2][2][4][2], const Unit& u, int wr, int wc, int fr, int fq) const {
        const int row0 = u.pm * 256 + wr * 64 + fr;
#pragma unroll
        for (int ai = 0; ai < 2; ++ai)
#pragma unroll
            for (int m = 0; m < 4; ++m) {
                const int row = row0 + ai * 128 + m * 16;
#pragma unroll
                for (int bj = 0; bj < 2; ++bj) {
                    bf16_t* ptr = P + (size_t)row * PW + u.pn * 256 + bj * 128 + wc * 32 + 8 * fq;
                    const u32x4 g = *(const u32x4*)ptr; const u32x4 t = *(const u32x4*)(ptr + 1024);
                    f32x4 v0 = acc[ai][bj][m][0], v1 = acc[ai][bj][m][1];
                    v0[0] = v0[0] * bflo(g.x) + bflo(t.x); v0[1] = v0[1] * bfhi(g.x) + bfhi(t.x); v0[2] = v0[2] * bflo(g.y) + bflo(t.y); v0[3] = v0[3] * bfhi(g.y) + bfhi(t.y);
                    v1[0] = v1[0] * bflo(g.z) + bflo(t.z); v1[1] = v1[1] * bfhi(g.z) + bfhi(t.z); v1[2] = v1[2] * bflo(g.w) + bflo(t.w); v1[3] = v1[3] * bfhi(g.w) + bfhi(t.w);
                    *(u32x4*)ptr = pack8(v0, v1);
                }
                asm volatile("" ::: "memory");
            }
    }
};
struct EpiRes {
    static constexpr bool PERM = true;
    bf16_t* xb; float* ssq;
    __device__ __forceinline__ void operator()(const f32x4 (&acc)[2][2][4][2], const Unit& u, int wr, int wc, int fr, int fq) const {
        const int row0 = u.pm * 256 + wr * 64 + fr;
#pragma unroll
        for (int ai = 0; ai < 2; ++ai)
#pragma unroll
            for (int m = 0; m < 4; ++m) {
                const int row = row0 + ai * 128 + m * 16; float s = 0.f;
#pragma unroll
                for (int bj = 0; bj < 2; ++bj) {
                    bf16_t* ptr = xb + (size_t)row * 1024 + u.pn * 256 + bj * 128 + wc * 32 + 8 * fq;
                    const u32x4 g = *(const u32x4*)ptr;
                    f32x4 v0 = acc[ai][bj][m][0], v1 = acc[ai][bj][m][1];
                    v0[0] += bflo(g.x); v0[1] += bfhi(g.x); v0[2] += bflo(g.y); v0[3] += bfhi(g.y);
                    v1[0] += bflo(g.z); v1[1] += bfhi(g.z); v1[2] += bflo(g.w); v1[3] += bfhi(g.w);
                    *(u32x4*)ptr = pack8(v0, v1);
                    s += (v0[0] * v0[0] + v0[1] * v0[1]) + (v0[2] * v0[2] + v0[3] * v0[3]) + (v1[0] * v1[0] + v1[1] * v1[1]) + (v1[2] * v1[2] + v1[3] * v1[3]);
                }
                s += __shfl_xor(s, 16); s += __shfl_xor(s, 32);
                if (fq == 0) ssq[(size_t)row * 16 + u.pn * 4 + wc] = s;
            }
    }
};
struct EpiFfn1 {
    static constexpr bool PERM = true;
    bf16_t* ACT; const float* ssq;
    __device__ __forceinline__ void operator()(const f32x4 (&acc)[2][2][4][2], const Unit& u, int wr, int wc, int fr, int fq) const {
        const int row0 = u.pm * 256 + wr * 64 + fr;
#pragma unroll
        for (int ai = 0; ai < 2; ++ai)
#pragma unroll
            for (int m = 0; m < 4; ++m) {
                const int row = row0 + ai * 128 + m * 16; const float rs = rowscale(ssq, row);
                f32x4 o[2];
#pragma unroll
                for (int n = 0; n < 2; ++n)
#pragma unroll
                    for (int j = 0; j < 4; ++j) { const float gt = acc[ai][0][m][n][j] * rs, up = acc[ai][1][m][n][j] * rs; o[n][j] = gt * sigmoidf_(gt) * up; }
                *(u32x4*)(ACT + (size_t)row * DFF + u.pn * 128 + wc * 32 + 8 * fq) = pack8(o[0], o[1]);
            }
    }
};

struct WJob { const float* src; const float* g; bf16_t* dst; int ld, ldd, vlo, vhi, kw; };
__device__ __forceinline__ WJob wjob_decode(const Params& p, int layer, int j) {
    WJob w; w.g = nullptr; w.vlo = 0; w.vhi = 256; w.kw = 256;
    bf16_t* W = (bf16_t*)(p.ws + OFF_W + (size_t)layer * SZ_WLAYER);
    if (j < 480) { const int nb = j >> 2, kb = j & 3, n0 = nb * 32; int c0;
        if (n0 < 3072) c0 = n0; else if (n0 < 3584) c0 = 3104 + (n0 - 3072); else if (n0 == 3584) c0 = 3072; else { c0 = 0; w.vhi = 0; }
        w.src = p.w_in + (size_t)layer * 1024 * INW + (size_t)kb * 256 * INW + c0; w.ld = INW; w.g = p.norm_mix + layer * 1024 + kb * 256;
        w.dst = (bf16_t*)((char*)W + WO_A) + (size_t)n0 * 1024 + kb * 256; w.ldd = 1024; return w; }
    j -= 480;
    if (j < 256) { const int nb = j >> 2, kb = j & 3, n0 = nb * 32;
        w.src = p.w_in + (size_t)layer * 1024 * INW + (size_t)kb * 256 * INW + 3616 + n0; w.ld = INW; w.g = p.norm_mix + layer * 1024 + kb * 256;
        w.dst = (bf16_t*)((char*)W + WO_B) + (size_t)n0 * 1024 + kb * 256; w.ldd = 1024; return w; }
    j -= 256;
    if (j < 128) { const int nb = j >> 2, kb = j & 3, n0 = nb * 32;
        w.src = p.w_ga + (size_t)layer * 1024 * 1024 + (size_t)kb * 256 * 1024 + n0; w.ld = 1024;
        w.dst = (bf16_t*)((char*)W + WO_GA) + (size_t)n0 * 1024 + kb * 256; w.ldd = 1024; return w; }
    j -= 128;
    if (j < 64) { const int nb = j >> 1, kb = j & 1, n0 = nb * 32, grp = n0 >> 8;
        w.src = p.w_pool + (size_t)layer * 4 * 128 * 256 + (size_t)grp * 128 * 256 + (n0 & 255); w.ld = 256;
        w.vlo = 0; w.vhi = kb == 0 ? 128 : 0; w.kw = kb == 0 ? 128 : 0;
        w.dst = (bf16_t*)((char*)W + WO_POOL) + (size_t)n0 * 128; w.ldd = 128; return w; }
    j -= 64;
    if (j < 128) { const int nb = j >> 2, kb = j & 3, n0 = nb * 32;
        w.src = p.w_out + (size_t)layer * 1024 * 1024 + (size_t)kb * 256 * 1024 + n0; w.ld = 1024;
        w.dst = (bf16_t*)((char*)W + WO_OUT) + (size_t)n0 * 1024 + kb * 256; w.ldd = 1024; return w; }
    j -= 128;
    if (j < 704) { const int nb = j >> 2, kb = j & 3, n0 = nb * 32, pn = n0 >> 8, within = n0 & 255;
        const int c0 = within < 128 ? 128 * pn + within : DFF + 128 * pn + (within - 128);
        w.src = p.w_f1 + (size_t)layer * 1024 * 2 * DFF + (size_t)kb * 256 * 2 * DFF + c0; w.ld = 2 * DFF; w.g = p.norm_ffn + layer * 1024 + kb * 256;
        w.dst = (bf16_t*)((char*)W + WO_F1) + (size_t)n0 * 1024 + kb * 256; w.ldd = 1024; return w; }
    j -= 704;
    { const int nb = j / 11, kb = j % 11, n0 = nb * 32;
        w.src = p.w_f2 + (size_t)layer * DFF * 1024 + (size_t)kb * 256 * 1024 + n0; w.ld = 1024;
        w.dst = (bf16_t*)((char*)W + WO_F2) + (size_t)n0 * DFF + kb * 256; w.ldd = DFF; return w; }
}

__device__ __forceinline__ void phase_prep(LAS unsigned char* lds, const Params& p) {
    int tid = threadIdx.x; asm volatile("" : "+v"(tid));
    const int wid = tid >> 6, lane = tid & 63;
    for (int job = blockIdx.x; job < 2 * 2112; job += gridDim.x) {
        const int layer = job / 2112; const WJob w = wjob_decode(p, layer, job % 2112);
#pragma unroll
        for (int ps = 0; ps < 4; ++ps) {
            const int kk = (tid >> 3) + 64 * ps, c4 = (tid & 7) * 4;
            f32x4 v = (f32x4){0.f, 0.f, 0.f, 0.f};
            if (kk >= w.vlo && kk < w.vhi) { v = *(const f32x4*)(w.src + (size_t)kk * w.ld + c4); if (w.g) v = v * w.g[kk]; }
#pragma unroll
            for (int e = 0; e < 4; ++e) *(LAS float*)(lds + (kk * 33 + c4 + e) * 4) = v[e];
        }
        __syncthreads();
        { const int n = tid & 31, s = tid >> 5; unsigned pk[8];
#pragma unroll
            for (int e = 0; e < 8; ++e) { const float a = *(LAS float*)(lds + ((s * 16 + 2 * e) * 33 + n) * 4), b = *(LAS float*)(lds + ((s * 16 + 2 * e + 1) * 33 + n) * 4); pk[e] = cvt_pk_bf16(a, b); }
            bf16_t* d = w.dst + (size_t)n * w.ldd + s * 16;
            if (s * 16 < w.kw) { *(u32x4*)d = (u32x4){pk[0], pk[1], pk[2], pk[3]}; *(u32x4*)(d + 8) = (u32x4){pk[4], pk[5], pk[6], pk[7]}; } }
        __syncthreads();
    }
    bf16_t* xb = (bf16_t*)(p.ws + OFF_XB); float* ssq = (float*)(p.ws + OFF_SSQ);
    for (int row0 = blockIdx.x * 8 + wid; row0 < T_TOK; row0 += gridDim.x * 16) {
        f32x4 v[2][4]; bool ok[2];
#pragma unroll
        for (int u = 0; u < 2; ++u) { const int row = row0 + u * gridDim.x * 8; ok[u] = row < T_TOK;
            if (ok[u]) { const float* src = p.x_in + (size_t)row * 1024 + lane * 16;
#pragma unroll
                for (int i = 0; i < 4; ++i) v[u][i] = *(const f32x4*)(src + 4 * i); } }
#pragma unroll
        for (int u = 0; u < 2; ++u) if (ok[u]) { const int row = row0 + u * gridDim.x * 8;
            float s = 0.f;
#pragma unroll
            for (int i = 0; i < 4; ++i) s += (v[u][i][0] * v[u][i][0] + v[u][i][1] * v[u][i][1]) + (v[u][i][2] * v[u][i][2] + v[u][i][3] * v[u][i][3]);
#pragma unroll
            for (int o = 32; o >= 1; o >>= 1) s += __shfl_xor(s, o);
            bf16_t* dst = xb + (size_t)row * 1024 + lane * 16;
            *(u32x4*)dst = pack8(v[u][0], v[u][1]); *(u32x4*)(dst + 8) = pack8(v[u][2], v[u][3]);
            if (lane < 16) ssq[(size_t)row * 16 + lane] = lane == 0 ? s : 0.f; }
    }
}

#define MFMA16(a, b, c) __builtin_amdgcn_mfma_f32_16x16x32_bf16((a), (b), (c), 0, 0, 0)
template <bool PASS2>
__device__ __forceinline__ void gla_pass(LAS unsigned char* lds, const Params& p, int layer) {
    constexpr int SQ = 0, SKD = 17408, SV = 35840, SP = 69632, SLR = 78848, SDEC = 84992, SST = 85504, SK = SST, SX = SST + 17408, SCOL = SST + 51200;
    int tid = threadIdx.x; asm volatile("" : "+v"(tid));
    const int wid = __builtin_amdgcn_readfirstlane(tid >> 6), lane = tid & 63, fr = lane & 15, fq = lane >> 4;
    const int dk0 = (tid & 63) * 2;
    bf16_t* P = (bf16_t*)(p.ws + OFF_PROJ);
    const bf16_t* LR = (const bf16_t*)(p.ws + OFF_LR);
    bf16_t* E = (bf16_t*)(p.ws + OFF_E);
    bf16_t* QT = (bf16_t*)(p.ws + OFF_E + (size_t)32 * 1024 * 1024);
    float* DL = (float*)(p.ws + OFF_DLOG);
    bf16_t* O = (bf16_t*)(p.ws + OFF_O);
    for (int item = blockIdx.x; item < 256; item += gridDim.x) {
        const int b = item >> 7, h = (item >> 5) & 3, grp = item & 31;
#pragma unroll 1
        for (int dir = 0; dir < 2; ++dir) {
            const int scan = (b * 4 + h) * 2 + dir;
            bf16x8 wB1, wB2; float biasx;
            { const float* Wc = (dir ? p.wdu_b : p.wdu_f) + (size_t)layer * 16 * 512 + h * 128 + wid * 16 + fr;
              float wv[8]; unsigned h1[4], h2[4];
#pragma unroll
              for (int j = 0; j < 8; ++j) wv[j] = Wc[((fq & 1) * 8 + j) * 512];
#pragma unroll
              for (int jp = 0; jp < 4; ++jp) { const float a = wv[2 * jp], bq = wv[2 * jp + 1]; const unsigned hi = cvt_pk_bf16(a, bq);
                  const unsigned lo = cvt_pk_bf16(a - bflo(hi), bq - bfhi(hi)); h1[jp] = hi; h2[jp] = fq < 2 ? lo : 0u; }
              wB1 = __builtin_bit_cast(bf16x8, (u32x4){h1[0], h1[1], h1[2], h1[3]}); wB2 = __builtin_bit_cast(bf16x8, (u32x4){h2[0], h2[1], h2[2], h2[3]});
              biasx = (dir ? p.bd_b : p.bd_f)[layer * 512 + h * 128 + wid * 16 + fr]; }
            f32x4 accS[8][2];
            bf16_t* Eit = E + (size_t)(scan * 32 + grp) * 32768 + (size_t)(wid * 32 + fr) * 128 + 4 * fq;
#pragma unroll
            for (int m8 = 0; m8 < 8; ++m8)
#pragma unroll
                for (int n = 0; n < 2; ++n) accS[m8][n] = (f32x4){0.f, 0.f, 0.f, 0.f};
            float gtot0 = 0.f, gtot1 = 0.f;
            u32x4 rk[2], rq[2], rv[4]; u32x4 rl = (u32x4){0u, 0u, 0u, 0u};
#define GLA_ISSUE(CC) do { const int chunk_ = dir ? 7 - (CC) : (CC); const int t0_ = b * SEQL + grp * 512 + chunk_ * 64; \
                _Pragma("unroll") for (int it = 0; it < 2; ++it) { const int pi = tid + 512 * it, row = pi >> 4, seg = pi & 15; \
                    const bf16_t* src = P + (size_t)(t0_ + row) * PW + h * 128 + seg * 8; rk[it] = *(const u32x4*)(src + 512); } \
                if (tid < 256) { const int row = tid >> 2, seg = tid & 3; rl = *(const u32x4*)(LR + (size_t)(t0_ + row) * 64 + dir * 32 + seg * 8); } } while (0)
            GLA_ISSUE(0);
#pragma unroll 1
            for (int cc = 0; cc < 8; ++cc) {
                const int chunk = dir ? 7 - cc : cc;
                const int t0 = b * SEQL + grp * 512 + chunk * 64;
#pragma unroll
                for (int it = 0; it < 2; ++it) { const int pi = tid + 512 * it, row = pi >> 4, seg = pi & 15;
                    *(LAS u32x4*)(lds + SK + row * 272 + seg * 16) = rk[it];
                    if (PASS2) rq[it] = *(const u32x4*)(P + (size_t)(t0 + row) * PW + h * 128 + seg * 8); }
#pragma unroll
                for (int it = 0; it < 4; ++it) { const int pi = tid + 512 * it, row = pi >> 5, seg = pi & 31;
                    rv[it] = *(const u32x4*)(P + (size_t)(t0 + row) * PW + 1024 + h * 256 + seg * 8); }
                if (tid < 256) { const int row = tid >> 2, seg = tid & 3; *(LAS u32x4*)(lds + SLR + row * 64 + seg * 16) = rl; }
                __syncthreads();
#pragma unroll 1
                for (int m = 0; m < 4; ++m) {
                    const bf16x8 A = *(LAS bf16x8*)(lds + SLR + (m * 16 + fr) * 64 + fq * 16);
                    f32x4 xx = (f32x4){0.f, 0.f, 0.f, 0.f};
                    xx = MFMA16(A, wB1, xx); xx = MFMA16(A, wB2, xx);
#pragma unroll
                    for (int jj = 0; jj < 4; ++jj) { const float x = xx[jj] + biasx; const float ls = fminf(x, 0.f) - __logf(1.f + __expf(-fabsf(x)));
                        *(LAS float*)(lds + SX + ((m * 16 + 4 * fq + jj) * 132 + wid * 16 + fr) * 4) = ls * 0.0625f; }
                }
                if (PASS2) {
#pragma unroll
                    for (int it = 0; it < 2; ++it) { const int pi = tid + 512 * it, row = pi >> 4, seg = pi & 15; *(LAS u32x4*)(lds + SQ + row * 272 + seg * 16) = rq[it]; } }
                __syncthreads();
                float c0[8], c1[8];
#pragma unroll
                for (int e = 0; e < 8; ++e) { const f32x2 t2 = *(LAS f32x2*)(lds + SX + ((wid * 8 + e) * 132 + dk0) * 4); c0[e] = t2.x; c1[e] = t2.y; }
                if (dir == 0) {
#pragma unroll
                    for (int e = 1; e < 8; ++e) { c0[e] += c0[e - 1]; c1[e] += c1[e - 1]; }
                } else {
#pragma unroll
                    for (int e = 6; e >= 0; --e) { c0[e] += c0[e + 1]; c1[e] += c1[e + 1]; }
                }
                { f32x2 t2; t2.x = dir == 0 ? c0[7] : c0[0]; t2.y = dir == 0 ? c1[7] : c1[0]; *(LAS f32x2*)(lds + SCOL + (wid * 128 + dk0) * 4) = t2; }
                __syncthreads();
                float tot0 = 0.f, tot1 = 0.f, offs0 = 0.f, offs1 = 0.f;
#pragma unroll
                for (int s = 0; s < 8; ++s) { const f32x2 t2 = *(LAS f32x2*)(lds + SCOL + (s * 128 + dk0) * 4); tot0 += t2.x; tot1 += t2.y;
                    const bool inc = dir == 0 ? (s < wid) : (s > wid); offs0 += inc ? t2.x : 0.f; offs1 += inc ? t2.y : 0.f; }
                const float etot0 = __expf(tot0), etot1 = __expf(tot1), eg0 = __expf(gtot0), eg1 = __expf(gtot1);
                unsigned kd0p[4], kd1p[4]; float kd0prev = 0.f, kd1prev = 0.f;
#pragma unroll
                for (int e = 0; e < 8; ++e) { const int i = wid * 8 + e;
                    const float ec0 = __expf(c0[e] + offs0), ec1 = __expf(c1[e] + offs1), inv0 = __builtin_amdgcn_rcpf(ec0), inv1 = __builtin_amdgcn_rcpf(ec1);
                    const unsigned kw = *(LAS unsigned*)(lds + SK + i * 272 + dk0 * 2);
                    const float k0 = bflo(kw), k1 = bfhi(kw);
                    const float kd0 = k0 * (etot0 * inv0), kd1 = k1 * (etot1 * inv1);
                    if (PASS2) { const unsigned qw = *(LAS unsigned*)(lds + SQ + i * 272 + dk0 * 2);
                        const float qe0 = bflo(qw) * 0.08838834764831845f * ec0, qe1 = bfhi(qw) * 0.08838834764831845f * ec1;
                        *(LAS unsigned*)(lds + SQ + i * 272 + dk0 * 2) = cvt_pk_bf16(qe0, qe1);
                        const unsigned qt = cvt_pk_bf16(qe0 * eg0, qe1 * eg1);
                        if (dir == 0) *(unsigned*)(QT + (size_t)(t0 + i) * 512 + h * 128 + dk0) = qt; else *(unsigned*)(P + (size_t)(t0 + i) * PW + h * 128 + dk0) = qt;
                        *(LAS unsigned*)(lds + SK + i * 272 + dk0 * 2) = cvt_pk_bf16(k0 * inv0, k1 * inv1); }
                    if (e & 1) { kd0p[e >> 1] = cvt_pk_bf16(kd0prev, kd0); kd1p[e >> 1] = cvt_pk_bf16(kd1prev, kd1); } else { kd0prev = kd0; kd1prev = kd1; } }
                *(LAS u32x4*)(lds + SKD + dk0 * 144 + wid * 16) = (u32x4){kd0p[0], kd0p[1], kd0p[2], kd0p[3]};
                *(LAS u32x4*)(lds + SKD + (dk0 + 1) * 144 + wid * 16) = (u32x4){kd1p[0], kd1p[1], kd1p[2], kd1p[3]};
                if (wid == 0) { f32x2 t2; t2.x = etot0; t2.y = etot1; *(LAS f32x2*)(lds + SDEC + dk0 * 4) = t2; }
                gtot0 += tot0; gtot1 += tot1;
#pragma unroll
                for (int it = 0; it < 4; ++it) { const int pi = tid + 512 * it, row = pi >> 5, seg = pi & 31;
                    *(LAS u32x4*)(lds + SV + row * 528 + seg * 16) = rv[it]; }
                __syncthreads();
                if (PASS2) {
                    f32x4 accP[2];
#pragma unroll
                    for (int s = 0; s < 2; ++s) { const int tt = wid * 2 + s, ib = tt >> 2, jb = tt & 3; f32x4 a = (f32x4){0.f, 0.f, 0.f, 0.f};
#pragma unroll
                        for (int kb = 0; kb < 4; ++kb) { const bf16x8 A = *(LAS bf16x8*)(lds + SK + (jb * 16 + fr) * 272 + (kb * 32 + fq * 8) * 2);
                            const bf16x8 B = *(LAS bf16x8*)(lds + SQ + (ib * 16 + fr) * 272 + (kb * 32 + fq * 8) * 2); a = MFMA16(A, B, a); }
                        accP[s] = a; }
                    __syncthreads();
#pragma unroll
                    for (int s = 0; s < 2; ++s) { const int tt = wid * 2 + s, ib = tt >> 2, jb = tt & 3; const int i = ib * 16 + fr, jbase = jb * 16 + 4 * fq; float v[4];
#pragma unroll
                        for (int jj = 0; jj < 4; ++jj) { const int j = jbase + jj; const bool keep = dir == 0 ? (j <= i) : (j > i); v[jj] = keep ? accP[s][jj] : 0.f; }
                        *(LAS u32x2*)(lds + SP + i * 144 + jbase * 2) = (u32x2){cvt_pk_bf16(v[0], v[1]), cvt_pk_bf16(v[2], v[3])}; }
#pragma unroll
                    for (int m8 = 0; m8 < 8; ++m8)
#pragma unroll
                        for (int n = 0; n < 2; ++n) { const f32x4 sv = accS[m8][n];
                            *(LAS u32x2*)(lds + SST + (wid * 32 + n * 16 + fr) * 272 + (m8 * 16 + 4 * fq) * 2) = (u32x2){cvt_pk_bf16(sv[0], sv[1]), cvt_pk_bf16(sv[2], sv[3])}; }
                    __syncthreads();
                }
                bf16x8 vf[2][2];
#pragma unroll
                for (int n = 0; n < 2; ++n)
#pragma unroll
                    for (int kb2 = 0; kb2 < 2; ++kb2) { unsigned w[4];
#pragma unroll
                        for (int jp = 0; jp < 4; ++jp) { const unsigned lo = *(LAS unsigned short*)(lds + SV + (kb2 * 32 + fq * 8 + 2 * jp) * 528 + (wid * 32 + n * 16 + fr) * 2);
                            const unsigned hi = *(LAS unsigned short*)(lds + SV + (kb2 * 32 + fq * 8 + 2 * jp + 1) * 528 + (wid * 32 + n * 16 + fr) * 2); w[jp] = lo | (hi << 16); }
                        vf[n][kb2] = __builtin_bit_cast(bf16x8, (u32x4){w[0], w[1], w[2], w[3]}); }
                if (PASS2) {
#pragma unroll
                    for (int n = 0; n < 2; ++n) {
                        f32x4 accO[4];
#pragma unroll
                        for (int m = 0; m < 4; ++m) accO[m] = (f32x4){0.f, 0.f, 0.f, 0.f};
#pragma unroll
                        for (int kb = 0; kb < 4; ++kb) { const bf16x8 A = *(LAS bf16x8*)(lds + SST + (wid * 32 + n * 16 + fr) * 272 + (kb * 32 + fq * 8) * 2);
#pragma unroll
                            for (int m = 0; m < 4; ++m) { const bf16x8 B = *(LAS bf16x8*)(lds + SQ + (m * 16 + fr) * 272 + (kb * 32 + fq * 8) * 2); accO[m] = MFMA16(A, B, accO[m]); } }
#pragma unroll
                        for (int kb2 = 0; kb2 < 2; ++kb2)
#pragma unroll
                            for (int m = 0; m < 4; ++m) { const bf16x8 B = *(LAS bf16x8*)(lds + SP + (m * 16 + fr) * 144 + (kb2 * 32 + fq * 8) * 2); accO[m] = MFMA16(vf[n][kb2], B, accO[m]); }
#pragma unroll
                        for (int m = 0; m < 4; ++m) { bf16_t* dst = O + (size_t)(t0 + m * 16 + fr) * 1024 + h * 256 + wid * 32 + n * 16 + 4 * fq; f32x4 v = accO[m];
                            if (dir) { const u32x2 old = *(const u32x2*)dst; v[0] += bflo(old.x); v[1] += bfhi(old.x); v[2] += bflo(old.y); v[3] += bfhi(old.y); }
                            *(u32x2*)dst = (u32x2){cvt_pk_bf16(v[0], v[1]), cvt_pk_bf16(v[2], v[3])}; }
                        asm volatile("" ::: "memory");
                    }
                }
                if (cc < 7) GLA_ISSUE(cc + 1);
#pragma unroll
                for (int m8 = 0; m8 < 8; ++m8) { const f32x4 d = *(LAS f32x4*)(lds + SDEC + (m8 * 16 + 4 * fq) * 4);
#pragma unroll
                    for (int n = 0; n < 2; ++n) accS[m8][n] = accS[m8][n] * d;
#pragma unroll
                    for (int kb2 = 0; kb2 < 2; ++kb2) { const bf16x8 A = *(LAS bf16x8*)(lds + SKD + (m8 * 16 + fr) * 144 + (kb2 * 32 + fq * 8) * 2);
#pragma unroll
                        for (int n = 0; n < 2; ++n) accS[m8][n] = MFMA16(A, vf[n][kb2], accS[m8][n]); } }
                __syncthreads();
            }
            {
#pragma unroll
                for (int m8 = 0; m8 < 8; ++m8)
#pragma unroll
                    for (int n = 0; n < 2; ++n)
                        *(u32x2*)(Eit + n * 16 * 128 + m8 * 16) = (u32x2){cvt_pk_bf16(accS[m8][n][0], accS[m8][n][1]), cvt_pk_bf16(accS[m8][n][2], accS[m8][n][3])};
                if (wid == 0) { DL[(scan * 32 + grp) * 128 + dk0] = gtot0; DL[(scan * 32 + grp) * 128 + dk0 + 1] = gtot1; }
            }
        }
    }
}

#undef GLA_ISSUE
__device__ __forceinline__ void phase_combine(const Params& p) {
    bf16_t* E = (bf16_t*)(p.ws + OFF_E); const float* DL = (const float*)(p.ws + OFF_DLOG);
    int tid = threadIdx.x; asm volatile("" : "+v"(tid));
    for (int idx = blockIdx.x * 512 + tid; idx < 16 * 4096; idx += gridDim.x * 512) {
        const int scan = idx >> 12, e8 = idx & 4095, dk0 = (e8 & 15) * 8, dir = scan & 1;
        float R[8];
#pragma unroll
        for (int i = 0; i < 8; ++i) R[i] = 0.f;
#pragma unroll 1
        for (int q4 = 0; q4 < 4; ++q4) {
            u32x4 ev[8]; f32x4 d0[8], d1[8];
#pragma unroll
            for (int gg = 0; gg < 8; ++gg) { const int go = q4 * 8 + gg, g = dir ? 31 - go : go;
                ev[gg] = *(const u32x4*)(E + (size_t)(scan * 32 + g) * 32768 + e8 * 8);
                d0[gg] = *(const f32x4*)(DL + (scan * 32 + g) * 128 + dk0); d1[gg] = *(const f32x4*)(DL + (scan * 32 + g) * 128 + dk0 + 4); }
#pragma unroll
            for (int gg = 0; gg < 8; ++gg) { const int go = q4 * 8 + gg, g = dir ? 31 - go : go;
                *(u32x4*)(E + (size_t)(scan * 32 + g) * 32768 + e8 * 8) = (u32x4){cvt_pk_bf16(R[0], R[1]), cvt_pk_bf16(R[2], R[3]), cvt_pk_bf16(R[4], R[5]), cvt_pk_bf16(R[6], R[7])};
                const u32x4 w = ev[gg];
                R[0] = R[0] * __expf(d0[gg][0]) + bflo(w.x); R[1] = R[1] * __expf(d0[gg][1]) + bfhi(w.x); R[2] = R[2] * __expf(d0[gg][2]) + bflo(w.y); R[3] = R[3] * __expf(d0[gg][3]) + bfhi(w.y);
                R[4] = R[4] * __expf(d1[gg][0]) + bflo(w.z); R[5] = R[5] * __expf(d1[gg][1]) + bfhi(w.z); R[6] = R[6] * __expf(d1[gg][2]) + bflo(w.w); R[7] = R[7] * __expf(d1[gg][3]) + bfhi(w.w); }
        }
    }
}

__device__ __forceinline__ void gla_light(LAS unsigned char* lds, const Params& p, int layer) {
    constexpr int SSTF = 0, SSTB = 69632, SSS = 139264, SRN = SSS + 2048;
    int tid = threadIdx.x; asm volatile("" : "+v"(tid));
    const int wid = __builtin_amdgcn_readfirstlane(tid >> 6), lane = tid & 63, fr = lane & 15, fq = lane >> 4;
    bf16_t* P = (bf16_t*)(p.ws + OFF_PROJ);
    const bf16_t* E = (const bf16_t*)(p.ws + OFF_E);
    const bf16_t* QT = (const bf16_t*)(p.ws + OFF_E + (size_t)32 * 1024 * 1024);
    const bf16_t* O = (const bf16_t*)(p.ws + OFF_O);
    for (int item = blockIdx.x; item < 256; item += gridDim.x) {
        const int b = item >> 7, h = (item >> 5) & 3, grp = item & 31;
        const int scanf = (b * 4 + h) * 2;
        __syncthreads();
#pragma unroll
        for (int it = 0; it < 8; ++it) { const int pi = tid + 512 * it, row = pi >> 4, seg = pi & 15;
            const u32x4 vf_ = *(const u32x4*)(E + (size_t)(scanf * 32 + grp) * 32768 + row * 128 + seg * 8);
            const u32x4 vb_ = *(const u32x4*)(E + (size_t)((scanf + 1) * 32 + grp) * 32768 + row * 128 + seg * 8);
            *(LAS u32x4*)(lds + SSTF + row * 272 + seg * 16) = vf_; *(LAS u32x4*)(lds + SSTB + row * 272 + seg * 16) = vb_; }
        __syncthreads();
        f32x4 gn[2];
#pragma unroll
        for (int n = 0; n < 2; ++n) gn[n] = *(const f32x4*)(p.gla_norm + layer * 1024 + h * 256 + wid * 32 + n * 16 + 4 * fq);
#pragma unroll 1
        for (int cc = 0; cc < 8; ++cc) {
            const int t0 = b * SEQL + grp * 512 + cc * 64;
            u32x2 oo[2][4], rr[2][4];
#pragma unroll
            for (int n = 0; n < 2; ++n)
#pragma unroll
                for (int m = 0; m < 4; ++m) { oo[n][m] = *(const u32x2*)(O + (size_t)(t0 + m * 16 + fr) * 1024 + h * 256 + wid * 32 + n * 16 + 4 * fq);
                    rr[n][m] = *(const u32x2*)(P + (size_t)(t0 + m * 16 + fr) * PW + 2048 + h * 256 + wid * 32 + n * 16 + 4 * fq); }
            f32x4 accO[2][4];
#pragma unroll
            for (int n = 0; n < 2; ++n)
#pragma unroll
                for (int m = 0; m < 4; ++m) accO[n][m] = (f32x4){0.f, 0.f, 0.f, 0.f};
#pragma unroll
            for (int dir = 0; dir < 2; ++dir) {
                const bf16_t* qsrc = dir ? (const bf16_t*)P + h * 128 : QT + h * 128; const int qld = dir ? PW : 512; const int SSTd = dir ? SSTB : SSTF;
                bf16x8 bq[4][4];
#pragma unroll
                for (int kb = 0; kb < 4; ++kb)
#pragma unroll
                    for (int m = 0; m < 4; ++m) bq[kb][m] = *(const bf16x8*)(qsrc + (size_t)(t0 + m * 16 + fr) * qld + kb * 32 + fq * 8);
#pragma unroll
                for (int kb = 0; kb < 4; ++kb)
#pragma unroll
                    for (int n = 0; n < 2; ++n) { const bf16x8 A = *(LAS bf16x8*)(lds + SSTd + (wid * 32 + n * 16 + fr) * 272 + (kb * 32 + fq * 8) * 2);
#pragma unroll
                        for (int m = 0; m < 4; ++m) accO[n][m] = MFMA16(A, bq[kb][m], accO[n][m]); }
            }
            float ssl[4];
#pragma unroll
            for (int m = 0; m < 4; ++m) { float s = 0.f;
#pragma unroll
                for (int n = 0; n < 2; ++n) { f32x4 v = accO[n][m]; v[0] += bflo(oo[n][m].x); v[1] += bfhi(oo[n][m].x); v[2] += bflo(oo[n][m].y); v[3] += bfhi(oo[n][m].y); accO[n][m] = v;
                    s += (v[0] * v[0] + v[1] * v[1]) + (v[2] * v[2] + v[3] * v[3]); }
                s += __shfl_xor(s, 16); s += __shfl_xor(s, 32); ssl[m] = s;
                if (fq == 0) *(LAS float*)(lds + SSS + (wid * 64 + m * 16 + fr) * 4) = s; }
            __syncthreads();
            if (tid < 64) { float s = 0.f;
#pragma unroll
                for (int w = 0; w < 8; ++w) s += *(LAS float*)(lds + SSS + (w * 64 + tid) * 4);
                *(LAS float*)(lds + SRN + tid * 4) = rsqrtf(s * (1.f / 256.f) + 1e-6f); }
            __syncthreads();
#pragma unroll
            for (int n = 0; n < 2; ++n)
#pragma unroll
                for (int m = 0; m < 4; ++m) { const float rn = *(LAS float*)(lds + SRN + (m * 16 + fr) * 4);
                    const float r0 = bflo(rr[n][m].x), r1 = bfhi(rr[n][m].x), r2 = bflo(rr[n][m].y), r3 = bfhi(rr[n][m].y);
                    const f32x4 v = accO[n][m] * rn * gn[n];
                    *(u32x2*)(P + (size_t)(t0 + m * 16 + fr) * PW + 2048 + h * 256 + wid * 32 + n * 16 + 4 * fq) =
                        (u32x2){cvt_pk_bf16(v[0] * (r0 * sigmoidf_(r0)), v[1] * (r1 * sigmoidf_(r1))), cvt_pk_bf16(v[2] * (r2 * sigmoidf_(r2)), v[3] * (r3 * sigmoidf_(r3)))}; }
        }
    }
}

__device__ __forceinline__ void phase_gating(const Params& p, int layer) {
    int tid = threadIdx.x; asm volatile("" : "+v"(tid));
    const int wid = tid >> 6, lane = tid & 63;
    bf16_t* P = (bf16_t*)(p.ws + OFF_PROJ); const bf16_t* O = (const bf16_t*)(p.ws + OFF_O);
    const float* gn = p.gla_norm + layer * 1024 + lane * 16;
    f32x4 g4[4];
#pragma unroll
    for (int i = 0; i < 4; ++i) g4[i] = *(const f32x4*)(gn + 4 * i);
    for (int t0 = blockIdx.x * 8 + wid; t0 < T_TOK; t0 += gridDim.x * 16) {
        u32x4 oo[2][2], rr[2][2]; bool ok[2];
#pragma unroll
        for (int u = 0; u < 2; ++u) { const int t = t0 + u * gridDim.x * 8; ok[u] = t < T_TOK;
            if (ok[u]) { oo[u][0] = *(const u32x4*)(O + (size_t)t * 1024 + lane * 16); oo[u][1] = *(const u32x4*)(O + (size_t)t * 1024 + lane * 16 + 8);
                const bf16_t* rp = P + (size_t)t * PW + 2048 + lane * 16; rr[u][0] = *(const u32x4*)rp; rr[u][1] = *(const u32x4*)(rp + 8); } }
#pragma unroll
        for (int u = 0; u < 2; ++u) if (ok[u]) { const int t = t0 + u * gridDim.x * 8;
            bf16_t* rp = P + (size_t)t * PW + 2048 + lane * 16;
            const u32x4 o0 = oo[u][0], o1 = oo[u][1], r0 = rr[u][0], r1 = rr[u][1];
            float ov[16], rv[16];
            ov[0] = bflo(o0.x); ov[1] = bfhi(o0.x); ov[2] = bflo(o0.y); ov[3] = bfhi(o0.y); ov[4] = bflo(o0.z); ov[5] = bfhi(o0.z); ov[6] = bflo(o0.w); ov[7] = bfhi(o0.w);
            ov[8] = bflo(o1.x); ov[9] = bfhi(o1.x); ov[10] = bflo(o1.y); ov[11] = bfhi(o1.y); ov[12] = bflo(o1.z); ov[13] = bfhi(o1.z); ov[14] = bflo(o1.w); ov[15] = bfhi(o1.w);
            rv[0] = bflo(r0.x); rv[1] = bfhi(r0.x); rv[2] = bflo(r0.y); rv[3] = bfhi(r0.y); rv[4] = bflo(r0.z); rv[5] = bfhi(r0.z); rv[6] = bflo(r0.w); rv[7] = bfhi(r0.w);
            rv[8] = bflo(r1.x); rv[9] = bfhi(r1.x); rv[10] = bflo(r1.y); rv[11] = bfhi(r1.y); rv[12] = bflo(r1.z); rv[13] = bfhi(r1.z); rv[14] = bflo(r1.w); rv[15] = bfhi(r1.w);
            float s = 0.f;
#pragma unroll
            for (int i = 0; i < 16; ++i) s += ov[i] * ov[i];
            s += __shfl_xor(s, 8); s += __shfl_xor(s, 4); s += __shfl_xor(s, 2); s += __shfl_xor(s, 1);
            const float rn = rsqrtf(s * (1.f / 256.f) + 1e-6f);
            float out[16];
#pragma unroll
            for (int i = 0; i < 16; ++i) { const float r = rv[i]; out[i] = ov[i] * rn * g4[i >> 2][i & 3] * (r * sigmoidf_(r)); }
            *(u32x4*)rp = (u32x4){cvt_pk_bf16(out[0], out[1]), cvt_pk_bf16(out[2], out[3]), cvt_pk_bf16(out[4], out[5]), cvt_pk_bf16(out[6], out[7])};
            *(u32x4*)(rp + 8) = (u32x4){cvt_pk_bf16(out[8], out[9]), cvt_pk_bf16(out[10], out[11]), cvt_pk_bf16(out[12], out[13]), cvt_pk_bf16(out[14], out[15])}; }
    }
}

template <int HW>
__device__ __forceinline__ void pool_run(const bf16_t* P, bf16_t* PO, int t0, int c8) {
    constexpr int NR = 16 + 2 * HW - 1;
    const int pos0 = t0 & (SEQL - 1);
    const bf16_t* base = P + (size_t)t0 * PW + 3072 + c8 * 8;
    u32x4 v[NR];
#pragma unroll
    for (int k = 0; k < NR; ++k) { const int off = k - HW, tt = pos0 + off;
        v[k] = (tt >= 0 && tt < SEQL) ? *(const u32x4*)(base + (long)off * PW) : (u32x4){0u, 0u, 0u, 0u}; }
    float w[8];
#pragma unroll
    for (int i = 0; i < 8; ++i) w[i] = 0.f;
#pragma unroll
    for (int k = 0; k < 2 * HW; ++k) { w[0] += bflo(v[k].x); w[1] += bfhi(v[k].x); w[2] += bflo(v[k].y); w[3] += bfhi(v[k].y); w[4] += bflo(v[k].z); w[5] += bfhi(v[k].z); w[6] += bflo(v[k].w); w[7] += bfhi(v[k].w); }
#pragma unroll
    for (int i = 0; i < 16; ++i) {
        if (i > 0) { const u32x4 a = v[i + 2 * HW - 1], s = v[i - 1];
            w[0] += bflo(a.x) - bflo(s.x); w[1] += bfhi(a.x) - bfhi(s.x); w[2] += bflo(a.y) - bflo(s.y); w[3] += bfhi(a.y) - bfhi(s.y);
            w[4] += bflo(a.z) - bflo(s.z); w[5] += bfhi(a.z) - bfhi(s.z); w[6] += bflo(a.w) - bflo(s.w); w[7] += bfhi(a.w) - bfhi(s.w); }
        const int pos = pos0 + i, lo = pos - HW < 0 ? 0 : pos - HW, hi = pos + HW > SEQL ? SEQL : pos + HW;
        const float ic = 1.f / (float)(hi - lo);
        const u32x4 c = v[HW + i];
        *(u32x4*)(PO + (size_t)(t0 + i) * 512 + c8 * 8) = (u32x4){cvt_pk_bf16(w[0] * ic - bflo(c.x), w[1] * ic - bfhi(c.x)), cvt_pk_bf16(w[2] * ic - bflo(c.y), w[3] * ic - bfhi(c.y)),
                                                                 cvt_pk_bf16(w[4] * ic - bflo(c.z), w[5] * ic - bfhi(c.z)), cvt_pk_bf16(w[6] * ic - bflo(c.w), w[7] * ic - bfhi(c.w))};
    }
}
__device__ __forceinline__ void phase_pool(const Params& p) {
    const bf16_t* P = (const bf16_t*)(p.ws + OFF_PROJ); bf16_t* PO = (bf16_t*)(p.ws + OFF_E);
    int tid = threadIdx.x; asm volatile("" : "+v"(tid));
    const int wid = __builtin_amdgcn_readfirstlane(tid >> 6), lane = tid & 63;
    for (int wi = blockIdx.x * 8 + wid; wi < T_TOK / 16; wi += gridDim.x * 8) {
        const int grp = wi & 3, t0 = (wi >> 2) * 64 + (lane >> 4) * 16, c8 = grp * 16 + (lane & 15);
        if (grp == 0) pool_run<1>(P, PO, t0, c8); else if (grp == 1) pool_run<2>(P, PO, t0, c8); else if (grp == 2) pool_run<4>(P, PO, t0, c8); else pool_run<8>(P, PO, t0, c8);
    }
}

__device__ __forceinline__ void phase_final(const Params& p) {
    int tid = threadIdx.x; asm volatile("" : "+v"(tid));
    const int wid = tid >> 6, lane = tid & 63;
    const float* ssq = (const float*)(p.ws + OFF_SSQ); const bf16_t* xb = (const bf16_t*)(p.ws + OFF_XB);
    f32x4 g4[4];
#pragma unroll
    for (int i = 0; i < 4; ++i) g4[i] = *(const f32x4*)(p.norm_final + lane * 16 + 4 * i);
    for (int row0 = blockIdx.x * 8 + wid; row0 < T_TOK; row0 += gridDim.x * 32) {
        u32x4 v[4][2]; float rs[4]; bool ok[4];
#pragma unroll
        for (int u = 0; u < 4; ++u) { const int row = row0 + u * gridDim.x * 8; ok[u] = row < T_TOK;
            if (ok[u]) { rs[u] = rowscale(ssq, row); const bf16_t* xp = xb + (size_t)row * 1024 + lane * 16; v[u][0] = *(const u32x4*)xp; v[u][1] = *(const u32x4*)(xp + 8); } }
#pragma unroll
        for (int u = 0; u < 4; ++u) if (ok[u]) { const int row = row0 + u * gridDim.x * 8; float* op = p.xf + (size_t)row * 1024 + lane * 16; const float r = rs[u];
            *(f32x4*)(op) = (f32x4){bflo(v[u][0].x), bfhi(v[u][0].x), bflo(v[u][0].y), bfhi(v[u][0].y)} * r * g4[0];
            *(f32x4*)(op + 4) = (f32x4){bflo(v[u][0].z), bfhi(v[u][0].z), bflo(v[u][0].w), bfhi(v[u][0].w)} * r * g4[1];
            *(f32x4*)(op + 8) = (f32x4){bflo(v[u][1].x), bfhi(v[u][1].x), bflo(v[u][1].y), bfhi(v[u][1].y)} * r * g4[2];
            *(f32x4*)(op + 12) = (f32x4){bflo(v[u][1].z), bfhi(v[u][1].z), bflo(v[u][1].w), bfhi(v[u][1].w)} * r * g4[3]; }
    }
}

__device__ __forceinline__ void grid_barrier(unsigned* bar, unsigned k) {
    asm volatile("s_waitcnt vmcnt(0)" ::: "memory");
    __syncthreads();
    if (threadIdx.x == 0) {
        const unsigned nb = gridDim.x, g = blockIdx.x >> 4, ng = (nb + 15u) >> 4, gsz = (nb - 16u * g) < 16u ? (nb - 16u * g) : 16u;
        __builtin_amdgcn_fence(__ATOMIC_RELEASE, "agent");
        asm volatile("s_waitcnt vmcnt(0)" ::: "memory");
        const unsigned old = __hip_atomic_fetch_add(bar + 64 * g, 1u, __ATOMIC_RELAXED, __HIP_MEMORY_SCOPE_AGENT);
        if (old == k * gsz - 1u) {
            const unsigned old2 = __hip_atomic_fetch_add(bar + 64 * 32, 1u, __ATOMIC_RELAXED, __HIP_MEMORY_SCOPE_AGENT);
            if (old2 == k * ng - 1u) for (unsigned j = 0; j < ng; ++j) __hip_atomic_store(bar + 64 * (64 + j), k, __ATOMIC_RELAXED, __HIP_MEMORY_SCOPE_AGENT);
        }
        while (__hip_atomic_load(bar + 64 * (64 + g), __ATOMIC_RELAXED, __HIP_MEMORY_SCOPE_AGENT) < k) __builtin_amdgcn_s_sleep(2);
        __builtin_amdgcn_fence(__ATOMIC_ACQUIRE, "agent");
        asm volatile("s_waitcnt vmcnt(0)" ::: "memory");
    }
    __syncthreads();
}
__global__ void __launch_bounds__(512, 2) mega(const Params p_arg) {
    extern __shared__ __attribute__((aligned(16))) unsigned char shm[];
    LAS unsigned char* lds = (LAS unsigned char*)shm;
    typedef const Params __attribute__((address_space(4))) * KArgPtr;
    const int phase_lo = p_arg.phase_lo, phase_hi = p_arg.phase_hi;
    pg8::StaticOrder S;
    for (int ph = phase_lo; ph < phase_hi; ++ph) {
        KArgPtr kp = (KArgPtr)__builtin_amdgcn_kernarg_segment_ptr(); asm volatile("" : "+s"(kp));
        const Params& p = *(const Params*)kp;
        bf16_t* xb = (bf16_t*)(p.ws + OFF_XB); bf16_t* proj = (bf16_t*)(p.ws + OFF_PROJ); float* ssq = (float*)(p.ws + OFF_SSQ);
        if (ph > phase_lo) {
            if (phase_hi > 1000) cg::this_grid().sync();
            grid_barrier((unsigned*)(p.ws + OFF_BAR), (unsigned)(ph - phase_lo));
        }
        if (ph == 0) { phase_prep(lds, p); continue; }
        if (ph == 19) { phase_final(p); continue; }
        const int layer = (ph - 1) / 9, sub = (ph - 1) % 9;
        const char* W = p.ws + OFF_W + (size_t)layer * SZ_WLAYER;
        switch (sub) {
        case 0: { pg8::Gemm g{xb, (const bf16_t*)(W + WO_A), T_TOK, NA, 1024, 1024}; S.init(g.M, g.N, gridDim.x, blockIdx.x);
                  EpiA e{proj, (bf16_t*)(p.ws + OFF_LR), ssq}; pg8::gemm_phase(lds, g, S, e); } break;
        case 1: gla_pass<true>(lds, p, layer); break;
        case 2: phase_combine(p); break;
        case 3: gla_light(lds, p, layer); break;
        case 4: { pg8::Gemm g{xb, (const bf16_t*)(W + WO_B), T_TOK, NB, 1024, 1024}; S.init(g.M, g.N, gridDim.x, blockIdx.x);
                  EpiGate e{proj, ssq}; pg8::gemm_phase(lds, g, S, e);
                  phase_pool(p); } break;
        case 5: { { pg8::Gemm g{(const bf16_t*)(p.ws + OFF_E), (const bf16_t*)(W + WO_POOL), T_TOK, 1024, 128, 512}; S.init(g.M, g.N, gridDim.x, blockIdx.x);
                    EpiPool e{proj, p.pool_scale + layer * 1024}; pg8::gemm_phase<EpiPool, 256>(lds, g, S, e); }
                  { pg8::Gemm g{proj + 2048, (const bf16_t*)(W + WO_GA), T_TOK, 1024, 1024, PW}; S.init(g.M, g.N, gridDim.x, blockIdx.x);
                    EpiMerge e{proj}; pg8::gemm_phase(lds, g, S, e); } } break;
        case 6: { pg8::Gemm g{proj, (const bf16_t*)(W + WO_OUT), T_TOK, 1024, 1024, PW}; S.init(g.M, g.N, gridDim.x, blockIdx.x);
                  EpiRes e{xb, ssq}; pg8::gemm_phase(lds, g, S, e); } break;
        case 7: { pg8::Gemm g{xb, (const bf16_t*)(W + WO_F1), T_TOK, 2 * DFF, 1024, 1024}; S.init(g.M, g.N, gridDim.x, blockIdx.x);
                  EpiFfn1 e{proj, ssq}; pg8::gemm_phase(lds, g, S, e); } break;
        case 8: { pg8::Gemm g{proj, (const bf16_t*)(W + WO_F2), T_TOK, 1024, DFF, DFF}; S.init(g.M, g.N, gridDim.x, blockIdx.x);
                  EpiRes e{xb, ssq}; pg8::gemm_phase(lds, g, S, e); } break;
        }
    }
}

extern "C" void kernel_launch(void* const* d_in, const int* in_sizes, int n_in, void* d_out, int out_size, void* d_ws, size_t ws_size, hipStream_t stream) {
    (void)in_sizes; (void)n_in; (void)out_size;
    if (ws_size < WS_NEEDED) return;
    Params p{};
    p.x_in = (const float*)d_in[0]; p.norm_mix = (const float*)d_in[1]; p.w_in = (const float*)d_in[2]; p.wdu_f = (const float*)d_in[3]; p.bd_f = (const float*)d_in[4];
    p.wdu_b = (const float*)d_in[5]; p.bd_b = (const float*)d_in[6]; p.gla_norm = (const float*)d_in[7]; p.w_ga = (const float*)d_in[8]; p.w_pool = (const float*)d_in[9];
    p.pool_scale = (const float*)d_in[10]; p.w_out = (const float*)d_in[11]; p.norm_ffn = (const float*)d_in[12]; p.w_f1 = (const float*)d_in[13]; p.w_f2 = (const float*)d_in[14];
    p.norm_final = (const float*)d_in[15];
    p.xf = (float*)d_out; p.ws = (char*)d_ws;
    hipFuncSetAttribute((const void*)mega, hipFuncAttributeMaxDynamicSharedMemorySize, LDS_BYTES);
    int dev = 0, cus = 0, per = 0;
    hipGetDevice(&dev); hipDeviceGetAttribute(&cus, hipDeviceAttributeMultiprocessorCount, dev);
    hipOccupancyMaxActiveBlocksPerMultiprocessor(&per, mega, 512, LDS_BYTES);
    int grid = cus * (per > 0 ? per : 1); if (grid > 256) grid = 256; if (grid < 1) grid = 1;
#if MK_SINGLE_LAUNCH
    p.phase_lo = 0; p.phase_hi = 20;
    hipMemsetAsync((char*)d_ws + OFF_BAR, 0, 128 * 256, stream);
    void* args[] = {(void*)&p};
    hipLaunchCooperativeKernel((const void*)mega, dim3(grid), dim3(512), args, LDS_BYTES, stream);
#else
    for (int ph = 0; ph < 20; ++ph) { p.phase_lo = ph; p.phase_hi = ph + 1; hipLaunchKernelGGL(mega, dim3(grid), dim3(512), LDS_BYTES, stream, p); }
#endif
}
```

```cpp
#include <hip/hip_runtime.h>
#include <hip/hip_cooperative_groups.h>
namespace cg = cooperative_groups;

#ifndef MK_SINGLE_LAUNCH
#define MK_SINGLE_LAUNCH 1
#endif

#define LAS __attribute__((address_space(3)))
typedef unsigned short bf16_t;
typedef short bf16x8 __attribute__((ext_vector_type(8)));
typedef float f32x4 __attribute__((ext_vector_type(4)));
typedef unsigned u32x4 __attribute__((ext_vector_type(4)));
typedef unsigned u32x2 __attribute__((ext_vector_type(2)));

constexpr int T_TOK = 32768, SEQL = 16384, DM = 1024, PW = 3584, NA = 3840, NB = 2048, DFF = 2816, INW = 5664;
constexpr int LDS_BYTES = 155136;

constexpr size_t SZ_WA = (size_t)NA * 1024 * 2, SZ_WB = (size_t)NB * 1024 * 2, SZ_WGA = (size_t)1024 * 1024 * 2, SZ_WPOOL = (size_t)1024 * 512 * 2,
                 SZ_WOUT = (size_t)1024 * 1024 * 2, SZ_WF1 = (size_t)2 * DFF * 1024 * 2, SZ_WF2 = (size_t)1024 * DFF * 2;
constexpr size_t WO_A = 0, WO_B = WO_A + SZ_WA, WO_GA = WO_B + SZ_WB, WO_POOL = WO_GA + SZ_WGA, WO_OUT = WO_POOL + SZ_WPOOL, WO_F1 = WO_OUT + SZ_WOUT,
                 WO_F2 = WO_F1 + SZ_WF1, SZ_WLAYER = WO_F2 + SZ_WF2;
constexpr size_t OFF_W = 0;
constexpr size_t OFF_XB = OFF_W + 2 * SZ_WLAYER;
constexpr size_t OFF_PROJ = OFF_XB + (size_t)T_TOK * 1024 * 2;
constexpr size_t OFF_LR = OFF_PROJ + (size_t)T_TOK * PW * 2;
constexpr size_t OFF_E = OFF_LR + (size_t)T_TOK * 32 * 4;
constexpr size_t OFF_DLOG = OFF_E + (size_t)16 * 32 * 32768 * 4;
constexpr size_t OFF_O = OFF_DLOG + (size_t)16 * 32 * 128 * 4;
constexpr size_t OFF_SSQ = OFF_O + (size_t)T_TOK * 1024 * 2;
constexpr size_t OFF_BAR = OFF_SSQ + (size_t)T_TOK * 16 * 4;
constexpr size_t WS_NEEDED = OFF_BAR + 128 * 256;

struct Params {
    const float* x_in; const float* norm_mix; const float* w_in; const float* wdu_f; const float* bd_f; const float* wdu_b; const float* bd_b;
    const float* gla_norm; const float* w_ga; const float* w_pool; const float* pool_scale; const float* w_out; const float* norm_ffn;
    const float* w_f1; const float* w_f2; const float* norm_final;
    float* xf; char* ws;
    int phase_lo, phase_hi;
};

typedef float f32x2 __attribute__((ext_vector_type(2)));
typedef __bf16 bf16x2_t __attribute__((ext_vector_type(2)));
__device__ __forceinline__ unsigned cvt_pk_bf16(float lo, float hi) { const f32x2 v = {lo, hi}; const bf16x2_t b = __builtin_convertvector(v, bf16x2_t); return __builtin_bit_cast(unsigned, b); }
__device__ __forceinline__ float bf2f(unsigned short b) { return __uint_as_float(((unsigned)b) << 16); }
__device__ __forceinline__ float bflo(unsigned w) { return __uint_as_float(w << 16); }
__device__ __forceinline__ float bfhi(unsigned w) { return __uint_as_float(w & 0xffff0000u); }
__device__ __forceinline__ unsigned short f2bf(float f) { return (unsigned short)(cvt_pk_bf16(f, 0.f) & 0xffffu); }
__device__ __forceinline__ float sigmoidf_(float x) { return __builtin_amdgcn_rcpf(1.f + __expf(-x)); }

namespace pg8 {
constexpr int BM = 256, BK = 64, HALF = 128, HTB = HALF * BK * 2, STAGE_BYTES = 8 * HTB, NXCD = 8, WGM = 8;
__device__ __forceinline__ int lds_byte(int r, int c) { const int st = (r >> 4) * 2 + (c >> 5), rr = r & 15, cc = c & 31, ob = rr * 64 + cc * 2; return st * 1024 + (ob ^ (((ob >> 9) & 1) << 5)); }
__device__ __forceinline__ void stage_rc(int b, int& R, int& C) { const int st = b / 1024, sb = b % 1024, swz = sb ^ (((sb >> 9) & 1) << 5); R = (st >> 1) * 16 + swz / 64; C = (st & 1) * 32 + (swz % 64) / 2; }
__device__ __forceinline__ int perm32(int rho) { const int n = rho >> 4, i = rho & 15; return 8 * (i >> 2) + 4 * n + (i & 3); }
struct Unit { int pm, pn; };
struct Gemm { const bf16_t* A; const bf16_t* Bt; int M, N, K, lda; };
struct StaticOrder {
    int nM, nN, nwg, G, c;
    __device__ void init(int M, int N, int G_, int c_) { nM = M / BM; nN = N / BM; nwg = nM * nN; G = G_; c = c_; }
    __device__ bool next(int i, Unit& u) const {
        const long L = (long)i * G + c; if (L >= nwg) return false;
        int wgid = (int)L; { const int q = nwg / NXCD, r = nwg % NXCD, xcd = wgid % NXCD, off = wgid / NXCD; wgid = (xcd < r ? xcd * (q + 1) : r * (q + 1) + (xcd - r) * q) + off; }
        const int nig = WGM * nN, gid = wgid / nig, fm = gid * WGM, gsz = (nM - fm) < WGM ? (nM - fm) : WGM;
        u.pm = fm + ((wgid % nig) % gsz); u.pn = (wgid % nig) / gsz; return true;
    }
};

template <class Epi, int APN = 0, bool ALIGN_EPI = true, bool SP2 = true>
__device__ __forceinline__ void gemm_phase(LAS unsigned char* lds, const Gemm g, const StaticOrder& S, const Epi& E) {
    int tid = threadIdx.x; asm volatile("" : "+v"(tid));
    const int wid = __builtin_amdgcn_readfirstlane(tid >> 6), lane = tid & 63, wr = wid >> 2, wc = wid & 3, fr = lane & 15, fq = lane >> 4;
    int K = g.K; asm volatile("" : "+s"(K));
    const int nt = K / BK;
    unsigned voffA[2], voffB[2];
#pragma unroll
    for (int i = 0; i < 2; ++i) { int R, C; stage_rc(tid * 16 + i * 8192, R, C); const int Rb = Epi::PERM ? ((R & ~31) + perm32(R & 31)) : R;
        voffA[i] = (unsigned)(R * g.lda + C) * 2u; voffB[i] = (unsigned)(Rb * K + C) * 2u; }
    const size_t kstep = (size_t)(BK * 2);
    const size_t hstepA = (size_t)HALF * g.lda * 2, hstepB = (size_t)HALF * K * 2;
    const size_t tstepA = 2 * hstepA, tstepB = 2 * hstepB;
    const unsigned ldsw = (unsigned)wid * 1024u;
    const int aoff = lds_byte(wr * 64 + fr, fq * 8), boff = lds_byte(wc * 32 + fr, fq * 8);
#define PG8_SA(b, h) (((b) * 2 + (h)) * HTB)
#define PG8_SB(b, h) ((4 + (b) * 2 + (h)) * HTB)
#define PG8_STAGE(bufoff, gbase, voff) do { _Pragma("unroll") for (int _i = 0; _i < 2; ++_i) \
        __builtin_amdgcn_global_load_lds((const unsigned*)((const char*)(gbase) + (voff)[_i]), (LAS unsigned*)(lds + (bufoff) + ldsw + _i * 8192), 16, 0, 0); } while (0)
#define PG8_LDA(dst, b, h) do { _Pragma("unroll") for (int m = 0; m < 4; ++m) _Pragma("unroll") for (int k = 0; k < 2; ++k) dst[m][k] = *(const LAS bf16x8*)(lds + PG8_SA(b, h) + aoff + m * 2048 + k * 1024); } while (0)
#define PG8_LDB(dst, b, h) do { _Pragma("unroll") for (int n = 0; n < 2; ++n) _Pragma("unroll") for (int k = 0; k < 2; ++k) dst[n][k] = *(const LAS bf16x8*)(lds + PG8_SB(b, h) + boff + n * 2048 + k * 1024); } while (0)
#define PG8_MMA(ai, bj, At, Bt) do { __builtin_amdgcn_s_setprio(1); _Pragma("unroll") for (int m = 0; m < 4; ++m) _Pragma("unroll") for (int n = 0; n < 2; ++n) _Pragma("unroll") for (int k = 0; k < 2; ++k) \
        acc[ai][bj][m][n] = __builtin_amdgcn_mfma_f32_16x16x32_bf16(Bt[n][k], At[m][k], acc[ai][bj][m][n], 0, 0, 0); __builtin_amdgcn_s_setprio(0); } while (0)
#define PG8_WAIT_V(n) asm volatile("s_waitcnt vmcnt(" #n ")" ::: "memory")
#define PG8_WAIT_L(n) asm volatile("s_waitcnt lgkmcnt(" #n ")" ::: "memory")
#define PG8_BAR __builtin_amdgcn_s_barrier()
#define PG8_SCHED __builtin_amdgcn_sched_barrier(0)
    Unit cur, nxt; int ui = 0;
    if (!S.next(0, cur)) return;
    f32x4 acc[2][2][4][2];
#pragma unroll
    for (int a = 0; a < 2; ++a)
#pragma unroll
        for (int b = 0; b < 2; ++b)
#pragma unroll
            for (int m = 0; m < 4; ++m)
#pragma unroll
                for (int n = 0; n < 2; ++n) acc[a][b][m][n] = (f32x4){0.f, 0.f, 0.f, 0.f};
    bf16x8 At[4][2], B0[2][2], B1[2][2];
    const char* cA = (const char*)g.A + (size_t)cur.pm * tstepA + (size_t)cur.pn * APN; const char* cB = (const char*)g.Bt + (size_t)cur.pn * tstepB;
    if constexpr (SP2) {
        PG8_STAGE(PG8_SB(0, 0), cB, voffB); PG8_STAGE(PG8_SB(0, 1), cB + hstepB, voffB); PG8_STAGE(PG8_SA(0, 0), cA, voffA); PG8_STAGE(PG8_SA(0, 1), cA + hstepA, voffA);
        if (wr == 1) PG8_BAR;
        PG8_WAIT_V(2); PG8_BAR;
        PG8_STAGE(PG8_SB(1, 0), cB + kstep, voffB); PG8_STAGE(PG8_SA(1, 0), cA + kstep, voffA); PG8_STAGE(PG8_SB(1, 1), cB + hstepB + kstep, voffB);
        PG8_WAIT_V(6); PG8_BAR;
    } else {
        PG8_STAGE(PG8_SB(0, 0), cB, voffB); PG8_STAGE(PG8_SA(0, 0), cA, voffA); PG8_STAGE(PG8_SB(0, 1), cB + hstepB, voffB); PG8_STAGE(PG8_SA(0, 1), cA + hstepA, voffA);
        if (wr == 1) PG8_BAR;
        PG8_WAIT_V(4); PG8_BAR;
        PG8_STAGE(PG8_SB(1, 0), cB + kstep, voffB); PG8_STAGE(PG8_SA(1, 0), cA + kstep, voffA); PG8_STAGE(PG8_SB(1, 1), cB + hstepB + kstep, voffB);
        PG8_WAIT_V(6); PG8_BAR;
    }
    for (;;) {
        const bool has_next = S.next(ui + 1, nxt);
        const char* nA = has_next ? (const char*)g.A + (size_t)nxt.pm * tstepA + (size_t)nxt.pn * APN : cA; const char* nB = has_next ? (const char*)g.Bt + (size_t)nxt.pn * tstepB : cB;
        for (int t = 0; t < nt; t += 2) {
            const bool last = (t == nt - 2);
            const char* a1 = cA + (size_t)(t + 1) * kstep;
            const char* a2 = last ? nA : cA + (size_t)(t + 2) * kstep; const char* b2 = last ? nB : cB + (size_t)(t + 2) * kstep;
            const char* a3 = a2 + kstep; const char* b3 = b2 + kstep;
            if constexpr (SP2) {
            PG8_LDB(B0, 0, 0); PG8_LDB(B1, 0, 1); PG8_SCHED; PG8_LDA(At, 0, 0); PG8_STAGE(PG8_SA(1, 1), a1 + hstepA, voffA);
            PG8_WAIT_V(8); PG8_WAIT_L(0); PG8_BAR; PG8_MMA(0, 0, At, B0); PG8_MMA(0, 1, At, B1); PG8_BAR; PG8_SCHED;
            PG8_LDA(At, 0, 1); PG8_STAGE(PG8_SB(0, 0), b2, voffB); PG8_STAGE(PG8_SB(0, 1), b2 + hstepB, voffB); PG8_STAGE(PG8_SA(0, 0), a2, voffA);
            PG8_WAIT_V(8); PG8_WAIT_L(0); PG8_BAR; PG8_MMA(1, 0, At, B0); PG8_MMA(1, 1, At, B1); PG8_BAR; PG8_SCHED;
            PG8_LDB(B0, 1, 0); PG8_LDB(B1, 1, 1); PG8_SCHED; PG8_LDA(At, 1, 0); PG8_STAGE(PG8_SA(0, 1), a2 + hstepA, voffA);
            PG8_WAIT_V(8); PG8_WAIT_L(0); PG8_BAR; PG8_MMA(0, 0, At, B0); PG8_MMA(0, 1, At, B1); PG8_BAR; PG8_SCHED;
            PG8_LDA(At, 1, 1); PG8_STAGE(PG8_SB(1, 0), b3, voffB); PG8_STAGE(PG8_SB(1, 1), b3 + hstepB, voffB); PG8_STAGE(PG8_SA(1, 0), a3, voffA);
            PG8_WAIT_V(8); PG8_WAIT_L(0); PG8_BAR; PG8_MMA(1, 0, At, B0); PG8_MMA(1, 1, At, B1); PG8_BAR; PG8_SCHED;
            } else {
            PG8_LDB(B0, 0, 0); PG8_SCHED; PG8_LDA(At, 0, 0); PG8_STAGE(PG8_SA(1, 1), a1 + hstepA, voffA);
            PG8_WAIT_L(8); PG8_BAR; PG8_WAIT_L(0); PG8_MMA(0, 0, At, B0); PG8_BAR; PG8_SCHED;
            PG8_LDB(B1, 0, 1); PG8_STAGE(PG8_SB(0, 0), b2, voffB);
            PG8_BAR; PG8_WAIT_L(0); PG8_MMA(0, 1, At, B1); PG8_BAR;
            PG8_LDA(At, 0, 1); PG8_STAGE(PG8_SA(0, 0), a2, voffA);
            PG8_BAR; PG8_WAIT_L(0); PG8_MMA(1, 0, At, B0); PG8_BAR; PG8_SCHED;
            PG8_STAGE(PG8_SB(0, 1), b2 + hstepB, voffB);
            PG8_WAIT_V(6); PG8_BAR; PG8_MMA(1, 1, At, B1); PG8_BAR;
            PG8_LDB(B0, 1, 0); PG8_SCHED; PG8_LDA(At, 1, 0); PG8_STAGE(PG8_SA(0, 1), a2 + hstepA, voffA);
            PG8_WAIT_L(8); PG8_BAR; PG8_WAIT_L(0); PG8_MMA(0, 0, At, B0); PG8_BAR; PG8_SCHED;
            PG8_LDB(B1, 1, 1); PG8_STAGE(PG8_SB(1, 0), b3, voffB);
            PG8_BAR; PG8_WAIT_L(0); PG8_MMA(0, 1, At, B1); PG8_BAR;
            PG8_LDA(At, 1, 1); PG8_STAGE(PG8_SA(1, 0), a3, voffA);
            PG8_BAR; PG8_WAIT_L(0); PG8_MMA(1, 0, At, B0); PG8_BAR; PG8_SCHED;
            PG8_STAGE(PG8_SB(1, 1), b3 + hstepB, voffB);
            PG8_WAIT_V(6); PG8_BAR; PG8_MMA(1, 1, At, B1); PG8_BAR;
            }
        }
        if constexpr (ALIGN_EPI) { if (wr == 0) PG8_BAR; }
        E(acc, cur, wr, wc, fr, fq);
        if (!has_next) break;
#pragma unroll
        for (int a = 0; a < 2; ++a)
#pragma unroll
            for (int b = 0; b < 2; ++b)
#pragma unroll
                for (int m = 0; m < 4; ++m)
#pragma unroll
                    for (int n = 0; n < 2; ++n) acc[a][b][m][n] = (f32x4){0.f, 0.f, 0.f, 0.f};
        cur = nxt; cA = nA; cB = nB; ++ui;
        if constexpr (ALIGN_EPI) { if (wr == 1) PG8_BAR; }
    }
    PG8_WAIT_V(0);
    if constexpr (!ALIGN_EPI) { if (wr == 0) PG8_BAR; }
    PG8_BAR;
#undef PG8_SA
#undef PG8_SB
#undef PG8_STAGE
#undef PG8_LDA
#undef PG8_LDB
#undef PG8_MMA
#undef PG8_WAIT_V
#undef PG8_WAIT_L
#undef PG8_BAR
#undef PG8_SCHED
}
}
using pg8::Unit;

__device__ __forceinline__ float rowscale(const float* ssq, int row) {
    const f32x4* s = (const f32x4*)(ssq + (size_t)row * 16);
    const f32x4 a = s[0], b = s[1], c = s[2], d = s[3];
    const float t = ((a[0] + a[1]) + (a[2] + a[3])) + ((b[0] + b[1]) + (b[2] + b[3])) + ((c[0] + c[1]) + (c[2] + c[3])) + ((d[0] + d[1]) + (d[2] + d[3]));
    return rsqrtf(t * (1.f / 1024.f) + 1e-6f);
}
__device__ __forceinline__ u32x4 pack8(const f32x4 v0, const f32x4 v1) {
    u32x4 w; w.x = cvt_pk_bf16(v0[0], v0[1]); w.y = cvt_pk_bf16(v0[2], v0[3]); w.z = cvt_pk_bf16(v1[0], v1[1]); w.w = cvt_pk_bf16(v1[2], v1[3]); return w;
}

struct EpiA {
    static constexpr bool PERM = true;
    bf16_t* P; bf16_t* lr; const float* ssq;
    __device__ __forceinline__ void operator()(const f32x4 (&acc)[2][2][4][2], const Unit& u, int wr, int wc, int fr, int fq) const {
        const int row0 = u.pm * 256 + wr * 64 + fr;
#pragma unroll
        for (int ai = 0; ai < 2; ++ai)
#pragma unroll
            for (int m = 0; m < 4; ++m) {
                const int row = row0 + ai * 128 + m * 16; const float rs = rowscale(ssq, row);
                if (u.pn < 14) {
#pragma unroll
                    for (int bj = 0; bj < 2; ++bj) {
                        const f32x4 v0 = acc[ai][bj][m][0] * rs, v1 = acc[ai][bj][m][1] * rs;
                        *(u32x4*)(P + (size_t)row * PW + u.pn * 256 + bj * 128 + wc * 32 + 8 * fq) = pack8(v0, v1);
                    }
                } else if (wc == 0) {
                    const f32x4 v0 = acc[ai][0][m][0] * rs, v1 = acc[ai][0][m][1] * rs;
                    const u32x4 hi = pack8(v0, v1);
                    const f32x4 d0 = (f32x4){v0[0] - bflo(hi.x), v0[1] - bfhi(hi.x), v0[2] - bflo(hi.y), v0[3] - bfhi(hi.y)};
                    const f32x4 d1 = (f32x4){v1[0] - bflo(hi.z), v1[1] - bfhi(hi.z), v1[2] - bflo(hi.w), v1[3] - bfhi(hi.w)};
                    bf16_t* lp = lr + (size_t)row * 64 + (fq >> 1) * 32 + (fq & 1) * 8;
                    *(u32x4*)lp = hi; *(u32x4*)(lp + 16) = pack8(d0, d1);
                }
            }
    }
};
struct EpiGate {
    static constexpr bool PERM = true;
    bf16_t* P; const float* ssq;
    __device__ __forceinline__ void operator()(const f32x4 (&acc)[2][2][4][2], const Unit& u, int wr, int wc, int fr, int fq) const {
        const int row0 = u.pm * 256 + wr * 64 + fr;
#pragma unroll
        for (int ai = 0; ai < 2; ++ai)
#pragma unroll
            for (int m = 0; m < 4; ++m) {
                const int row = row0 + ai * 128 + m * 16; const float rs = rowscale(ssq, row);
#pragma unroll
                for (int bj = 0; bj < 2; ++bj) {
                    f32x4 v0 = acc[ai][bj][m][0] * rs, v1 = acc[ai][bj][m][1] * rs;
#pragma unroll
                    for (int j = 0; j < 4; ++j) { v0[j] = sigmoidf_(v0[j]); v1[j] = sigmoidf_(v1[j]); }
                    *(u32x4*)(P + (size_t)row * PW + u.pn * 256 + bj * 128 + wc * 32 + 8 * fq) = pack8(v0, v1);
                }
            }
    }
};
struct EpiPool {
    static constexpr bool PERM = true;
    bf16_t* P; const float* pscale;
    __device__ __forceinline__ void operator()(const f32x4 (&acc)[2][2][4][2], const Unit& u, int wr, int wc, int fr, int fq) const {
        const int row0 = u.pm * 256 + wr * 64 + fr;
#pragma unroll
        for (int bj = 0; bj < 2; ++bj) {
            const int col = u.pn * 256 + bj * 128 + wc * 32 + 8 * fq;
            const f32x4 p0 = *(const f32x4*)(pscale + col), p1 = *(const f32x4*)(pscale + col + 4);
#pragma unroll
            for (int ai = 0; ai < 2; ++ai)
#pragma unroll
                for (int m = 0; m < 4; ++m) {
                    const int row = row0 + ai * 128 + m * 16;
                    bf16_t* ptr = P + (size_t)row * PW + 1024 + col;
                    const u32x4 g = *(const u32x4*)ptr;
                    f32x4 v0 = acc[ai][bj][m][0] * p0, v1 = acc[ai][bj][m][1] * p1;
                    v0[0] *= bflo(g.x); v0[1] *= bfhi(g.x); v0[2] *= bflo(g.y); v0[3] *= bfhi(g.y);
                    v1[0] *= bflo(g.z); v1[1] *= bfhi(g.z); v1[2] *= bflo(g.w); v1[3] *= bfhi(g.w);
                    *(u32x4*)ptr = pack8(v0, v1);
                    if (m & 1) asm volatile("" ::: "memory");
                }
        }
    }
};
struct EpiMerge {
    static constexpr bool PERM = true;
    bf16_t* P;
    __device__ __forceinline__ void operator()(const f32x4 (&acc)[2][2][4][2], const Unit& u, int wr, int wc, int fr, int fq) const {
        const int row0 = u.pm * 256 + wr * 64 + fr;
#pragma unroll
        for (int ai = 0; ai < 2; ++ai)
#pragma unroll
            for (int m = 0; m < 4; ++m) {
                const int row = row0 + ai * 128 + m * 16;
#pragma unroll
                for (int bj = 0; bj < 2; ++bj) {
                    bf16_t* ptr = P + (size_t)row * PW + u.pn * 256 + bj * 128 + wc * 32 + 8 * fq;
                    const u32x4 g = *(const u32x4*)ptr; const u32x4 t = *(const u32x4*)(ptr + 1024);
                    f32x4 v0 = acc[ai][bj][m][0], v1 = acc[ai][bj][m][1];
                    v0[0] = v0[0] * bflo(g.x) + bflo(t.x); v0[1] = v0[1] * bfhi(g.x) + bfhi(t.x); v0[2] = v0[2] * bflo(g.y) + bflo(t.y); v0[3] = v0[3] * bfhi(g.y) + bfhi(t.y);
                    v1[0] = v1[0] * bflo(g.z) + bflo(t.z); v1[1] = v1[1] * bfhi(g.z) + bfhi(t.z); v1[2] = v1[2] * bflo(g.w) + bflo(t.w); v1[3] = v1[3] * bfhi(g.w) + bfhi(t.w);
                    *(u32x4*)ptr = pack8(v0, v1);
                }
                asm volatile("" ::: "memory");
            }
    }
};
struct EpiRes {
    static constexpr bool PERM = true;
    bf16_t* xb; float* ssq;
    __device__ __forceinline__ void operator()(const f32x4 (&acc)[2][2][4][2], const Unit& u, int wr, int wc, int fr, int fq) const {
        const int row0 = u.pm * 256 + wr * 64 + fr;
#pragma unroll
        for (int ai = 0; ai < 2; ++ai)
#pragma unroll
            for (int m = 0; m < 4; ++m) {
                const int row = row0 + ai * 128 + m * 16; float s = 0.f;
#pragma unroll
                for (int bj = 0; bj < 2; ++bj) {
                    bf16_t* ptr = xb + (size_t)row * 1024 + u.pn * 256 + bj * 128 + wc * 32 + 8 * fq;
                    const u32x4 g = *(const u32x4*)ptr;
                    f32x4 v0 = acc[ai][bj][m][0], v1 = acc[ai][bj][m][1];
                    v0[0] += bflo(g.x); v0[1] += bfhi(g.x); v0[2] += bflo(g.y); v0[3] += bfhi(g.y);
                    v1[0] += bflo(g.z); v1[1] += bfhi(g.z); v1[2] += bflo(g.w); v1[3] += bfhi(g.w);
                    *(u32x4*)ptr = pack8(v0, v1);
                    s += (v0[0] * v0[0] + v0[1] * v0[1]) + (v0[2] * v0[2] + v0[3] * v0[3]) + (v1[0] * v1[0] + v1[1] * v1[1]) + (v1[2] * v1[2] + v1[3] * v1[3]);
                }
                s += __shfl_xor(s, 16); s += __shfl_xor(s, 32);
                if (fq == 0) ssq[(size_t)row * 16 + u.pn * 4 + wc] = s;
            }
    }
};
struct EpiFfn1 {
    static constexpr bool PERM = true;
    bf16_t* ACT; const float* ssq;
    __device__ __forceinline__ void operator()(const f32x4 (&acc)[2][2][4][2], const Unit& u, int wr, int wc, int fr, int fq) const {
        const int row0 = u.pm * 256 + wr * 64 + fr;
#pragma unroll
        for (int ai = 0; ai < 2; ++ai)
#pragma unroll
            for (int m = 0; m < 4; ++m) {
                const int row = row0 + ai * 128 + m * 16; const float rs = rowscale(ssq, row);
                f32x4 o[2];
#pragma unroll
                for (int n = 0; n < 2; ++n)
#pragma unroll
                    for (int j = 0; j < 4; ++j) { const float gt = acc[ai][0][m][n][j] * rs, up = acc[ai][1][m][n][j] * rs; o[n][j] = gt * sigmoidf_(gt) * up; }
                *(u32x4*)(ACT + (size_t)row * DFF + u.pn * 128 + wc * 32 + 8 * fq) = pack8(o[0], o[1]);
            }
    }
};

struct WJob { const float* src; const float* g; bf16_t* dst; int ld, ldd, vlo, vhi, kw; };
__device__ __forceinline__ WJob wjob_decode(const Params& p, int layer, int j) {
    WJob w; w.g = nullptr; w.vlo = 0; w.vhi = 256; w.kw = 256;
    bf16_t* W = (bf16_t*)(p.ws + OFF_W + (size_t)layer * SZ_WLAYER);
    if (j < 480) { const int nb = j >> 2, kb = j & 3, n0 = nb * 32; int c0;
        if (n0 < 3072) c0 = n0; else if (n0 < 3584) c0 = 3104 + (n0 - 3072); else if (n0 == 3584) c0 = 3072; else { c0 = 0; w.vhi = 0; }
        w.src = p.w_in + (size_t)layer * 1024 * INW + (size_t)kb * 256 * INW + c0; w.ld = INW; w.g = p.norm_mix + layer * 1024 + kb * 256;
        w.dst = (bf16_t*)((char*)W + WO_A) + (size_t)n0 * 1024 + kb * 256; w.ldd = 1024; return w; }
    j -= 480;
    if (j < 256) { const int nb = j >> 2, kb = j & 3, n0 = nb * 32;
        w.src = p.w_in + (size_t)layer * 1024 * INW + (size_t)kb * 256 * INW + 3616 + n0; w.ld = INW; w.g = p.norm_mix + layer * 1024 + kb * 256;
        w.dst = (bf16_t*)((char*)W + WO_B) + (size_t)n0 * 1024 + kb * 256; w.ldd = 1024; return w; }
    j -= 256;
    if (j < 128) { const int nb = j >> 2, kb = j & 3, n0 = nb * 32;
        w.src = p.w_ga + (size_t)layer * 1024 * 1024 + (size_t)kb * 256 * 1024 + n0; w.ld = 1024;
        w.dst = (bf16_t*)((char*)W + WO_GA) + (size_t)n0 * 1024 + kb * 256; w.ldd = 1024; return w; }
    j -= 128;
    if (j < 64) { const int nb = j >> 1, kb = j & 1, n0 = nb * 32, grp = n0 >> 8;
        w.src = p.w_pool + (size_t)layer * 4 * 128 * 256 + (size_t)grp * 128 * 256 + (n0 & 255); w.ld = 256;
        w.vlo = 0; w.vhi = kb == 0 ? 128 : 0; w.kw = kb == 0 ? 128 : 0;
        w.dst = (bf16_t*)((char*)W + WO_POOL) + (size_t)n0 * 128; w.ldd = 128; return w; }
    j -= 64;
    if (j < 128) { const int nb = j >> 2, kb = j & 3, n0 = nb * 32;
        w.src = p.w_out + (size_t)layer * 1024 * 1024 + (size_t)kb * 256 * 1024 + n0; w.ld = 1024;
        w.dst = (bf16_t*)((char*)W + WO_OUT) + (size_t)n0 * 1024 + kb * 256; w.ldd = 1024; return w; }
    j -= 128;
    if (j < 704) { const int nb = j >> 2, kb = j & 3, n0 = nb * 32, pn = n0 >> 8, within = n0 & 255;
        const int c0 = within < 128 ? 128 * pn + within : DFF + 128 * pn + (within - 128);
        w.src = p.w_f1 + (size_t)layer * 1024 * 2 * DFF + (size_t)kb * 256 * 2 * DFF + c0; w.ld = 2 * DFF; w.g = p.norm_ffn + layer * 1024 + kb * 256;
        w.dst = (bf16_t*)((char*)W + WO_F1) + (size_t)n0 * 1024 + kb * 256; w.ldd = 1024; return w; }
    j -= 704;
    { const int nb = j / 11, kb = j % 11, n0 = nb * 32;
        w.src = p.w_f2 + (size_t)layer * DFF * 1024 + (size_t)kb * 256 * 1024 + n0; w.ld = 1024;
        w.dst = (bf16_t*)((char*)W + WO_F2) + (size_t)n0 * DFF + kb * 256; w.ldd = DFF; return w; }
}

__device__ __forceinline__ void phase_prep(LAS unsigned char* lds, const Params& p) {
    int tid = threadIdx.x; asm volatile("" : "+v"(tid));
    const int wid = tid >> 6, lane = tid & 63;
    for (int job = blockIdx.x; job < 2 * 2112; job += gridDim.x) {
        const int layer = job / 2112; const WJob w = wjob_decode(p, layer, job % 2112);
#pragma unroll
        for (int ps = 0; ps < 4; ++ps) {
            const int kk = (tid >> 3) + 64 * ps, c4 = (tid & 7) * 4;
            f32x4 v = (f32x4){0.f, 0.f, 0.f, 0.f};
            if (kk >= w.vlo && kk < w.vhi) { v = *(const f32x4*)(w.src + (size_t)kk * w.ld + c4); if (w.g) v = v * w.g[kk]; }
#pragma unroll
            for (int e = 0; e < 4; ++e) *(LAS float*)(lds + (kk * 33 + c4 + e) * 4) = v[e];
        }
        __syncthreads();
        { const int n = tid & 31, s = tid >> 5; unsigned pk[8];
#pragma unroll
            for (int e = 0; e < 8; ++e) { const float a = *(LAS float*)(lds + ((s * 16 + 2 * e) * 33 + n) * 4), b = *(LAS float*)(lds + ((s * 16 + 2 * e + 1) * 33 + n) * 4); pk[e] = cvt_pk_bf16(a, b); }
            bf16_t* d = w.dst + (size_t)n * w.ldd + s * 16;
            if (s * 16 < w.kw) { *(u32x4*)d = (u32x4){pk[0], pk[1], pk[2], pk[3]}; *(u32x4*)(d + 8) = (u32x4){pk[4], pk[5], pk[6], pk[7]}; } }
        __syncthreads();
    }
    bf16_t* xb = (bf16_t*)(p.ws + OFF_XB); float* ssq = (float*)(p.ws + OFF_SSQ);
    for (int row0 = blockIdx.x * 8 + wid; row0 < T_TOK; row0 += gridDim.x * 16) {
        f32x4 v[2][4]; bool ok[2];
#pragma unroll
        for (int u = 0; u < 2; ++u) { const int row = row0 + u * gridDim.x * 8; ok[u] = row < T_TOK;
            if (ok[u]) { const float* src = p.x_in + (size_t)row * 1024 + lane * 16;
#pragma unroll
                for (int i = 0; i < 4; ++i) v[u][i] = *(const f32x4*)(src + 4 * i); } }
#pragma unroll
        for (int u = 0; u < 2; ++u) if (ok[u]) { const int row = row0 + u * gridDim.x * 8;
            float s = 0.f;
#pragma unroll
            for (int i = 0; i < 4; ++i) s += (v[u][i][0] * v[u][i][0] + v[u][i][1] * v[u][i][1]) + (v[u][i][2] * v[u][i][2] + v[u][i][3] * v[u][i][3]);
#pragma unroll
            for (int o = 32; o >= 1; o >>= 1) s += __shfl_xor(s, o);
            bf16_t* dst = xb + (size_t)row * 1024 + lane * 16;
            *(u32x4*)dst = pack8(v[u][0], v[u][1]); *(u32x4*)(dst + 8) = pack8(v[u][2], v[u][3]);
            if (lane < 16) ssq[(size_t)row * 16 + lane] = lane == 0 ? s : 0.f; }
    }
}

#define MFMA16(a, b, c) __builtin_amdgcn_mfma_f32_16x16x32_bf16((a), (b), (c), 0, 0, 0)
template <bool PASS2>
__device__ __forceinline__ void gla_pass(LAS unsigned char* lds, const Params& p, int layer) {
    constexpr int SQ = 0, SKD = 17408, SV = 35840, SP = 69632, SLR = 78848, SDEC = 84992, SST = 85504, SK = SST, SX = SST + 17408, SCOL = SST + 51200;
    int tid = threadIdx.x; asm volatile("" : "+v"(tid));
    const int wid = __builtin_amdgcn_readfirstlane(tid >> 6), lane = tid & 63, fr = lane & 15, fq = lane >> 4;
    const int dk0 = (tid & 63) * 2;
    bf16_t* P = (bf16_t*)(p.ws + OFF_PROJ);
    const bf16_t* LR = (const bf16_t*)(p.ws + OFF_LR);
    bf16_t* E = (bf16_t*)(p.ws + OFF_E);
    bf16_t* QT = (bf16_t*)(p.ws + OFF_E + (size_t)32 * 1024 * 1024);
    float* DL = (float*)(p.ws + OFF_DLOG);
    bf16_t* O = (bf16_t*)(p.ws + OFF_O);
    for (int item = blockIdx.x; item < 256; item += gridDim.x) {
        const int b = item >> 7, h = (item >> 5) & 3, grp = item & 31;
#pragma unroll 1
        for (int dir = 0; dir < 2; ++dir) {
            const int scan = (b * 4 + h) * 2 + dir;
            bf16x8 wB1, wB2; float biasx;
            { const float* Wc = (dir ? p.wdu_b : p.wdu_f) + (size_t)layer * 16 * 512 + h * 128 + wid * 16 + fr;
              float wv[8]; unsigned h1[4], h2[4];
#pragma unroll
              for (int j = 0; j < 8; ++j) wv[j] = Wc[((fq & 1) * 8 + j) * 512];
#pragma unroll
              for (int jp = 0; jp < 4; ++jp) { const float a = wv[2 * jp], bq = wv[2 * jp + 1]; const unsigned hi = cvt_pk_bf16(a, bq);
                  const unsigned lo = cvt_pk_bf16(a - bflo(hi), bq - bfhi(hi)); h1[jp] = hi; h2[jp] = fq < 2 ? lo : 0u; }
              wB1 = __builtin_bit_cast(bf16x8, (u32x4){h1[0], h1[1], h1[2], h1[3]}); wB2 = __builtin_bit_cast(bf16x8, (u32x4){h2[0], h2[1], h2[2], h2[3]});
              biasx = (dir ? p.bd_b : p.bd_f)[layer * 512 + h * 128 + wid * 16 + fr]; }
            f32x4 accS[8][2];
            bf16_t* Eit = E + (size_t)(scan * 32 + grp) * 32768 + (size_t)(wid * 32 + fr) * 128 + 4 * fq;
#pragma unroll
            for (int m8 = 0; m8 < 8; ++m8)
#pragma unroll
                for (int n = 0; n < 2; ++n) accS[m8][n] = (f32x4){0.f, 0.f, 0.f, 0.f};
            float gtot0 = 0.f, gtot1 = 0.f;
            u32x4 rk[2], rq[2], rv[4]; u32x4 rl = (u32x4){0u, 0u, 0u, 0u};
#define GLA_ISSUE(CC) do { const int chunk_ = dir ? 7 - (CC) : (CC); const int t0_ = b * SEQL + grp * 512 + chunk_ * 64; \
                _Pragma("unroll") for (int it = 0; it < 2; ++it) { const int pi = tid + 512 * it, row = pi >> 4, seg = pi & 15; \
                    const bf16_t* src = P + (size_t)(t0_ + row) * PW + h * 128 + seg * 8; rk[it] = *(const u32x4*)(src + 512); } \
                if (tid < 256) { const int row = tid >> 2, seg = tid & 3; rl = *(const u32x4*)(LR + (size_t)(t0_ + row) * 64 + dir * 32 + seg * 8); } } while (0)
            GLA_ISSUE(0);
#pragma unroll 1
            for (int cc = 0; cc < 8; ++cc) {
                const int chunk = dir ? 7 - cc : cc;
                const int t0 = b * SEQL + grp * 512 + chunk * 64;
#pragma unroll
                for (int it = 0; it < 2; ++it) { const int pi = tid + 512 * it, row = pi >> 4, seg = pi & 15;
                    *(LAS u32x4*)(lds + SK + row * 272 + seg * 16) = rk[it];
                    if (PASS2) rq[it] = *(const u32x4*)(P + (size_t)(t0 + row) * PW + h * 128 + seg * 8); }
#pragma unroll
                for (int it = 0; it < 4; ++it) { const int pi = tid + 512 * it, row = pi >> 5, seg = pi & 31;
                    rv[it] = *(const u32x4*)(P + (size_t)(t0 + row) * PW + 1024 + h * 256 + seg * 8); }
                if (tid < 256) { const int row = tid >> 2, seg = tid & 3; *(LAS u32x4*)(lds + SLR + row * 64 + seg * 16) = rl; }
                __syncthreads();
#pragma unroll 1
                for (int m = 0; m < 4; ++m) {
                    const bf16x8 A = *(LAS bf16x8*)(lds + SLR + (m * 16 + fr) * 64 + fq * 16);
                    f32x4 xx = (f32x4){0.f, 0.f, 0.f, 0.f};
                    xx = MFMA16(A, wB1, xx); xx = MFMA16(A, wB2, xx);
#pragma unroll
                    for (int jj = 0; jj < 4; ++jj) { const float x = xx[jj] + biasx; const float ls = fminf(x, 0.f) - __logf(1.f + __expf(-fabsf(x)));
                        *(LAS float*)(lds + SX + ((m * 16 + 4 * fq + jj) * 132 + wid * 16 + fr) * 4) = ls * 0.0625f; }
                }
                if (PASS2) {
#pragma unroll
                    for (int it = 0; it < 2; ++it) { const int pi = tid + 512 * it, row = pi >> 4, seg = pi & 15; *(LAS u32x4*)(lds + SQ + row * 272 + seg * 16) = rq[it]; } }
                __syncthreads();
                float c0[8], c1[8];
#pragma unroll
                for (int e = 0; e < 8; ++e) { const f32x2 t2 = *(LAS f32x2*)(lds + SX + ((wid * 8 + e) * 132 + dk0) * 4); c0[e] = t2.x; c1[e] = t2.y; }
                if (dir == 0) {
#pragma unroll
                    for (int e = 1; e < 8; ++e) { c0[e] += c0[e - 1]; c1[e] += c1[e - 1]; }
                } else {
#pragma unroll
                    for (int e = 6; e >= 0; --e) { c0[e] += c0[e + 1]; c1[e] += c1[e + 1]; }
                }
                { f32x2 t2; t2.x = dir == 0 ? c0[7] : c0[0]; t2.y = dir == 0 ? c1[7] : c1[0]; *(LAS f32x2*)(lds + SCOL + (wid * 128 + dk0) * 4) = t2; }
                __syncthreads();
                float tot0 = 0.f, tot1 = 0.f, offs0 = 0.f, offs1 = 0.f;
#pragma unroll
                for (int s = 0; s < 8; ++s) { const f32x2 t2 = *(LAS f32x2*)(lds + SCOL + (s * 128 + dk0) * 4); tot0 += t2.x; tot1 += t2.y;
                    const bool inc = dir == 0 ? (s < wid) : (s > wid); offs0 += inc ? t2.x : 0.f; offs1 += inc ? t2.y : 0.f; }
                const float etot0 = __expf(tot0), etot1 = __expf(tot1), eg0 = __expf(gtot0), eg1 = __expf(gtot1);
                unsigned kd0p[4], kd1p[4]; float kd0prev = 0.f, kd1prev = 0.f;
#pragma unroll
                for (int e = 0; e < 8; ++e) { const int i = wid * 8 + e;
                    const float ec0 = __expf(c0[e] + offs0), ec1 = __expf(c1[e] + offs1), inv0 = __builtin_amdgcn_rcpf(ec0), inv1 = __builtin_amdgcn_rcpf(ec1);
                    const unsigned kw = *(LAS unsigned*)(lds + SK + i * 272 + dk0 * 2);
                    const float k0 = bflo(kw), k1 = bfhi(kw);
                    const float kd0 = k0 * (etot0 * inv0), kd1 = k1 * (etot1 * inv1);
                    if (PASS2) { const unsigned qw = *(LAS unsigned*)(lds + SQ + i * 272 + dk0 * 2);
                        const float qe0 = bflo(qw) * 0.08838834764831845f * ec0, qe1 = bfhi(qw) * 0.08838834764831845f * ec1;
                        *(LAS unsigned*)(lds + SQ + i * 272 + dk0 * 2) = cvt_pk_bf16(qe0, qe1);
                        const unsigned qt = cvt_pk_bf16(qe0 * eg0, qe1 * eg1);
                        if (dir == 0) *(unsigned*)(QT + (size_t)(t0 + i) * 512 + h * 128 + dk0) = qt; else *(unsigned*)(P + (size_t)(t0 + i) * PW + h * 128 + dk0) = qt;
                        *(LAS unsigned*)(lds + SK + i * 272 + dk0 * 2) = cvt_pk_bf16(k0 * inv0, k1 * inv1); }
                    if (e & 1) { kd0p[e >> 1] = cvt_pk_bf16(kd0prev, kd0); kd1p[e >> 1] = cvt_pk_bf16(kd1prev, kd1); } else { kd0prev = kd0; kd1prev = kd1; } }
                *(LAS u32x4*)(lds + SKD + dk0 * 144 + wid * 16) = (u32x4){kd0p[0], kd0p[1], kd0p[2], kd0p[3]};
                *(LAS u32x4*)(lds + SKD + (dk0 + 1) * 144 + wid * 16) = (u32x4){kd1p[0], kd1p[1], kd1p[2], kd1p[3]};
                if (wid == 0) { f32x2 t2; t2.x = etot0; t2.y = etot1; *(LAS f32x2*)(lds + SDEC + dk0 * 4) = t2; }
                gtot0 += tot0; gtot1 += tot1;
#pragma unroll
                for (int it = 0; it < 4; ++it) { const int pi = tid + 512 * it, row = pi >> 5, seg = pi & 31;
                    *(LAS u32x4*)(lds + SV + row * 528 + seg * 16) = rv[it]; }
                __syncthreads();
                if (PASS2) {
                    f32x4 accP[2];
#pragma unroll
                    for (int s = 0; s < 2; ++s) { const int tt = wid * 2 + s, ib = tt >> 2, jb = tt & 3; f32x4 a = (f32x4){0.f, 0.f, 0.f, 0.f};
#pragma unroll
                        for (int kb = 0; kb < 4; ++kb) { const bf16x8 A = *(LAS bf16x8*)(lds + SK + (jb * 16 + fr) * 272 + (kb * 32 + fq * 8) * 2);
                            const bf16x8 B = *(LAS bf16x8*)(lds + SQ + (ib * 16 + fr) * 272 + (kb * 32 + fq * 8) * 2); a = MFMA16(A, B, a); }
                        accP[s] = a; }
                    __syncthreads();
#pragma unroll
                    for (int s = 0; s < 2; ++s) { const int tt = wid * 2 + s, ib = tt >> 2, jb = tt & 3; const int i = ib * 16 + fr, jbase = jb * 16 + 4 * fq; float v[4];
#pragma unroll
                        for (int jj = 0; jj < 4; ++jj) { const int j = jbase + jj; const bool keep = dir == 0 ? (j <= i) : (j > i); v[jj] = keep ? accP[s][jj] : 0.f; }
                        *(LAS u32x2*)(lds + SP + i * 144 + jbase * 2) = (u32x2){cvt_pk_bf16(v[0], v[1]), cvt_pk_bf16(v[2], v[3])}; }
#pragma unroll
                    for (int m8 = 0; m8 < 8; ++m8)
#pragma unroll
                        for (int n = 0; n < 2; ++n) { const f32x4 sv = accS[m8][n];
                            *(LAS u32x2*)(lds + SST + (wid * 32 + n * 16 + fr) * 272 + (m8 * 16 + 4 * fq) * 2) = (u32x2){cvt_pk_bf16(sv[0], sv[1]), cvt_pk_bf16(sv[2], sv[3])}; }
                    __syncthreads();
                }
                bf16x8 vf[2][2];
#pragma unroll
                for (int n = 0; n < 2; ++n)
#pragma unroll
                    for (int kb2 = 0; kb2 < 2; ++kb2) { unsigned w[4];
#pragma unroll
                        for (int jp = 0; jp < 4; ++jp) { const unsigned lo = *(LAS unsigned short*)(lds + SV + (kb2 * 32 + fq * 8 + 2 * jp) * 528 + (wid * 32 + n * 16 + fr) * 2);
                            const unsigned hi = *(LAS unsigned short*)(lds + SV + (kb2 * 32 + fq * 8 + 2 * jp + 1) * 528 + (wid * 32 + n * 16 + fr) * 2); w[jp] = lo | (hi << 16); }
                        vf[n][kb2] = __builtin_bit_cast(bf16x8, (u32x4){w[0], w[1], w[2], w[3]}); }
                if (PASS2) {
#pragma unroll
                    for (int n = 0; n < 2; ++n) {
                        f32x4 accO[4];
#pragma unroll
                        for (int m = 0; m < 4; ++m) accO[m] = (f32x4){0.f, 0.f, 0.f, 0.f};
#pragma unroll
                        for (int kb = 0; kb < 4; ++kb) { const bf16x8 A = *(LAS bf16x8*)(lds + SST + (wid * 32 + n * 16 + fr) * 272 + (kb * 32 + fq * 8) * 2);
#pragma unroll
                            for (int m = 0; m < 4; ++m) { const bf16x8 B = *(LAS bf16x8*)(lds + SQ + (m * 16 + fr) * 272 + (kb * 32 + fq * 8) * 2); accO[m] = MFMA16(A, B, accO[m]); } }
#pragma unroll
                        for (int kb2 = 0; kb2 < 2; ++kb2)
#pragma unroll
                            for (int m = 0; m < 4; ++m) { const bf16x8 B = *(LAS bf16x8*)(lds + SP + (m * 16 + fr) * 144 + (kb2 * 32 + fq * 8) * 2); accO[m] = MFMA16(vf[n][kb2], B, accO[m]); }
#pragma unroll
                        for (int m = 0; m < 4; ++m) { bf16_t* dst = O + (size_t)(t0 + m * 16 + fr) * 1024 + h * 256 + wid * 32 + n * 16 + 4 * fq; f32x4 v = accO[m];
                            if (dir) { const u32x2 old = *(const u32x2*)dst; v[0] += bflo(old.x); v[1] += bfhi(old.x); v[2] += bflo(old.y); v[3] += bfhi(old.y); }
                            *(u32x2*)dst = (u32x2){cvt_pk_bf16(v[0], v[1]), cvt_pk_bf16(v[2], v[3])}; }
                        asm volatile("" ::: "memory");
                    }
                }
                if (cc < 7) GLA_ISSUE(cc + 1);
#pragma unroll
                for (int m8 = 0; m8 < 8; ++m8) { const f32x4 d = *(LAS f32x4*)(lds + SDEC + (m8 * 16 + 4 * fq) * 4);
#pragma unroll
                    for (int n = 0; n < 2; ++n) accS[m8][n] = accS[m8][n] * d;
#pragma unroll
                    for (int kb2 = 0; kb2 < 2; ++kb2) { const bf16x8 A = *(LAS bf16x8*)(lds + SKD + (m8 * 16 + fr) * 144 + (kb2 * 32 + fq * 8) * 2);
#pragma unroll
                        for (int n = 0; n < 2; ++n) accS[m8][n] = MFMA16(A, vf[n][kb2], accS[m8][n]); } }
                __syncthreads();
            }
            {
#pragma unroll
                for (int m8 = 0; m8 < 8; ++m8)
#pragma unroll
                    for (int n = 0; n < 2; ++n)
                        *(u32x2*)(Eit + n * 16 * 128 + m8 * 16) = (u32x2){cvt_pk_bf16(accS[m8][n][0], accS[m8][n][1]), cvt_pk_bf16(accS[m8][n][2], accS[m8][n][3])};
                if (wid == 0) { DL[(scan * 32 + grp) * 128 + dk0] = gtot0; DL[(scan * 32 + grp) * 128 + dk0 + 1] = gtot1; }
            }
        }
    }
}

#undef GLA_ISSUE
__device__ __forceinline__ void phase_combine(const Params& p) {
    bf16_t* E = (bf16_t*)(p.ws + OFF_E); const float* DL = (const float*)(p.ws + OFF_DLOG);
    int tid = threadIdx.x; asm volatile("" : "+v"(tid));
    for (int idx = blockIdx.x * 512 + tid; idx < 16 * 4096; idx += gridDim.x * 512) {
        const int scan = idx >> 12, e8 = idx & 4095, dk0 = (e8 & 15) * 8, dir = scan & 1;
        float R[8];
#pragma unroll
        for (int i = 0; i < 8; ++i) R[i] = 0.f;
#pragma unroll 1
        for (int q4 = 0; q4 < 4; ++q4) {
            u32x4 ev[8]; f32x4 d0[8], d1[8];
#pragma unroll
            for (int gg = 0; gg < 8; ++gg) { const int go = q4 * 8 + gg, g = dir ? 31 - go : go;
                ev[gg] = *(const u32x4*)(E + (size_t)(scan * 32 + g) * 32768 + e8 * 8);
                d0[gg] = *(const f32x4*)(DL + (scan * 32 + g) * 128 + dk0); d1[gg] = *(const f32x4*)(DL + (scan * 32 + g) * 128 + dk0 + 4); }
#pragma unroll
            for (int gg = 0; gg < 8; ++gg) { const int go = q4 * 8 + gg, g = dir ? 31 - go : go;
                *(u32x4*)(E + (size_t)(scan * 32 + g) * 32768 + e8 * 8) = (u32x4){cvt_pk_bf16(R[0], R[1]), cvt_pk_bf16(R[2], R[3]), cvt_pk_bf16(R[4], R[5]), cvt_pk_bf16(R[6], R[7])};
                const u32x4 w = ev[gg];
                R[0] = R[0] * __expf(d0[gg][0]) + bflo(w.x); R[1] = R[1] * __expf(d0[gg][1]) + bfhi(w.x); R[2] = R[2] * __expf(d0[gg][2]) + bflo(w.y); R[3] = R[3] * __expf(d0[gg][3]) + bfhi(w.y);
                R[4] = R[4] * __expf(d1[gg][0]) + bflo(w.z); R[5] = R[5] * __expf(d1[gg][1]) + bfhi(w.z); R[6] = R[6] * __expf(d1[gg][2]) + bflo(w.w); R[7] = R[7] * __expf(d1[gg][3]) + bfhi(w.w); }
        }
    }
}

__device__ __forceinline__ void gla_light(LAS unsigned char* lds, const Params& p, int layer) {
    constexpr int SSTF = 0, SSTB = 69632, SSS = 139264;
    int tid = threadIdx.x; asm volatile("" : "+v"(tid));
    const int wid = __builtin_amdgcn_readfirstlane(tid >> 6), lane = tid & 63, fr = lane & 15, fq = lane >> 4, mt = wid & 3, hv = wid >> 2;
    bf16_t* P = (bf16_t*)(p.ws + OFF_PROJ);
    const bf16_t* E = (const bf16_t*)(p.ws + OFF_E);
    const bf16_t* QT = (const bf16_t*)(p.ws + OFF_E + (size_t)32 * 1024 * 1024);
    const bf16_t* O = (const bf16_t*)(p.ws + OFF_O);
    for (int item = blockIdx.x; item < 256; item += gridDim.x) {
        const int b = item >> 7, h = (item >> 5) & 3, grp = item & 31;
        const int scanf = (b * 4 + h) * 2;
        __syncthreads();
#pragma unroll
        for (int it = 0; it < 8; ++it) { const int pi = tid + 512 * it, row = pi >> 4, seg = pi & 15;
            const u32x4 vf_ = *(const u32x4*)(E + (size_t)(scanf * 32 + grp) * 32768 + row * 128 + seg * 8);
            const u32x4 vb_ = *(const u32x4*)(E + (size_t)((scanf + 1) * 32 + grp) * 32768 + row * 128 + seg * 8);
            *(LAS u32x4*)(lds + SSTF + row * 272 + seg * 16) = vf_; *(LAS u32x4*)(lds + SSTB + row * 272 + seg * 16) = vb_; }
        __syncthreads();
        f32x4 gn[8];
#pragma unroll
        for (int n = 0; n < 8; ++n) gn[n] = *(const f32x4*)(p.gla_norm + layer * 1024 + h * 256 + hv * 128 + n * 16 + 4 * fq);
#pragma unroll 1
        for (int cc = 0; cc < 8; ++cc) {
            const size_t tok = (size_t)(b * SEQL + grp * 512 + cc * 64 + mt * 16 + fr);
            bf16x8 bq[2][4];
#pragma unroll
            for (int kb = 0; kb < 4; ++kb) { bq[0][kb] = *(const bf16x8*)(QT + tok * 512 + h * 128 + kb * 32 + fq * 8); bq[1][kb] = *(const bf16x8*)(P + tok * PW + h * 128 + kb * 32 + fq * 8); }
            u32x2 oo[8], rr[8];
#pragma unroll
            for (int n = 0; n < 8; ++n) { oo[n] = *(const u32x2*)(O + tok * 1024 + h * 256 + hv * 128 + n * 16 + 4 * fq);
                rr[n] = *(const u32x2*)(P + tok * PW + 2048 + h * 256 + hv * 128 + n * 16 + 4 * fq); }
            f32x4 accO[8];
#pragma unroll
            for (int n = 0; n < 8; ++n) accO[n] = (f32x4){0.f, 0.f, 0.f, 0.f};
#pragma unroll
            for (int dir = 0; dir < 2; ++dir)
#pragma unroll
                for (int kb = 0; kb < 4; ++kb)
#pragma unroll
                    for (int n = 0; n < 8; ++n) { const bf16x8 A = *(LAS bf16x8*)(lds + (dir ? SSTB : SSTF) + (hv * 128 + n * 16 + fr) * 272 + (kb * 32 + fq * 8) * 2);
                        accO[n] = MFMA16(A, bq[dir][kb], accO[n]); }
            float s = 0.f;
#pragma unroll
            for (int n = 0; n < 8; ++n) { f32x4 v = accO[n]; v[0] += bflo(oo[n].x); v[1] += bfhi(oo[n].x); v[2] += bflo(oo[n].y); v[3] += bfhi(oo[n].y); accO[n] = v;
                s += (v[0] * v[0] + v[1] * v[1]) + (v[2] * v[2] + v[3] * v[3]); }
            s += __shfl_xor(s, 16); s += __shfl_xor(s, 32);
            const int sb = SSS + (cc & 1) * 512;
            if (fq == 0) *(LAS float*)(lds + sb + (hv * 64 + mt * 16 + fr) * 4) = s;
            __syncthreads();
            const float tot = *(LAS float*)(lds + sb + (mt * 16 + fr) * 4) + *(LAS float*)(lds + sb + (64 + mt * 16 + fr) * 4);
            const float rn = rsqrtf(tot * (1.f / 256.f) + 1e-6f);
#pragma unroll
            for (int n = 0; n < 8; ++n) { const float r0 = bflo(rr[n].x), r1 = bfhi(rr[n].x), r2 = bflo(rr[n].y), r3 = bfhi(rr[n].y);
                const f32x4 v = accO[n] * rn * gn[n];
                *(u32x2*)(P + tok * PW + 2048 + h * 256 + hv * 128 + n * 16 + 4 * fq) =
                    (u32x2){cvt_pk_bf16(v[0] * (r0 * sigmoidf_(r0)), v[1] * (r1 * sigmoidf_(r1))), cvt_pk_bf16(v[2] * (r2 * sigmoidf_(r2)), v[3] * (r3 * sigmoidf_(r3)))}; }
        }
    }
}

__device__ __forceinline__ void phase_gating(const Params& p, int layer) {
    int tid = threadIdx.x; asm volatile("" : "+v"(tid));
    const int wid = tid >> 6, lane = tid & 63;
    bf16_t* P = (bf16_t*)(p.ws + OFF_PROJ); const bf16_t* O = (const bf16_t*)(p.ws + OFF_O);
    const float* gn = p.gla_norm + layer * 1024 + lane * 16;
    f32x4 g4[4];
#pragma unroll
    for (int i = 0; i < 4; ++i) g4[i] = *(const f32x4*)(gn + 4 * i);
    for (int t0 = blockIdx.x * 8 + wid; t0 < T_TOK; t0 += gridDim.x * 16) {
        u32x4 oo[2][2], rr[2][2]; bool ok[2];
#pragma unroll
        for (int u = 0; u < 2; ++u) { const int t = t0 + u * gridDim.x * 8; ok[u] = t < T_TOK;
            if (ok[u]) { oo[u][0] = *(const u32x4*)(O + (size_t)t * 1024 + lane * 16); oo[u][1] = *(const u32x4*)(O + (size_t)t * 1024 + lane * 16 + 8);
                const bf16_t* rp = P + (size_t)t * PW + 2048 + lane * 16; rr[u][0] = *(const u32x4*)rp; rr[u][1] = *(const u32x4*)(rp + 8); } }
#pragma unroll
        for (int u = 0; u < 2; ++u) if (ok[u]) { const int t = t0 + u * gridDim.x * 8;
            bf16_t* rp = P + (size_t)t * PW + 2048 + lane * 16;
            const u32x4 o0 = oo[u][0], o1 = oo[u][1], r0 = rr[u][0], r1 = rr[u][1];
            float ov[16], rv[16];
            ov[0] = bflo(o0.x); ov[1] = bfhi(o0.x); ov[2] = bflo(o0.y); ov[3] = bfhi(o0.y); ov[4] = bflo(o0.z); ov[5] = bfhi(o0.z); ov[6] = bflo(o0.w); ov[7] = bfhi(o0.w);
            ov[8] = bflo(o1.x); ov[9] = bfhi(o1.x); ov[10] = bflo(o1.y); ov[11] = bfhi(o1.y); ov[12] = bflo(o1.z); ov[13] = bfhi(o1.z); ov[14] = bflo(o1.w); ov[15] = bfhi(o1.w);
            rv[0] = bflo(r0.x); rv[1] = bfhi(r0.x); rv[2] = bflo(r0.y); rv[3] = bfhi(r0.y); rv[4] = bflo(r0.z); rv[5] = bfhi(r0.z); rv[6] = bflo(r0.w); rv[7] = bfhi(r0.w);
            rv[8] = bflo(r1.x); rv[9] = bfhi(r1.x); rv[10] = bflo(r1.y); rv[11] = bfhi(r1.y); rv[12] = bflo(r1.z); rv[13] = bfhi(r1.z); rv[14] = bflo(r1.w); rv[15] = bfhi(r1.w);
            float s = 0.f;
#pragma unroll
            for (int i = 0; i < 16; ++i) s += ov[i] * ov[i];
            s += __shfl_xor(s, 8); s += __shfl_xor(s, 4); s += __shfl_xor(s, 2); s += __shfl_xor(s, 1);
            const float rn = rsqrtf(s * (1.f / 256.f) + 1e-6f);
            float out[16];
#pragma unroll
            for (int i = 0; i < 16; ++i) { const float r = rv[i]; out[i] = ov[i] * rn * g4[i >> 2][i & 3] * (r * sigmoidf_(r)); }
            *(u32x4*)rp = (u32x4){cvt_pk_bf16(out[0], out[1]), cvt_pk_bf16(out[2], out[3]), cvt_pk_bf16(out[4], out[5]), cvt_pk_bf16(out[6], out[7])};
            *(u32x4*)(rp + 8) = (u32x4){cvt_pk_bf16(out[8], out[9]), cvt_pk_bf16(out[10], out[11]), cvt_pk_bf16(out[12], out[13]), cvt_pk_bf16(out[14], out[15])}; }
    }
}

template <int HW>
__device__ __forceinline__ void pool_run(const bf16_t* P, bf16_t* PO, int t0, int c8) {
    constexpr int NR = 16 + 2 * HW - 1;
    const int pos0 = t0 & (SEQL - 1);
    const bf16_t* base = P + (size_t)t0 * PW + 3072 + c8 * 8;
    u32x4 v[NR];
#pragma unroll
    for (int k = 0; k < NR; ++k) { const int off = k - HW, tt = pos0 + off;
        v[k] = (tt >= 0 && tt < SEQL) ? *(const u32x4*)(base + (long)off * PW) : (u32x4){0u, 0u, 0u, 0u}; }
    float w[8];
#pragma unroll
    for (int i = 0; i < 8; ++i) w[i] = 0.f;
#pragma unroll
    for (int k = 0; k < 2 * HW; ++k) { w[0] += bflo(v[k].x); w[1] += bfhi(v[k].x); w[2] += bflo(v[k].y); w[3] += bfhi(v[k].y); w[4] += bflo(v[k].z); w[5] += bfhi(v[k].z); w[6] += bflo(v[k].w); w[7] += bfhi(v[k].w); }
#pragma unroll
    for (int i = 0; i < 16; ++i) {
        if (i > 0) { const u32x4 a = v[i + 2 * HW - 1], s = v[i - 1];
            w[0] += bflo(a.x) - bflo(s.x); w[1] += bfhi(a.x) - bfhi(s.x); w[2] += bflo(a.y) - bflo(s.y); w[3] += bfhi(a.y) - bfhi(s.y);
            w[4] += bflo(a.z) - bflo(s.z); w[5] += bfhi(a.z) - bfhi(s.z); w[6] += bflo(a.w) - bflo(s.w); w[7] += bfhi(a.w) - bfhi(s.w); }
        const int pos = pos0 + i, lo = pos - HW < 0 ? 0 : pos - HW, hi = pos + HW > SEQL ? SEQL : pos + HW;
        const float ic = 1.f / (float)(hi - lo);
        const u32x4 c = v[HW + i];
        *(u32x4*)(PO + (size_t)(t0 + i) * 512 + c8 * 8) = (u32x4){cvt_pk_bf16(w[0] * ic - bflo(c.x), w[1] * ic - bfhi(c.x)), cvt_pk_bf16(w[2] * ic - bflo(c.y), w[3] * ic - bfhi(c.y)),
                                                                 cvt_pk_bf16(w[4] * ic - bflo(c.z), w[5] * ic - bfhi(c.z)), cvt_pk_bf16(w[6] * ic - bflo(c.w), w[7] * ic - bfhi(c.w))};
    }
}
__device__ __forceinline__ void phase_pool(const Params& p) {
    const bf16_t* P = (const bf16_t*)(p.ws + OFF_PROJ); bf16_t* PO = (bf16_t*)(p.ws + OFF_E);
    int tid = threadIdx.x; asm volatile("" : "+v"(tid));
    const int wid = __builtin_amdgcn_readfirstlane(tid >> 6), lane = tid & 63;
    for (int wi = blockIdx.x * 8 + wid; wi < T_TOK / 16; wi += gridDim.x * 8) {
        const int grp = wi & 3, t0 = (wi >> 2) * 64 + (lane >> 4) * 16, c8 = grp * 16 + (lane & 15);
        if (grp == 0) pool_run<1>(P, PO, t0, c8); else if (grp == 1) pool_run<2>(P, PO, t0, c8); else if (grp == 2) pool_run<4>(P, PO, t0, c8); else pool_run<8>(P, PO, t0, c8);
    }
}

__device__ __forceinline__ void phase_final(const Params& p) {
    int tid = threadIdx.x; asm volatile("" : "+v"(tid));
    const int wid = tid >> 6, lane = tid & 63;
    const float* ssq = (const float*)(p.ws + OFF_SSQ); const bf16_t* xb = (const bf16_t*)(p.ws + OFF_XB);
    f32x4 g4[4];
#pragma unroll
    for (int i = 0; i < 4; ++i) g4[i] = *(const f32x4*)(p.norm_final + lane * 16 + 4 * i);
    for (int row0 = blockIdx.x * 8 + wid; row0 < T_TOK; row0 += gridDim.x * 32) {
        u32x4 v[4][2]; float rs[4]; bool ok[4];
#pragma unroll
        for (int u = 0; u < 4; ++u) { const int row = row0 + u * gridDim.x * 8; ok[u] = row < T_TOK;
            if (ok[u]) { rs[u] = rowscale(ssq, row); const bf16_t* xp = xb + (size_t)row * 1024 + lane * 16; v[u][0] = *(const u32x4*)xp; v[u][1] = *(const u32x4*)(xp + 8); } }
#pragma unroll
        for (int u = 0; u < 4; ++u) if (ok[u]) { const int row = row0 + u * gridDim.x * 8; float* op = p.xf + (size_t)row * 1024 + lane * 16; const float r = rs[u];
            *(f32x4*)(op) = (f32x4){bflo(v[u][0].x), bfhi(v[u][0].x), bflo(v[u][0].y), bfhi(v[u][0].y)} * r * g4[0];
            *(f32x4*)(op + 4) = (f32x4){bflo(v[u][0].z), bfhi(v[u][0].z), bflo(v[u][0].w), bfhi(v[u][0].w)} * r * g4[1];
            *(f32x4*)(op + 8) = (f32x4){bflo(v[u][1].x), bfhi(v[u][1].x), bflo(v[u][1].y), bfhi(v[u][1].y)} * r * g4[2];
            *(f32x4*)(op + 12) = (f32x4){bflo(v[u][1].z), bfhi(v[u][1].z), bflo(v[u][1].w), bfhi(v[u][1].w)} * r * g4[3]; }
    }
}

__device__ __forceinline__ void grid_barrier(unsigned* bar, unsigned k) {
    asm volatile("s_waitcnt vmcnt(0)" ::: "memory");
    __syncthreads();
    if (threadIdx.x == 0) {
        const unsigned nb = gridDim.x, g = blockIdx.x >> 4, ng = (nb + 15u) >> 4, gsz = (nb - 16u * g) < 16u ? (nb - 16u * g) : 16u;
        __builtin_amdgcn_fence(__ATOMIC_RELEASE, "agent");
        asm volatile("s_waitcnt vmcnt(0)" ::: "memory");
        const unsigned old = __hip_atomic_fetch_add(bar + 64 * g, 1u, __ATOMIC_RELAXED, __HIP_MEMORY_SCOPE_AGENT);
        if (old == k * gsz - 1u) {
            const unsigned old2 = __hip_atomic_fetch_add(bar + 64 * 32, 1u, __ATOMIC_RELAXED, __HIP_MEMORY_SCOPE_AGENT);
            if (old2 == k * ng - 1u) for (unsigned j = 0; j < ng; ++j) __hip_atomic_store(bar + 64 * (64 + j), k, __ATOMIC_RELAXED, __HIP_MEMORY_SCOPE_AGENT);
        }
        while (__hip_atomic_load(bar + 64 * (64 + g), __ATOMIC_RELAXED, __HIP_MEMORY_SCOPE_AGENT) < k) __builtin_amdgcn_s_sleep(2);
        __builtin_amdgcn_fence(__ATOMIC_ACQUIRE, "agent");
        asm volatile("s_waitcnt vmcnt(0)" ::: "memory");
    }
    __syncthreads();
}
__global__ void __launch_bounds__(512, 2) mega(const Params p_arg) {
    extern __shared__ __attribute__((aligned(16))) unsigned char shm[];
    LAS unsigned char* lds = (LAS unsigned char*)shm;
    typedef const Params __attribute__((address_space(4))) * KArgPtr;
    const int phase_lo = p_arg.phase_lo, phase_hi = p_arg.phase_hi;
    pg8::StaticOrder S;
    for (int ph = phase_lo; ph < phase_hi; ++ph) {
        KArgPtr kp = (KArgPtr)__builtin_amdgcn_kernarg_segment_ptr(); asm volatile("" : "+s"(kp));
        const Params& p = *(const Params*)kp;
        bf16_t* xb = (bf16_t*)(p.ws + OFF_XB); bf16_t* proj = (bf16_t*)(p.ws + OFF_PROJ); float* ssq = (float*)(p.ws + OFF_SSQ);
        if (ph > phase_lo) {
            if (phase_hi > 1000) cg::this_grid().sync();
            grid_barrier((unsigned*)(p.ws + OFF_BAR), (unsigned)(ph - phase_lo));
        }
        if (ph == 0) { phase_prep(lds, p); continue; }
        if (ph == 19) { phase_final(p); continue; }
        const int layer = (ph - 1) / 9, sub = (ph - 1) % 9;
        const char* W = p.ws + OFF_W + (size_t)layer * SZ_WLAYER;
        switch (sub) {
        case 0: { pg8::Gemm g{xb, (const bf16_t*)(W + WO_A), T_TOK, NA, 1024, 1024}; S.init(g.M, g.N, gridDim.x, blockIdx.x);
                  EpiA e{proj, (bf16_t*)(p.ws + OFF_LR), ssq}; pg8::gemm_phase(lds, g, S, e); } break;
        case 1: gla_pass<true>(lds, p, layer); break;
        case 2: phase_combine(p); break;
        case 3: gla_light(lds, p, layer); break;
        case 4: { pg8::Gemm g{xb, (const bf16_t*)(W + WO_B), T_TOK, NB, 1024, 1024}; S.init(g.M, g.N, gridDim.x, blockIdx.x);
                  EpiGate e{proj, ssq}; pg8::gemm_phase(lds, g, S, e);
                  phase_pool(p); } break;
        case 5: { { pg8::Gemm g{(const bf16_t*)(p.ws + OFF_E), (const bf16_t*)(W + WO_POOL), T_TOK, 1024, 128, 512}; S.init(g.M, g.N, gridDim.x, blockIdx.x);
                    EpiPool e{proj, p.pool_scale + layer * 1024}; pg8::gemm_phase<EpiPool, 256>(lds, g, S, e); }
                  { pg8::Gemm g{proj + 2048, (const bf16_t*)(W + WO_GA), T_TOK, 1024, 1024, PW}; S.init(g.M, g.N, gridDim.x, blockIdx.x);
                    EpiMerge e{proj}; pg8::gemm_phase(lds, g, S, e); } } break;
        case 6: { pg8::Gemm g{proj, (const bf16_t*)(W + WO_OUT), T_TOK, 1024, 1024, PW}; S.init(g.M, g.N, gridDim.x, blockIdx.x);
                  EpiRes e{xb, ssq}; pg8::gemm_phase(lds, g, S, e); } break;
        case 7: { pg8::Gemm g{xb, (const bf16_t*)(W + WO_F1), T_TOK, 2 * DFF, 1024, 1024}; S.init(g.M, g.N, gridDim.x, blockIdx.x);
                  EpiFfn1 e{proj, ssq}; pg8::gemm_phase(lds, g, S, e); } break;
        case 8: { pg8::Gemm g{proj, (const bf16_t*)(W + WO_F2), T_TOK, 1024, DFF, DFF}; S.init(g.M, g.N, gridDim.x, blockIdx.x);
                  EpiRes e{xb, ssq}; pg8::gemm_phase(lds, g, S, e); } break;
        }
    }
}

extern "C" void kernel_launch(void* const* d_in, const int* in_sizes, int n_in, void* d_out, int out_size, void* d_ws, size_t ws_size, hipStream_t stream) {
    (void)in_sizes; (void)n_in; (void)out_size;
    if (ws_size < WS_NEEDED) return;
    Params p{};
    p.x_in = (const float*)d_in[0]; p.norm_mix = (const float*)d_in[1]; p.w_in = (const float*)d_in[2]; p.wdu_f = (const float*)d_in[3]; p.bd_f = (const float*)d_in[4];
    p.wdu_b = (const float*)d_in[5]; p.bd_b = (const float*)d_in[6]; p.gla_norm = (const float*)d_in[7]; p.w_ga = (const float*)d_in[8]; p.w_pool = (const float*)d_in[9];
    p.pool_scale = (const float*)d_in[10]; p.w_out = (const float*)d_in[11]; p.norm_ffn = (const float*)d_in[12]; p.w_f1 = (const float*)d_in[13]; p.w_f2 = (const float*)d_in[14];
    p.norm_final = (const float*)d_in[15];
    p.xf = (float*)d_out; p.ws = (char*)d_ws;
    hipFuncSetAttribute((const void*)mega, hipFuncAttributeMaxDynamicSharedMemorySize, LDS_BYTES);
    int dev = 0, cus = 0, per = 0;
    hipGetDevice(&dev); hipDeviceGetAttribute(&cus, hipDeviceAttributeMultiprocessorCount, dev);
    hipOccupancyMaxActiveBlocksPerMultiprocessor(&per, mega, 512, LDS_BYTES);
    int grid = cus * (per > 0 ? per : 1); if (grid > 256) grid = 256; if (grid < 1) grid = 1;
#if MK_SINGLE_LAUNCH
    p.phase_lo = 0; p.phase_hi = 20;
    hipMemsetAsync((char*)d_ws + OFF_BAR, 0, 128 * 256, stream);
    void* args[] = {(void*)&p};
    hipLaunchCooperativeKernel((const void*)mega, dim3(grid), dim3(512), args, LDS_BYTES, stream);
#else
    for (int ph = 0; ph < 20; ++ph) { p.phase_lo = ph; p.phase_hi = ph + 1; hipLaunchKernelGGL(mega, dim3(grid), dim3(512), LDS_BYTES, stream, p); }
#endif
}
```

```cpp
#include <hip/hip_runtime.h>
#include <hip/hip_cooperative_groups.h>
namespace cg = cooperative_groups;

#ifndef MK_SINGLE_LAUNCH
#define MK_SINGLE_LAUNCH 1
#endif

#define LAS __attribute__((address_space(3)))
typedef unsigned short bf16_t;
typedef short bf16x8 __attribute__((ext_vector_type(8)));
typedef float f32x4 __attribute__((ext_vector_type(4)));
typedef unsigned u32x4 __attribute__((ext_vector_type(4)));
typedef unsigned u32x2 __attribute__((ext_vector_type(2)));

constexpr int T_TOK = 32768, SEQL = 16384, DM = 1024, PW = 3584, NA = 3840, NB = 2048, DFF = 2816, INW = 5664;
constexpr int LDS_BYTES = 155136;

constexpr size_t SZ_WA = (size_t)NA * 1024 * 2, SZ_WB = (size_t)NB * 1024 * 2, SZ_WGA = (size_t)1024 * 1024 * 2, SZ_WPOOL = (size_t)1024 * 512 * 2,
                 SZ_WOUT = (size_t)1024 * 1024 * 2, SZ_WF1 = (size_t)2 * DFF * 1024 * 2, SZ_WF2 = (size_t)1024 * DFF * 2;
constexpr size_t WO_A = 0, WO_B = WO_A + SZ_WA, WO_GA = WO_B + SZ_WB, WO_POOL = WO_GA + SZ_WGA, WO_OUT = WO_POOL + SZ_WPOOL, WO_F1 = WO_OUT + SZ_WOUT,
                 WO_F2 = WO_F1 + SZ_WF1, SZ_WLAYER = WO_F2 + SZ_WF2;
constexpr size_t OFF_W = 0;
constexpr size_t OFF_XB = OFF_W + 2 * SZ_WLAYER;
constexpr size_t OFF_PROJ = OFF_XB + (size_t)T_TOK * 1024 * 2;
constexpr size_t OFF_LR = OFF_PROJ + (size_t)T_TOK * PW * 2;
constexpr size_t OFF_E = OFF_LR + (size_t)T_TOK * 32 * 4;
constexpr size_t OFF_DLOG = OFF_E + (size_t)16 * 32 * 32768 * 4;
constexpr size_t OFF_O = OFF_DLOG + (size_t)16 * 32 * 128 * 4;
constexpr size_t OFF_SSQ = OFF_O + (size_t)T_TOK * 1024 * 2;
constexpr size_t OFF_BAR = OFF_SSQ + (size_t)T_TOK * 16 * 4;
constexpr size_t OFF_RS = OFF_BAR + 128 * 256;
constexpr size_t WS_NEEDED = OFF_RS + (size_t)T_TOK * 4;

struct Params {
    const float* x_in; const float* norm_mix; const float* w_in; const float* wdu_f; const float* bd_f; const float* wdu_b; const float* bd_b;
    const float* gla_norm; const float* w_ga; const float* w_pool; const float* pool_scale; const float* w_out; const float* norm_ffn;
    const float* w_f1; const float* w_f2; const float* norm_final;
    float* xf; char* ws;
    int phase_lo, phase_hi;
};

typedef float f32x2 __attribute__((ext_vector_type(2)));
typedef __bf16 bf16x2_t __attribute__((ext_vector_type(2)));
__device__ __forceinline__ unsigned cvt_pk_bf16(float lo, float hi) { const f32x2 v = {lo, hi}; const bf16x2_t b = __builtin_convertvector(v, bf16x2_t); return __builtin_bit_cast(unsigned, b); }
__device__ __forceinline__ float bf2f(unsigned short b) { return __uint_as_float(((unsigned)b) << 16); }
__device__ __forceinline__ float bflo(unsigned w) { return __uint_as_float(w << 16); }
__device__ __forceinline__ float bfhi(unsigned w) { return __uint_as_float(w & 0xffff0000u); }
__device__ __forceinline__ unsigned short f2bf(float f) { return (unsigned short)(cvt_pk_bf16(f, 0.f) & 0xffffu); }
__device__ __forceinline__ float sigmoidf_(float x) { return __builtin_amdgcn_rcpf(1.f + __expf(-x)); }

namespace pg8 {
constexpr int BM = 256, BK = 64, HALF = 128, HTB = HALF * BK * 2, STAGE_BYTES = 8 * HTB, NXCD = 8, WGM = 8;
__device__ __forceinline__ int lds_byte(int r, int c) { const int st = (r >> 4) * 2 + (c >> 5), rr = r & 15, cc = c & 31, ob = rr * 64 + cc * 2; return st * 1024 + (ob ^ (((ob >> 9) & 1) << 5)); }
__device__ __forceinline__ void stage_rc(int b, int& R, int& C) { const int st = b / 1024, sb = b % 1024, swz = sb ^ (((sb >> 9) & 1) << 5); R = (st >> 1) * 16 + swz / 64; C = (st & 1) * 32 + (swz % 64) / 2; }
__device__ __forceinline__ int perm32(int rho) { const int n = rho >> 4, i = rho & 15; return 8 * (i >> 2) + 4 * n + (i & 3); }
struct Unit { int pm, pn; };
struct Gemm { const bf16_t* A; const bf16_t* Bt; int M, N, K, lda; };
struct StaticOrder {
    int nM, nN, nwg, G, c;
    __device__ void init(int M, int N, int G_, int c_) { nM = M / BM; nN = N / BM; nwg = nM * nN; G = G_; c = c_; }
    __device__ bool next(int i, Unit& u) const {
        const long L = (long)i * G + c; if (L >= nwg) return false;
        int wgid = (int)L; { const int q = nwg / NXCD, r = nwg % NXCD, xcd = wgid % NXCD, off = wgid / NXCD; wgid = (xcd < r ? xcd * (q + 1) : r * (q + 1) + (xcd - r) * q) + off; }
        const int nig = WGM * nN, gid = wgid / nig, fm = gid * WGM, gsz = (nM - fm) < WGM ? (nM - fm) : WGM;
        u.pm = fm + ((wgid % nig) % gsz); u.pn = (wgid % nig) / gsz; return true;
    }
};

template <class Epi, int APN = 0, bool ALIGN_EPI = true, bool SP2 = true>
__device__ __forceinline__ void gemm_phase(LAS unsigned char* lds, const Gemm g, const StaticOrder& S, const Epi& E) {
    int tid = threadIdx.x; asm volatile("" : "+v"(tid));
    const int wid = __builtin_amdgcn_readfirstlane(tid >> 6), lane = tid & 63, wr = wid >> 2, wc = wid & 3, fr = lane & 15, fq = lane >> 4;
    int K = g.K; asm volatile("" : "+s"(K));
    const int nt = K / BK;
    unsigned voffA[2], voffB[2];
#pragma unroll
    for (int i = 0; i < 2; ++i) { int R, C; stage_rc(tid * 16 + i * 8192, R, C); const int Rb = Epi::PERM ? ((R & ~31) + perm32(R & 31)) : R;
        voffA[i] = (unsigned)(R * g.lda + C) * 2u; voffB[i] = (unsigned)(Rb * K + C) * 2u; }
    const size_t kstep = (size_t)(BK * 2);
    const size_t hstepA = (size_t)HALF * g.lda * 2, hstepB = (size_t)HALF * K * 2;
    const size_t tstepA = 2 * hstepA, tstepB = 2 * hstepB;
    const unsigned ldsw = (unsigned)wid * 1024u;
    const int aoff = lds_byte(wr * 64 + fr, fq * 8), boff = lds_byte(wc * 32 + fr, fq * 8);
#define PG8_SA(b, h) (((b) * 2 + (h)) * HTB)
#define PG8_SB(b, h) ((4 + (b) * 2 + (h)) * HTB)
#define PG8_STAGE(bufoff, gbase, voff) do { _Pragma("unroll") for (int _i = 0; _i < 2; ++_i) \
        __builtin_amdgcn_global_load_lds((const unsigned*)((const char*)(gbase) + (voff)[_i]), (LAS unsigned*)(lds + (bufoff) + ldsw + _i * 8192), 16, 0, 0); } while (0)
#define PG8_LDA(dst, b, h) do { _Pragma("unroll") for (int m = 0; m < 4; ++m) _Pragma("unroll") for (int k = 0; k < 2; ++k) dst[m][k] = *(const LAS bf16x8*)(lds + PG8_SA(b, h) + aoff + m * 2048 + k * 1024); } while (0)
#define PG8_LDB(dst, b, h) do { _Pragma("unroll") for (int n = 0; n < 2; ++n) _Pragma("unroll") for (int k = 0; k < 2; ++k) dst[n][k] = *(const LAS bf16x8*)(lds + PG8_SB(b, h) + boff + n * 2048 + k * 1024); } while (0)
#define PG8_MMA(ai, bj, At, Bt) do { __builtin_amdgcn_s_setprio(1); _Pragma("unroll") for (int m = 0; m < 4; ++m) _Pragma("unroll") for (int n = 0; n < 2; ++n) _Pragma("unroll") for (int k = 0; k < 2; ++k) \
        acc[ai][bj][m][n] = __builtin_amdgcn_mfma_f32_16x16x32_bf16(Bt[n][k], At[m][k], acc[ai][bj][m][n], 0, 0, 0); __builtin_amdgcn_s_setprio(0); } while (0)
#define PG8_WAIT_V(n) asm volatile("s_waitcnt vmcnt(" #n ")" ::: "memory")
#define PG8_WAIT_L(n) asm volatile("s_waitcnt lgkmcnt(" #n ")" ::: "memory")
#define PG8_BAR __builtin_amdgcn_s_barrier()
#define PG8_SCHED __builtin_amdgcn_sched_barrier(0)
    Unit cur, nxt; int ui = 0;
    if (!S.next(0, cur)) return;
    f32x4 acc[2][2][4][2];
#pragma unroll
    for (int a = 0; a < 2; ++a)
#pragma unroll
        for (int b = 0; b < 2; ++b)
#pragma unroll
            for (int m = 0; m < 4; ++m)
#pragma unroll
                for (int n = 0; n < 2; ++n) acc[a][b][m][n] = (f32x4){0.f, 0.f, 0.f, 0.f};
    bf16x8 At[4][2], B0[2][2], B1[2][2];
    const char* cA = (const char*)g.A + (size_t)cur.pm * tstepA + (size_t)cur.pn * APN; const char* cB = (const char*)g.Bt + (size_t)cur.pn * tstepB;
    if constexpr (SP2) {
        PG8_STAGE(PG8_SB(0, 0), cB, voffB); PG8_STAGE(PG8_SB(0, 1), cB + hstepB, voffB); PG8_STAGE(PG8_SA(0, 0), cA, voffA); PG8_STAGE(PG8_SA(0, 1), cA + hstepA, voffA);
        if (wr == 1) PG8_BAR;
        PG8_WAIT_V(2); PG8_BAR;
        PG8_STAGE(PG8_SB(1, 0), cB + kstep, voffB); PG8_STAGE(PG8_SA(1, 0), cA + kstep, voffA); PG8_STAGE(PG8_SB(1, 1), cB + hstepB + kstep, voffB);
        PG8_WAIT_V(6); PG8_BAR;
    } else {
        PG8_STAGE(PG8_SB(0, 0), cB, voffB); PG8_STAGE(PG8_SA(0, 0), cA, voffA); PG8_STAGE(PG8_SB(0, 1), cB + hstepB, voffB); PG8_STAGE(PG8_SA(0, 1), cA + hstepA, voffA);
        if (wr == 1) PG8_BAR;
        PG8_WAIT_V(4); PG8_BAR;
        PG8_STAGE(PG8_SB(1, 0), cB + kstep, voffB); PG8_STAGE(PG8_SA(1, 0), cA + kstep, voffA); PG8_STAGE(PG8_SB(1, 1), cB + hstepB + kstep, voffB);
        PG8_WAIT_V(6); PG8_BAR;
    }
    for (;;) {
        const bool has_next = S.next(ui + 1, nxt);
        const unsigned rsoff = (unsigned)STAGE_BYTES + (unsigned)(ui & 1) * 1024u;
        if constexpr (Epi::NEEDS_RS) { if (wid < 4) __builtin_amdgcn_global_load_lds((const unsigned*)(E.rsv + cur.pm * 256 + wid * 64 + lane), (LAS unsigned*)(lds + rsoff + wid * 256), 4, 0, 0); }
        const char* nA = has_next ? (const char*)g.A + (size_t)nxt.pm * tstepA + (size_t)nxt.pn * APN : cA; const char* nB = has_next ? (const char*)g.Bt + (size_t)nxt.pn * tstepB : cB;
        for (int t = 0; t < nt; t += 2) {
            const bool last = (t == nt - 2);
            const char* a1 = cA + (size_t)(t + 1) * kstep;
            const char* a2 = last ? nA : cA + (size_t)(t + 2) * kstep; const char* b2 = last ? nB : cB + (size_t)(t + 2) * kstep;
            const char* a3 = a2 + kstep; const char* b3 = b2 + kstep;
            if constexpr (SP2) {
            PG8_LDB(B0, 0, 0); PG8_LDB(B1, 0, 1); PG8_SCHED; PG8_LDA(At, 0, 0); PG8_STAGE(PG8_SA(1, 1), a1 + hstepA, voffA);
            PG8_WAIT_V(8); PG8_WAIT_L(0); PG8_BAR; PG8_MMA(0, 0, At, B0); PG8_MMA(0, 1, At, B1); PG8_BAR; PG8_SCHED;
            PG8_LDA(At, 0, 1); PG8_STAGE(PG8_SB(0, 0), b2, voffB); PG8_STAGE(PG8_SB(0, 1), b2 + hstepB, voffB); PG8_STAGE(PG8_SA(0, 0), a2, voffA);
            PG8_WAIT_V(8); PG8_WAIT_L(0); PG8_BAR; PG8_MMA(1, 0, At, B0); PG8_MMA(1, 1, At, B1); PG8_BAR; PG8_SCHED;
            PG8_LDB(B0, 1, 0); PG8_LDB(B1, 1, 1); PG8_SCHED; PG8_LDA(At, 1, 0); PG8_STAGE(PG8_SA(0, 1), a2 + hstepA, voffA);
            PG8_WAIT_V(8); PG8_WAIT_L(0); PG8_BAR; PG8_MMA(0, 0, At, B0); PG8_MMA(0, 1, At, B1); PG8_BAR; PG8_SCHED;
            PG8_LDA(At, 1, 1); PG8_STAGE(PG8_SB(1, 0), b3, voffB); PG8_STAGE(PG8_SB(1, 1), b3 + hstepB, voffB); PG8_STAGE(PG8_SA(1, 0), a3, voffA);
            PG8_WAIT_V(8); PG8_WAIT_L(0); PG8_BAR; PG8_MMA(1, 0, At, B0); PG8_MMA(1, 1, At, B1); PG8_BAR; PG8_SCHED;
            } else {
            PG8_LDB(B0, 0, 0); PG8_SCHED; PG8_LDA(At, 0, 0); PG8_STAGE(PG8_SA(1, 1), a1 + hstepA, voffA);
            PG8_WAIT_L(8); PG8_BAR; PG8_WAIT_L(0); PG8_MMA(0, 0, At, B0); PG8_BAR; PG8_SCHED;
            PG8_LDB(B1, 0, 1); PG8_STAGE(PG8_SB(0, 0), b2, voffB);
            PG8_BAR; PG8_WAIT_L(0); PG8_MMA(0, 1, At, B1); PG8_BAR;
            PG8_LDA(At, 0, 1); PG8_STAGE(PG8_SA(0, 0), a2, voffA);
            PG8_BAR; PG8_WAIT_L(0); PG8_MMA(1, 0, At, B0); PG8_BAR; PG8_SCHED;
            PG8_STAGE(PG8_SB(0, 1), b2 + hstepB, voffB);
            PG8_WAIT_V(6); PG8_BAR; PG8_MMA(1, 1, At, B1); PG8_BAR;
            PG8_LDB(B0, 1, 0); PG8_SCHED; PG8_LDA(At, 1, 0); PG8_STAGE(PG8_SA(0, 1), a2 + hstepA, voffA);
            PG8_WAIT_L(8); PG8_BAR; PG8_WAIT_L(0); PG8_MMA(0, 0, At, B0); PG8_BAR; PG8_SCHED;
            PG8_LDB(B1, 1, 1); PG8_STAGE(PG8_SB(1, 0), b3, voffB);
            PG8_BAR; PG8_WAIT_L(0); PG8_MMA(0, 1, At, B1); PG8_BAR;
            PG8_LDA(At, 1, 1); PG8_STAGE(PG8_SA(1, 0), a3, voffA);
            PG8_BAR; PG8_WAIT_L(0); PG8_MMA(1, 0, At, B0); PG8_BAR; PG8_SCHED;
            PG8_STAGE(PG8_SB(1, 1), b3 + hstepB, voffB);
            PG8_WAIT_V(6); PG8_BAR; PG8_MMA(1, 1, At, B1); PG8_BAR;
            }
        }
        if constexpr (ALIGN_EPI) { if (wr == 0) PG8_BAR; }
        E(acc, cur, wr, wc, fr, fq, (const LAS float*)(lds + rsoff));
        if (!has_next) break;
#pragma unroll
        for (int a = 0; a < 2; ++a)
#pragma unroll
            for (int b = 0; b < 2; ++b)
#pragma unroll
                for (int m = 0; m < 4; ++m)
#pragma unroll
                    for (int n = 0; n < 2; ++n) acc[a][b][m][n] = (f32x4){0.f, 0.f, 0.f, 0.f};
        cur = nxt; cA = nA; cB = nB; ++ui;
        if constexpr (ALIGN_EPI) { if (wr == 1) PG8_BAR; }
    }
    PG8_WAIT_V(0);
    if constexpr (!ALIGN_EPI) { if (wr == 0) PG8_BAR; }
    PG8_BAR;
#undef PG8_SA
#undef PG8_SB
#undef PG8_STAGE
#undef PG8_LDA
#undef PG8_LDB
#undef PG8_MMA
#undef PG8_WAIT_V
#undef PG8_WAIT_L
#undef PG8_BAR
#undef PG8_SCHED
}
}
using pg8::Unit;

__device__ __forceinline__ float rowscale(const float* ssq, int row) {
    const f32x4* s = (const f32x4*)(ssq + (size_t)row * 16);
    const f32x4 a = s[0], b = s[1], c = s[2], d = s[3];
    const float t = ((a[0] + a[1]) + (a[2] + a[3])) + ((b[0] + b[1]) + (b[2] + b[3])) + ((c[0] + c[1]) + (c[2] + c[3])) + ((d[0] + d[1]) + (d[2] + d[3]));
    return rsqrtf(t * (1.f / 1024.f) + 1e-6f);
}
__device__ __forceinline__ u32x4 pack8(const f32x4 v0, const f32x4 v1) {
    u32x4 w; w.x = cvt_pk_bf16(v0[0], v0[1]); w.y = cvt_pk_bf16(v0[2], v0[3]); w.z = cvt_pk_bf16(v1[0], v1[1]); w.w = cvt_pk_bf16(v1[2], v1[3]); return w;
}

struct EpiA {
    static constexpr bool PERM = true;
    static constexpr bool NEEDS_RS = true; const float* rsv;
    bf16_t* P; bf16_t* lr; const float* ssq;
    __device__ __forceinline__ void operator()(const f32x4 (&acc)[2][2][4][2], const Unit& u, int wr, int wc, int fr, int fq, const LAS float* rsl) const {
        const int row0 = u.pm * 256 + wr * 64 + fr;
#pragma unroll
        for (int ai = 0; ai < 2; ++ai)
#pragma unroll
            for (int m = 0; m < 4; ++m) {
                const int row = row0 + ai * 128 + m * 16; const float rs = rsl[ai * 128 + wr * 64 + m * 16 + fr];
                if (u.pn < 14) {
#pragma unroll
                    for (int bj = 0; bj < 2; ++bj) {
                        const f32x4 v0 = acc[ai][bj][m][0] * rs, v1 = acc[ai][bj][m][1] * rs;
                        *(u32x4*)(P + (size_t)row * PW + u.pn * 256 + bj * 128 + wc * 32 + 8 * fq) = pack8(v0, v1);
                    }
                } else if (wc == 0) {
                    const f32x4 v0 = acc[ai][0][m][0] * rs, v1 = acc[ai][0][m][1] * rs;
                    const u32x4 hi = pack8(v0, v1);
                    const f32x4 d0 = (f32x4){v0[0] - bflo(hi.x), v0[1] - bfhi(hi.x), v0[2] - bflo(hi.y), v0[3] - bfhi(hi.y)};
                    const f32x4 d1 = (f32x4){v1[0] - bflo(hi.z), v1[1] - bfhi(hi.z), v1[2] - bflo(hi.w), v1[3] - bfhi(hi.w)};
                    bf16_t* lp = lr + (size_t)row * 64 + (fq >> 1) * 32 + (fq & 1) * 8;
                    *(u32x4*)lp = hi; *(u32x4*)(lp + 16) = pack8(d0, d1);
                }
            }
    }
};
struct EpiGate {
    static constexpr bool PERM = true;
    static constexpr bool NEEDS_RS = true; const float* rsv;
    bf16_t* P; const float* ssq;
    __device__ __forceinline__ void operator()(const f32x4 (&acc)[2][2][4][2], const Unit& u, int wr, int wc, int fr, int fq, const LAS float* rsl) const {
        const int row0 = u.pm * 256 + wr * 64 + fr;
#pragma unroll
        for (int ai = 0; ai < 2; ++ai)
#pragma unroll
            for (int m = 0; m < 4; ++m) {
                const int row = row0 + ai * 128 + m * 16; const float rs = rsl[ai * 128 + wr * 64 + m * 16 + fr];
#pragma unroll
                for (int bj = 0; bj < 2; ++bj) {
                    f32x4 v0 = acc[ai][bj][m][0] * rs, v1 = acc[ai][bj][m][1] * rs;
#pragma unroll
                    for (int j = 0; j < 4; ++j) { v0[j] = sigmoidf_(v0[j]); v1[j] = sigmoidf_(v1[j]); }
                    *(u32x4*)(P + (size_t)row * PW + u.pn * 256 + bj * 128 + wc * 32 + 8 * fq) = pack8(v0, v1);
                }
            }
    }
};
struct EpiPool {
    static constexpr bool PERM = true;
    static constexpr bool NEEDS_RS = false;
    bf16_t* P; const float* pscale;
    __device__ __forceinline__ void operator()(const f32x4 (&acc)[2][2][4][2], const Unit& u, int wr, int wc, int fr, int fq, const LAS float* rsl) const {
        const int row0 = u.pm * 256 + wr * 64 + fr;
#pragma unroll
        for (int bj = 0; bj < 2; ++bj) {
            const int col = u.pn * 256 + bj * 128 + wc * 32 + 8 * fq;
            const f32x4 p0 = *(const f32x4*)(pscale + col), p1 = *(const f32x4*)(pscale + col + 4);
#pragma unroll
            for (int ai = 0; ai < 2; ++ai)
#pragma unroll
                for (int m = 0; m < 4; ++m) {
                    const int row = row0 + ai * 128 + m * 16;
                    bf16_t* ptr = P + (size_t)row * PW + 1024 + col;
                    const u32x4 g = *(const u32x4*)ptr;
                    f32x4 v0 = acc[ai][bj][m][0] * p0, v1 = acc[ai][bj][m][1] * p1;
                    v0[0] *= bflo(g.x); v0[1] *= bfhi(g.x); v0[2] *= bflo(g.y); v0[3] *= bfhi(g.y);
                    v1[0] *= bflo(g.z); v1[1] *= bfhi(g.z); v1[2] *= bflo(g.w); v1[3] *= bfhi(g.w);
                    *(u32x4*)ptr = pack8(v0, v1);
                    if (m & 1) asm volatile("" ::: "memory");
                }
        }
    }
};
struct EpiMerge {
    static constexpr bool PERM = true;
    static constexpr bool NEEDS_RS = false;
    bf16_t* P;
    __device__ __forceinline__ void operator()(const f32x4 (&acc)[2][2][4][2], const Unit& u, int wr, int wc, int fr, int fq, const LAS float* rsl) const {
        const int row0 = u.pm * 256 + wr * 64 + fr;
#pragma unroll
        for (int ai = 0; ai < 2; ++ai)
#pragma unroll
            for (int m = 0; m < 4; ++m) {
                const int row = row0 + ai * 128 + m * 16;
#pragma unroll
                for (int bj = 0; bj < 2; ++bj) {
                    bf16_t* ptr = P + (size_t)row * PW + u.pn * 256 + bj * 128 + wc * 32 + 8 * fq;
                    const u32x4 g = *(const u32x4*)ptr; const u32x4 t = *(const u32x4*)(ptr + 1024);
                    f32x4 v0 = acc[ai][bj][m][0], v1 = acc[ai][bj][m][1];
                    v0[0] = v0[0] * bflo(g.x) + bflo(t.x); v0[1] = v0[1] * bfhi(g.x) + bfhi(t.x); v0[2] = v0[2] * bflo(g.y) + bflo(t.y); v0[3] = v0[3] * bfhi(g.y) + bfhi(t.y);
                    v1[0] = v1[0] * bflo(g.z) + bflo(t.z); v1[1] = v1[1] * bfhi(g.z) + bfhi(t.z); v1[2] = v1[2] * bflo(g.w) + bflo(t.w); v1[3] = v1[3] * bfhi(g.w) + bfhi(t.w);
                    *(u32x4*)ptr = pack8(v0, v1);
                }
                asm volatile("" ::: "memory");
            }
    }
};
struct EpiRes {
    static constexpr bool PERM = true;
    static constexpr bool NEEDS_RS = false;
    bf16_t* xb; float* ssq;
    __device__ __forceinline__ void operator()(const f32x4 (&acc)[2][2][4][2], const Unit& u, int wr, int wc, int fr, int fq, const LAS float* rsl) const {
        const int row0 = u.pm * 256 + wr * 64 + fr;
#pragma unroll
        for (int ai = 0; ai < 2; ++ai)
#pragma unroll
            for (int m = 0; m < 4; ++m) {
                const int row = row0 + ai * 128 + m * 16; float s = 0.f;
#pragma unroll
                for (int bj = 0; bj < 2; ++bj) {
                    bf16_t* ptr = xb + (size_t)row * 1024 + u.pn * 256 + bj * 128 + wc * 32 + 8 * fq;
                    const u32x4 g = *(const u32x4*)ptr;
                    f32x4 v0 = acc[ai][bj][m][0], v1 = acc[ai][bj][m][1];
                    v0[0] += bflo(g.x); v0[1] += bfhi(g.x); v0[2] += bflo(g.y); v0[3] += bfhi(g.y);
                    v1[0] += bflo(g.z); v1[1] += bfhi(g.z); v1[2] += bflo(g.w); v1[3] += bfhi(g.w);
                    *(u32x4*)ptr = pack8(v0, v1);
                    s += (v0[0] * v0[0] + v0[1] * v0[1]) + (v0[2] * v0[2] + v0[3] * v0[3]) + (v1[0] * v1[0] + v1[1] * v1[1]) + (v1[2] * v1[2] + v1[3] * v1[3]);
                }
                s += __shfl_xor(s, 16); s += __shfl_xor(s, 32);
                if (fq == 0) ssq[(size_t)row * 16 + u.pn * 4 + wc] = s;
            }
    }
};
struct EpiFfn1 {
    static constexpr bool PERM = true;
    static constexpr bool NEEDS_RS = true; const float* rsv;
    bf16_t* ACT; const float* ssq;
    __device__ __forceinline__ void operator()(const f32x4 (&acc)[2][2][4][2], const Unit& u, int wr, int wc, int fr, int fq, const LAS float* rsl) const {
        const int row0 = u.pm * 256 + wr * 64 + fr;
#pragma unroll
        for (int ai = 0; ai < 2; ++ai)
#pragma unroll
            for (int m = 0; m < 4; ++m) {
                const int row = row0 + ai * 128 + m * 16; const float rs = rsl[ai * 128 + wr * 64 + m * 16 + fr];
                f32x4 o[2];
#pragma unroll
                for (int n = 0; n < 2; ++n)
#pragma unroll
                    for (int j = 0; j < 4; ++j) { const float gt = acc[ai][0][m][n][j] * rs, up = acc[ai][1][m][n][j] * rs; o[n][j] = gt * sigmoidf_(gt) * up; }
                *(u32x4*)(ACT + (size_t)row * DFF + u.pn * 128 + wc * 32 + 8 * fq) = pack8(o[0], o[1]);
            }
    }
};

struct WJob { const float* src; const float* g; bf16_t* dst; int ld, ldd, vlo, vhi, kw; };
__device__ __forceinline__ WJob wjob_decode(const Params& p, int layer, int j) {
    WJob w; w.g = nullptr; w.vlo = 0; w.vhi = 256; w.kw = 256;
    bf16_t* W = (bf16_t*)(p.ws + OFF_W + (size_t)layer * SZ_WLAYER);
    if (j < 480) { const int nb = j >> 2, kb = j & 3, n0 = nb * 32; int c0;
        if (n0 < 3072) c0 = n0; else if (n0 < 3584) c0 = 3104 + (n0 - 3072); else if (n0 == 3584) c0 = 3072; else { c0 = 0; w.vhi = 0; }
        w.src = p.w_in + (size_t)layer * 1024 * INW + (size_t)kb * 256 * INW + c0; w.ld = INW; w.g = p.norm_mix + layer * 1024 + kb * 256;
        w.dst = (bf16_t*)((char*)W + WO_A) + (size_t)n0 * 1024 + kb * 256; w.ldd = 1024; return w; }
    j -= 480;
    if (j < 256) { const int nb = j >> 2, kb = j & 3, n0 = nb * 32;
        w.src = p.w_in + (size_t)layer * 1024 * INW + (size_t)kb * 256 * INW + 3616 + n0; w.ld = INW; w.g = p.norm_mix + layer * 1024 + kb * 256;
        w.dst = (bf16_t*)((char*)W + WO_B) + (size_t)n0 * 1024 + kb * 256; w.ldd = 1024; return w; }
    j -= 256;
    if (j < 128) { const int nb = j >> 2, kb = j & 3, n0 = nb * 32;
        w.src = p.w_ga + (size_t)layer * 1024 * 1024 + (size_t)kb * 256 * 1024 + n0; w.ld = 1024;
        w.dst = (bf16_t*)((char*)W + WO_GA) + (size_t)n0 * 1024 + kb * 256; w.ldd = 1024; return w; }
    j -= 128;
    if (j < 64) { const int nb = j >> 1, kb = j & 1, n0 = nb * 32, grp = n0 >> 8;
        w.src = p.w_pool + (size_t)layer * 4 * 128 * 256 + (size_t)grp * 128 * 256 + (n0 & 255); w.ld = 256;
        w.vlo = 0; w.vhi = kb == 0 ? 128 : 0; w.kw = kb == 0 ? 128 : 0;
        w.dst = (bf16_t*)((char*)W + WO_POOL) + (size_t)n0 * 128; w.ldd = 128; return w; }
    j -= 64;
    if (j < 128) { const int nb = j >> 2, kb = j & 3, n0 = nb * 32;
        w.src = p.w_out + (size_t)layer * 1024 * 1024 + (size_t)kb * 256 * 1024 + n0; w.ld = 1024;
        w.dst = (bf16_t*)((char*)W + WO_OUT) + (size_t)n0 * 1024 + kb * 256; w.ldd = 1024; return w; }
    j -= 128;
    if (j < 704) { const int nb = j >> 2, kb = j & 3, n0 = nb * 32, pn = n0 >> 8, within = n0 & 255;
        const int c0 = within < 128 ? 128 * pn + within : DFF + 128 * pn + (within - 128);
        w.src = p.w_f1 + (size_t)layer * 1024 * 2 * DFF + (size_t)kb * 256 * 2 * DFF + c0; w.ld = 2 * DFF; w.g = p.norm_ffn + layer * 1024 + kb * 256;
        w.dst = (bf16_t*)((char*)W + WO_F1) + (size_t)n0 * 1024 + kb * 256; w.ldd = 1024; return w; }
    j -= 704;
    { const int nb = j / 11, kb = j % 11, n0 = nb * 32;
        w.src = p.w_f2 + (size_t)layer * DFF * 1024 + (size_t)kb * 256 * 1024 + n0; w.ld = 1024;
        w.dst = (bf16_t*)((char*)W + WO_F2) + (size_t)n0 * DFF + kb * 256; w.ldd = DFF; return w; }
}

__device__ __forceinline__ void phase_prep(LAS unsigned char* lds, const Params& p) {
    int tid = threadIdx.x; asm volatile("" : "+v"(tid));
    const int wid = tid >> 6, lane = tid & 63;
    for (int job = blockIdx.x; job < 2 * 2112; job += gridDim.x) {
        const int layer = job / 2112; const WJob w = wjob_decode(p, layer, job % 2112);
#pragma unroll
        for (int ps = 0; ps < 4; ++ps) {
            const int kk = (tid >> 3) + 64 * ps, c4 = (tid & 7) * 4;
            f32x4 v = (f32x4){0.f, 0.f, 0.f, 0.f};
            if (kk >= w.vlo && kk < w.vhi) { v = *(const f32x4*)(w.src + (size_t)kk * w.ld + c4); if (w.g) v = v * w.g[kk]; }
#pragma unroll
            for (int e = 0; e < 4; ++e) *(LAS float*)(lds + (kk * 33 + c4 + e) * 4) = v[e];
        }
        __syncthreads();
        { const int n = tid & 31, s = tid >> 5; unsigned pk[8];
#pragma unroll
            for (int e = 0; e < 8; ++e) { const float a = *(LAS float*)(lds + ((s * 16 + 2 * e) * 33 + n) * 4), b = *(LAS float*)(lds + ((s * 16 + 2 * e + 1) * 33 + n) * 4); pk[e] = cvt_pk_bf16(a, b); }
            bf16_t* d = w.dst + (size_t)n * w.ldd + s * 16;
            if (s * 16 < w.kw) { *(u32x4*)d = (u32x4){pk[0], pk[1], pk[2], pk[3]}; *(u32x4*)(d + 8) = (u32x4){pk[4], pk[5], pk[6], pk[7]}; } }
        __syncthreads();
    }
    bf16_t* xb = (bf16_t*)(p.ws + OFF_XB); float* ssq = (float*)(p.ws + OFF_SSQ);
    for (int row0 = blockIdx.x * 8 + wid; row0 < T_TOK; row0 += gridDim.x * 16) {
        f32x4 v[2][4]; bool ok[2];
#pragma unroll
        for (int u = 0; u < 2; ++u) { const int row = row0 + u * gridDim.x * 8; ok[u] = row < T_TOK;
            if (ok[u]) { const float* src = p.x_in + (size_t)row * 1024 + lane * 16;
#pragma unroll
                for (int i = 0; i < 4; ++i) v[u][i] = *(const f32x4*)(src + 4 * i); } }
#pragma unroll
        for (int u = 0; u < 2; ++u) if (ok[u]) { const int row = row0 + u * gridDim.x * 8;
            float s = 0.f;
#pragma unroll
            for (int i = 0; i < 4; ++i) s += (v[u][i][0] * v[u][i][0] + v[u][i][1] * v[u][i][1]) + (v[u][i][2] * v[u][i][2] + v[u][i][3] * v[u][i][3]);
#pragma unroll
            for (int o = 32; o >= 1; o >>= 1) s += __shfl_xor(s, o);
            bf16_t* dst = xb + (size_t)row * 1024 + lane * 16;
            *(u32x4*)dst = pack8(v[u][0], v[u][1]); *(u32x4*)(dst + 8) = pack8(v[u][2], v[u][3]);
            if (lane < 16) ssq[(size_t)row * 16 + lane] = lane == 0 ? s : 0.f;
            if (lane == 0) ((float*)(p.ws + OFF_RS))[row] = rsqrtf(s * (1.f / 1024.f) + 1e-6f); }
    }
}

#define MFMA16(a, b, c) __builtin_amdgcn_mfma_f32_16x16x32_bf16((a), (b), (c), 0, 0, 0)
template <bool PASS2>
__device__ __forceinline__ void gla_pass(LAS unsigned char* lds, const Params& p, int layer) {
    constexpr int SQ = 0, SKD = 17408, SV = 35840, SP = 69632, SLR = 78848, SDEC = 84992, SST = 85504, SK = SST, SX = SST + 17408, SCOL = SST + 51200;
    int tid = threadIdx.x; asm volatile("" : "+v"(tid));
    const int wid = __builtin_amdgcn_readfirstlane(tid >> 6), lane = tid & 63, fr = lane & 15, fq = lane >> 4;
    const int dk0 = (tid & 63) * 2;
    bf16_t* P = (bf16_t*)(p.ws + OFF_PROJ);
    const bf16_t* LR = (const bf16_t*)(p.ws + OFF_LR);
    bf16_t* E = (bf16_t*)(p.ws + OFF_E);
    bf16_t* QT = (bf16_t*)(p.ws + OFF_E + (size_t)32 * 1024 * 1024);
    float* DL = (float*)(p.ws + OFF_DLOG);
    bf16_t* O = (bf16_t*)(p.ws + OFF_O);
    for (int item = blockIdx.x; item < 256; item += gridDim.x) {
        const int b = item >> 7, h = (item >> 5) & 3, grp = item & 31;
#pragma unroll 1
        for (int dir = 0; dir < 2; ++dir) {
            const int scan = (b * 4 + h) * 2 + dir;
            bf16x8 wB1, wB2; float biasx;
            { const float* Wc = (dir ? p.wdu_b : p.wdu_f) + (size_t)layer * 16 * 512 + h * 128 + wid * 16 + fr;
              float wv[8]; unsigned h1[4], h2[4];
#pragma unroll
              for (int j = 0; j < 8; ++j) wv[j] = Wc[((fq & 1) * 8 + j) * 512];
#pragma unroll
              for (int jp = 0; jp < 4; ++jp) { const float a = wv[2 * jp], bq = wv[2 * jp + 1]; const unsigned hi = cvt_pk_bf16(a, bq);
                  const unsigned lo = cvt_pk_bf16(a - bflo(hi), bq - bfhi(hi)); h1[jp] = hi; h2[jp] = fq < 2 ? lo : 0u; }
              wB1 = __builtin_bit_cast(bf16x8, (u32x4){h1[0], h1[1], h1[2], h1[3]}); wB2 = __builtin_bit_cast(bf16x8, (u32x4){h2[0], h2[1], h2[2], h2[3]});
              biasx = (dir ? p.bd_b : p.bd_f)[layer * 512 + h * 128 + wid * 16 + fr]; }
            f32x4 accS[8][2];
            bf16_t* Eit = E + (size_t)(scan * 32 + grp) * 32768 + (size_t)(wid * 32 + fr) * 128 + 4 * fq;
#pragma unroll
            for (int m8 = 0; m8 < 8; ++m8)
#pragma unroll
                for (int n = 0; n < 2; ++n) accS[m8][n] = (f32x4){0.f, 0.f, 0.f, 0.f};
            float gtot0 = 0.f, gtot1 = 0.f;
            u32x4 rk[2], rq[2], rv[4]; u32x4 rl = (u32x4){0u, 0u, 0u, 0u};
#define GLA_ISSUE(CC) do { const int chunk_ = dir ? 7 - (CC) : (CC); const int t0_ = b * SEQL + grp * 512 + chunk_ * 64; \
                _Pragma("unroll") for (int it = 0; it < 2; ++it) { const int pi = tid + 512 * it, row = pi >> 4, seg = pi & 15; \
                    const bf16_t* src = P + (size_t)(t0_ + row) * PW + h * 128 + seg * 8; rk[it] = *(const u32x4*)(src + 512); } \
                if (tid < 256) { const int row = tid >> 2, seg = tid & 3; rl = *(const u32x4*)(LR + (size_t)(t0_ + row) * 64 + dir * 32 + seg * 8); } } while (0)
            GLA_ISSUE(0);
#pragma unroll 1
            for (int cc = 0; cc < 8; ++cc) {
                const int chunk = dir ? 7 - cc : cc;
                const int t0 = b * SEQL + grp * 512 + chunk * 64;
#pragma unroll
                for (int it = 0; it < 2; ++it) { const int pi = tid + 512 * it, row = pi >> 4, seg = pi & 15;
                    *(LAS u32x4*)(lds + SK + row * 272 + seg * 16) = rk[it];
                    if (PASS2) rq[it] = *(const u32x4*)(P + (size_t)(t0 + row) * PW + h * 128 + seg * 8); }
#pragma unroll
                for (int it = 0; it < 4; ++it) { const int pi = tid + 512 * it, row = pi >> 5, seg = pi & 31;
                    rv[it] = *(const u32x4*)(P + (size_t)(t0 + row) * PW + 1024 + h * 256 + seg * 8); }
                if (tid < 256) { const int row = tid >> 2, seg = tid & 3; *(LAS u32x4*)(lds + SLR + row * 64 + seg * 16) = rl; }
                __syncthreads();
#pragma unroll 1
                for (int m = 0; m < 4; ++m) {
                    const bf16x8 A = *(LAS bf16x8*)(lds + SLR + (m * 16 + fr) * 64 + fq * 16);
                    f32x4 xx = (f32x4){0.f, 0.f, 0.f, 0.f};
                    xx = MFMA16(A, wB1, xx); xx = MFMA16(A, wB2, xx);
#pragma unroll
                    for (int jj = 0; jj < 4; ++jj) { const float x = xx[jj] + biasx; const float ls = fminf(x, 0.f) - __logf(1.f + __expf(-fabsf(x)));
                        *(LAS float*)(lds + SX + ((m * 16 + 4 * fq + jj) * 132 + wid * 16 + fr) * 4) = ls * 0.0625f; }
                }
                if (PASS2) {
#pragma unroll
                    for (int it = 0; it < 2; ++it) { const int pi = tid + 512 * it, row = pi >> 4, seg = pi & 15; *(LAS u32x4*)(lds + SQ + row * 272 + seg * 16) = rq[it]; } }
                __syncthreads();
                float c0[8], c1[8];
#pragma unroll
                for (int e = 0; e < 8; ++e) { const f32x2 t2 = *(LAS f32x2*)(lds + SX + ((wid * 8 + e) * 132 + dk0) * 4); c0[e] = t2.x; c1[e] = t2.y; }
                if (dir == 0) {
#pragma unroll
                    for (int e = 1; e < 8; ++e) { c0[e] += c0[e - 1]; c1[e] += c1[e - 1]; }
                } else {
#pragma unroll
                    for (int e = 6; e >= 0; --e) { c0[e] += c0[e + 1]; c1[e] += c1[e + 1]; }
                }
                { f32x2 t2; t2.x = dir == 0 ? c0[7] : c0[0]; t2.y = dir == 0 ? c1[7] : c1[0]; *(LAS f32x2*)(lds + SCOL + (wid * 128 + dk0) * 4) = t2; }
                __syncthreads();
                float tot0 = 0.f, tot1 = 0.f, offs0 = 0.f, offs1 = 0.f;
#pragma unroll
                for (int s = 0; s < 8; ++s) { const f32x2 t2 = *(LAS f32x2*)(lds + SCOL + (s * 128 + dk0) * 4); tot0 += t2.x; tot1 += t2.y;
                    const bool inc = dir == 0 ? (s < wid) : (s > wid); offs0 += inc ? t2.x : 0.f; offs1 += inc ? t2.y : 0.f; }
                const float etot0 = __expf(tot0), etot1 = __expf(tot1), eg0 = __expf(gtot0), eg1 = __expf(gtot1);
                unsigned kd0p[4], kd1p[4]; float kd0prev = 0.f, kd1prev = 0.f;
#pragma unroll
                for (int e = 0; e < 8; ++e) { const int i = wid * 8 + e;
                    const float ec0 = __expf(c0[e] + offs0), ec1 = __expf(c1[e] + offs1), inv0 = __builtin_amdgcn_rcpf(ec0), inv1 = __builtin_amdgcn_rcpf(ec1);
                    const unsigned kw = *(LAS unsigned*)(lds + SK + i * 272 + dk0 * 2);
                    const float k0 = bflo(kw), k1 = bfhi(kw);
                    const float kd0 = k0 * (etot0 * inv0), kd1 = k1 * (etot1 * inv1);
                    if (PASS2) { const unsigned qw = *(LAS unsigned*)(lds + SQ + i * 272 + dk0 * 2);
                        const float qe0 = bflo(qw) * 0.08838834764831845f * ec0, qe1 = bfhi(qw) * 0.08838834764831845f * ec1;
                        *(LAS unsigned*)(lds + SQ + i * 272 + dk0 * 2) = cvt_pk_bf16(qe0, qe1);
                        const unsigned qt = cvt_pk_bf16(qe0 * eg0, qe1 * eg1);
                        if (dir == 0) *(unsigned*)(QT + (size_t)(t0 + i) * 512 + h * 128 + dk0) = qt; else *(unsigned*)(P + (size_t)(t0 + i) * PW + h * 128 + dk0) = qt;
                        *(LAS unsigned*)(lds + SK + i * 272 + dk0 * 2) = cvt_pk_bf16(k0 * inv0, k1 * inv1); }
                    if (e & 1) { kd0p[e >> 1] = cvt_pk_bf16(kd0prev, kd0); kd1p[e >> 1] = cvt_pk_bf16(kd1prev, kd1); } else { kd0prev = kd0; kd1prev = kd1; } }
                *(LAS u32x4*)(lds + SKD + dk0 * 144 + wid * 16) = (u32x4){kd0p[0], kd0p[1], kd0p[2], kd0p[3]};
                *(LAS u32x4*)(lds + SKD + (dk0 + 1) * 144 + wid * 16) = (u32x4){kd1p[0], kd1p[1], kd1p[2], kd1p[3]};
                if (wid == 0) { f32x2 t2; t2.x = etot0; t2.y = etot1; *(LAS f32x2*)(lds + SDEC + dk0 * 4) = t2; }
                gtot0 += tot0; gtot1 += tot1;
#pragma unroll
                for (int it = 0; it < 4; ++it) { const int pi = tid + 512 * it, row = pi >> 5, seg = pi & 31;
                    *(LAS u32x4*)(lds + SV + row * 528 + seg * 16) = rv[it]; }
                __syncthreads();
                if (PASS2) {
                    f32x4 accP[2];
#pragma unroll
                    for (int s = 0; s < 2; ++s) { const int tt = wid * 2 + s, ib = tt >> 2, jb = tt & 3; f32x4 a = (f32x4){0.f, 0.f, 0.f, 0.f};
#pragma unroll
                        for (int kb = 0; kb < 4; ++kb) { const bf16x8 A = *(LAS bf16x8*)(lds + SK + (jb * 16 + fr) * 272 + (kb * 32 + fq * 8) * 2);
                            const bf16x8 B = *(LAS bf16x8*)(lds + SQ + (ib * 16 + fr) * 272 + (kb * 32 + fq * 8) * 2); a = MFMA16(A, B, a); }
                        accP[s] = a; }
                    __syncthreads();
#pragma unroll
                    for (int s = 0; s < 2; ++s) { const int tt = wid * 2 + s, ib = tt >> 2, jb = tt & 3; const int i = ib * 16 + fr, jbase = jb * 16 + 4 * fq; float v[4];
#pragma unroll
                        for (int jj = 0; jj < 4; ++jj) { const int j = jbase + jj; const bool keep = dir == 0 ? (j <= i) : (j > i); v[jj] = keep ? accP[s][jj] : 0.f; }
                        *(LAS u32x2*)(lds + SP + i * 144 + jbase * 2) = (u32x2){cvt_pk_bf16(v[0], v[1]), cvt_pk_bf16(v[2], v[3])}; }
#pragma unroll
                    for (int m8 = 0; m8 < 8; ++m8)
#pragma unroll
                        for (int n = 0; n < 2; ++n) { const f32x4 sv = accS[m8][n];
                            *(LAS u32x2*)(lds + SST + (wid * 32 + n * 16 + fr) * 272 + (m8 * 16 + 4 * fq) * 2) = (u32x2){cvt_pk_bf16(sv[0], sv[1]), cvt_pk_bf16(sv[2], sv[3])}; }
                    __syncthreads();
                }
                bf16x8 vf[2][2];
#pragma unroll
                for (int n = 0; n < 2; ++n)
#pragma unroll
                    for (int kb2 = 0; kb2 < 2; ++kb2) { unsigned w[4];
#pragma unroll
                        for (int jp = 0; jp < 4; ++jp) { const unsigned lo = *(LAS unsigned short*)(lds + SV + (kb2 * 32 + fq * 8 + 2 * jp) * 528 + (wid * 32 + n * 16 + fr) * 2);
                            const unsigned hi = *(LAS unsigned short*)(lds + SV + (kb2 * 32 + fq * 8 + 2 * jp + 1) * 528 + (wid * 32 + n * 16 + fr) * 2); w[jp] = lo | (hi << 16); }
                        vf[n][kb2] = __builtin_bit_cast(bf16x8, (u32x4){w[0], w[1], w[2], w[3]}); }
                if (PASS2) {
#pragma unroll
                    for (int n = 0; n < 2; ++n) {
                        f32x4 accO[4];
#pragma unroll
                        for (int m = 0; m < 4; ++m) accO[m] = (f32x4){0.f, 0.f, 0.f, 0.f};
#pragma unroll
                        for (int kb = 0; kb < 4; ++kb) { const bf16x8 A = *(LAS bf16x8*)(lds + SST + (wid * 32 + n * 16 + fr) * 272 + (kb * 32 + fq * 8) * 2);
#pragma unroll
                            for (int m = 0; m < 4; ++m) { const bf16x8 B = *(LAS bf16x8*)(lds + SQ + (m * 16 + fr) * 272 + (kb * 32 + fq * 8) * 2); accO[m] = MFMA16(A, B, accO[m]); } }
#pragma unroll
                        for (int kb2 = 0; kb2 < 2; ++kb2)
#pragma unroll
                            for (int m = 0; m < 4; ++m) { const bf16x8 B = *(LAS bf16x8*)(lds + SP + (m * 16 + fr) * 144 + (kb2 * 32 + fq * 8) * 2); accO[m] = MFMA16(vf[n][kb2], B, accO[m]); }
#pragma unroll
                        for (int m = 0; m < 4; ++m) { bf16_t* dst = O + (size_t)(t0 + m * 16 + fr) * 1024 + h * 256 + wid * 32 + n * 16 + 4 * fq; f32x4 v = accO[m];
                            if (dir) { const u32x2 old = *(const u32x2*)dst; v[0] += bflo(old.x); v[1] += bfhi(old.x); v[2] += bflo(old.y); v[3] += bfhi(old.y); }
                            *(u32x2*)dst = (u32x2){cvt_pk_bf16(v[0], v[1]), cvt_pk_bf16(v[2], v[3])}; }
                        asm volatile("" ::: "memory");
                    }
                }
                if (cc < 7) GLA_ISSUE(cc + 1);
#pragma unroll
                for (int m8 = 0; m8 < 8; ++m8) { const f32x4 d = *(LAS f32x4*)(lds + SDEC + (m8 * 16 + 4 * fq) * 4);
#pragma unroll
                    for (int n = 0; n < 2; ++n) accS[m8][n] = accS[m8][n] * d;
#pragma unroll
                    for (int kb2 = 0; kb2 < 2; ++kb2) { const bf16x8 A = *(LAS bf16x8*)(lds + SKD + (m8 * 16 + fr) * 144 + (kb2 * 32 + fq * 8) * 2);
#pragma unroll
                        for (int n = 0; n < 2; ++n) accS[m8][n] = MFMA16(A, vf[n][kb2], accS[m8][n]); } }
                __syncthreads();
            }
            {
#pragma unroll
                for (int m8 = 0; m8 < 8; ++m8)
#pragma unroll
                    for (int n = 0; n < 2; ++n)
                        *(u32x2*)(Eit + n * 16 * 128 + m8 * 16) = (u32x2){cvt_pk_bf16(accS[m8][n][0], accS[m8][n][1]), cvt_pk_bf16(accS[m8][n][2], accS[m8][n][3])};
                if (wid == 0) { DL[(scan * 32 + grp) * 128 + dk0] = gtot0; DL[(scan * 32 + grp) * 128 + dk0 + 1] = gtot1; }
            }
        }
    }
}

#undef GLA_ISSUE
__device__ __forceinline__ void phase_combine(const Params& p) {
    bf16_t* E = (bf16_t*)(p.ws + OFF_E); const float* DL = (const float*)(p.ws + OFF_DLOG);
    int tid = threadIdx.x; asm volatile("" : "+v"(tid));
    for (int idx = blockIdx.x * 512 + tid; idx < 16 * 4096; idx += gridDim.x * 512) {
        const int scan = idx >> 12, e8 = idx & 4095, dk0 = (e8 & 15) * 8, dir = scan & 1;
        float R[8];
#pragma unroll
        for (int i = 0; i < 8; ++i) R[i] = 0.f;
#pragma unroll 1
        for (int q4 = 0; q4 < 4; ++q4) {
            u32x4 ev[8]; f32x4 d0[8], d1[8];
#pragma unroll
            for (int gg = 0; gg < 8; ++gg) { const int go = q4 * 8 + gg, g = dir ? 31 - go : go;
                ev[gg] = *(const u32x4*)(E + (size_t)(scan * 32 + g) * 32768 + e8 * 8);
                d0[gg] = *(const f32x4*)(DL + (scan * 32 + g) * 128 + dk0); d1[gg] = *(const f32x4*)(DL + (scan * 32 + g) * 128 + dk0 + 4); }
#pragma unroll
            for (int gg = 0; gg < 8; ++gg) { const int go = q4 * 8 + gg, g = dir ? 31 - go : go;
                *(u32x4*)(E + (size_t)(scan * 32 + g) * 32768 + e8 * 8) = (u32x4){cvt_pk_bf16(R[0], R[1]), cvt_pk_bf16(R[2], R[3]), cvt_pk_bf16(R[4], R[5]), cvt_pk_bf16(R[6], R[7])};
                const u32x4 w = ev[gg];
                R[0] = R[0] * __expf(d0[gg][0]) + bflo(w.x); R[1] = R[1] * __expf(d0[gg][1]) + bfhi(w.x); R[2] = R[2] * __expf(d0[gg][2]) + bflo(w.y); R[3] = R[3] * __expf(d0[gg][3]) + bfhi(w.y);
                R[4] = R[4] * __expf(d1[gg][0]) + bflo(w.z); R[5] = R[5] * __expf(d1[gg][1]) + bfhi(w.z); R[6] = R[6] * __expf(d1[gg][2]) + bflo(w.w); R[7] = R[7] * __expf(d1[gg][3]) + bfhi(w.w); }
        }
    }
}

__device__ __forceinline__ void gla_light(LAS unsigned char* lds, const Params& p, int layer) {
    constexpr int SSTF = 0, SSTB = 69632, SSS = 139264;
    int tid = threadIdx.x; asm volatile("" : "+v"(tid));
    const int wid = __builtin_amdgcn_readfirstlane(tid >> 6), lane = tid & 63, fr = lane & 15, fq = lane >> 4, mt = wid & 3, hv = wid >> 2;
    bf16_t* P = (bf16_t*)(p.ws + OFF_PROJ);
    const bf16_t* E = (const bf16_t*)(p.ws + OFF_E);
    const bf16_t* QT = (const bf16_t*)(p.ws + OFF_E + (size_t)32 * 1024 * 1024);
    const bf16_t* O = (const bf16_t*)(p.ws + OFF_O);
    for (int item = blockIdx.x; item < 256; item += gridDim.x) {
        const int b = item >> 7, h = (item >> 5) & 3, grp = item & 31;
        const int scanf = (b * 4 + h) * 2;
        __syncthreads();
#pragma unroll
        for (int it = 0; it < 8; ++it) { const int pi = tid + 512 * it, row = pi >> 4, seg = pi & 15;
            const u32x4 vf_ = *(const u32x4*)(E + (size_t)(scanf * 32 + grp) * 32768 + row * 128 + seg * 8);
            const u32x4 vb_ = *(const u32x4*)(E + (size_t)((scanf + 1) * 32 + grp) * 32768 + row * 128 + seg * 8);
            *(LAS u32x4*)(lds + SSTF + row * 272 + seg * 16) = vf_; *(LAS u32x4*)(lds + SSTB + row * 272 + seg * 16) = vb_; }
        __syncthreads();
        f32x4 gn[8];
#pragma unroll
        for (int n = 0; n < 8; ++n) gn[n] = *(const f32x4*)(p.gla_norm + layer * 1024 + h * 256 + hv * 128 + n * 16 + 4 * fq);
#pragma unroll 1
        for (int cc = 0; cc < 8; ++cc) {
            const size_t tok = (size_t)(b * SEQL + grp * 512 + cc * 64 + mt * 16 + fr);
            bf16x8 bq[2][4];
#pragma unroll
            for (int kb = 0; kb < 4; ++kb) { bq[0][kb] = *(const bf16x8*)(QT + tok * 512 + h * 128 + kb * 32 + fq * 8); bq[1][kb] = *(const bf16x8*)(P + tok * PW + h * 128 + kb * 32 + fq * 8); }
            u32x2 oo[8], rr[8];
#pragma unroll
            for (int n = 0; n < 8; ++n) { oo[n] = *(const u32x2*)(O + tok * 1024 + h * 256 + hv * 128 + n * 16 + 4 * fq);
                rr[n] = *(const u32x2*)(P + tok * PW + 2048 + h * 256 + hv * 128 + n * 16 + 4 * fq); }
            f32x4 accO[8];
#pragma unroll
            for (int n = 0; n < 8; ++n) accO[n] = (f32x4){0.f, 0.f, 0.f, 0.f};
#pragma unroll
            for (int dir = 0; dir < 2; ++dir)
#pragma unroll
                for (int kb = 0; kb < 4; ++kb)
#pragma unroll
                    for (int n = 0; n < 8; ++n) { const bf16x8 A = *(LAS bf16x8*)(lds + (dir ? SSTB : SSTF) + (hv * 128 + n * 16 + fr) * 272 + (kb * 32 + fq * 8) * 2);
                        accO[n] = MFMA16(A, bq[dir][kb], accO[n]); }
            float s = 0.f;
#pragma unroll
            for (int n = 0; n < 8; ++n) { f32x4 v = accO[n]; v[0] += bflo(oo[n].x); v[1] += bfhi(oo[n].x); v[2] += bflo(oo[n].y); v[3] += bfhi(oo[n].y); accO[n] = v;
                s += (v[0] * v[0] + v[1] * v[1]) + (v[2] * v[2] + v[3] * v[3]); }
            s += __shfl_xor(s, 16); s += __shfl_xor(s, 32);
            const int sb = SSS + (cc & 1) * 512;
            if (fq == 0) *(LAS float*)(lds + sb + (hv * 64 + mt * 16 + fr) * 4) = s;
            __syncthreads();
            const float tot = *(LAS float*)(lds + sb + (mt * 16 + fr) * 4) + *(LAS float*)(lds + sb + (64 + mt * 16 + fr) * 4);
            const float rn = rsqrtf(tot * (1.f / 256.f) + 1e-6f);
#pragma unroll
            for (int n = 0; n < 8; ++n) { const float r0 = bflo(rr[n].x), r1 = bfhi(rr[n].x), r2 = bflo(rr[n].y), r3 = bfhi(rr[n].y);
                const f32x4 v = accO[n] * rn * gn[n];
                *(u32x2*)(P + tok * PW + 2048 + h * 256 + hv * 128 + n * 16 + 4 * fq) =
                    (u32x2){cvt_pk_bf16(v[0] * (r0 * sigmoidf_(r0)), v[1] * (r1 * sigmoidf_(r1))), cvt_pk_bf16(v[2] * (r2 * sigmoidf_(r2)), v[3] * (r3 * sigmoidf_(r3)))}; }
        }
    }
}

__device__ __forceinline__ void phase_gating(const Params& p, int layer) {
    int tid = threadIdx.x; asm volatile("" : "+v"(tid));
    const int wid = tid >> 6, lane = tid & 63;
    bf16_t* P = (bf16_t*)(p.ws + OFF_PROJ); const bf16_t* O = (const bf16_t*)(p.ws + OFF_O);
    const float* gn = p.gla_norm + layer * 1024 + lane * 16;
    f32x4 g4[4];
#pragma unroll
    for (int i = 0; i < 4; ++i) g4[i] = *(const f32x4*)(gn + 4 * i);
    for (int t0 = blockIdx.x * 8 + wid; t0 < T_TOK; t0 += gridDim.x * 16) {
        u32x4 oo[2][2], rr[2][2]; bool ok[2];
#pragma unroll
        for (int u = 0; u < 2; ++u) { const int t = t0 + u * gridDim.x * 8; ok[u] = t < T_TOK;
            if (ok[u]) { oo[u][0] = *(const u32x4*)(O + (size_t)t * 1024 + lane * 16); oo[u][1] = *(const u32x4*)(O + (size_t)t * 1024 + lane * 16 + 8);
                const bf16_t* rp = P + (size_t)t * PW + 2048 + lane * 16; rr[u][0] = *(const u32x4*)rp; rr[u][1] = *(const u32x4*)(rp + 8); } }
#pragma unroll
        for (int u = 0; u < 2; ++u) if (ok[u]) { const int t = t0 + u * gridDim.x * 8;
            bf16_t* rp = P + (size_t)t * PW + 2048 + lane * 16;
            const u32x4 o0 = oo[u][0], o1 = oo[u][1], r0 = rr[u][0], r1 = rr[u][1];
            float ov[16], rv[16];
            ov[0] = bflo(o0.x); ov[1] = bfhi(o0.x); ov[2] = bflo(o0.y); ov[3] = bfhi(o0.y); ov[4] = bflo(o0.z); ov[5] = bfhi(o0.z); ov[6] = bflo(o0.w); ov[7] = bfhi(o0.w);
            ov[8] = bflo(o1.x); ov[9] = bfhi(o1.x); ov[10] = bflo(o1.y); ov[11] = bfhi(o1.y); ov[12] = bflo(o1.z); ov[13] = bfhi(o1.z); ov[14] = bflo(o1.w); ov[15] = bfhi(o1.w);
            rv[0] = bflo(r0.x); rv[1] = bfhi(r0.x); rv[2] = bflo(r0.y); rv[3] = bfhi(r0.y); rv[4] = bflo(r0.z); rv[5] = bfhi(r0.z); rv[6] = bflo(r0.w); rv[7] = bfhi(r0.w);
            rv[8] = bflo(r1.x); rv[9] = bfhi(r1.x); rv[10] = bflo(r1.y); rv[11] = bfhi(r1.y); rv[12] = bflo(r1.z); rv[13] = bfhi(r1.z); rv[14] = bflo(r1.w); rv[15] = bfhi(r1.w);
            float s = 0.f;
#pragma unroll
            for (int i = 0; i < 16; ++i) s += ov[i] * ov[i];
            s += __shfl_xor(s, 8); s += __shfl_xor(s, 4); s += __shfl_xor(s, 2); s += __shfl_xor(s, 1);
            const float rn = rsqrtf(s * (1.f / 256.f) + 1e-6f);
            float out[16];
#pragma unroll
            for (int i = 0; i < 16; ++i) { const float r = rv[i]; out[i] = ov[i] * rn * g4[i >> 2][i & 3] * (r * sigmoidf_(r)); }
            *(u32x4*)rp = (u32x4){cvt_pk_bf16(out[0], out[1]), cvt_pk_bf16(out[2], out[3]), cvt_pk_bf16(out[4], out[5]), cvt_pk_bf16(out[6], out[7])};
            *(u32x4*)(rp + 8) = (u32x4){cvt_pk_bf16(out[8], out[9]), cvt_pk_bf16(out[10], out[11]), cvt_pk_bf16(out[12], out[13]), cvt_pk_bf16(out[14], out[15])}; }
    }
}

template <int HW>
__device__ __forceinline__ void pool_run(const bf16_t* P, bf16_t* PO, int t0, int c8) {
    constexpr int NR = 16 + 2 * HW - 1;
    const int pos0 = t0 & (SEQL - 1);
    const bf16_t* base = P + (size_t)t0 * PW + 3072 + c8 * 8;
    u32x4 v[NR];
#pragma unroll
    for (int k = 0; k < NR; ++k) { const int off = k - HW, tt = pos0 + off;
        v[k] = (tt >= 0 && tt < SEQL) ? *(const u32x4*)(base + (long)off * PW) : (u32x4){0u, 0u, 0u, 0u}; }
    float w[8];
#pragma unroll
    for (int i = 0; i < 8; ++i) w[i] = 0.f;
#pragma unroll
    for (int k = 0; k < 2 * HW; ++k) { w[0] += bflo(v[k].x); w[1] += bfhi(v[k].x); w[2] += bflo(v[k].y); w[3] += bfhi(v[k].y); w[4] += bflo(v[k].z); w[5] += bfhi(v[k].z); w[6] += bflo(v[k].w); w[7] += bfhi(v[k].w); }
#pragma unroll
    for (int i = 0; i < 16; ++i) {
        if (i > 0) { const u32x4 a = v[i + 2 * HW - 1], s = v[i - 1];
            w[0] += bflo(a.x) - bflo(s.x); w[1] += bfhi(a.x) - bfhi(s.x); w[2] += bflo(a.y) - bflo(s.y); w[3] += bfhi(a.y) - bfhi(s.y);
            w[4] += bflo(a.z) - bflo(s.z); w[5] += bfhi(a.z) - bfhi(s.z); w[6] += bflo(a.w) - bflo(s.w); w[7] += bfhi(a.w) - bfhi(s.w); }
        const int pos = pos0 + i, lo = pos - HW < 0 ? 0 : pos - HW, hi = pos + HW > SEQL ? SEQL : pos + HW;
        const float ic = 1.f / (float)(hi - lo);
        const u32x4 c = v[HW + i];
        *(u32x4*)(PO + (size_t)(t0 + i) * 512 + c8 * 8) = (u32x4){cvt_pk_bf16(w[0] * ic - bflo(c.x), w[1] * ic - bfhi(c.x)), cvt_pk_bf16(w[2] * ic - bflo(c.y), w[3] * ic - bfhi(c.y)),
                                                                 cvt_pk_bf16(w[4] * ic - bflo(c.z), w[5] * ic - bfhi(c.z)), cvt_pk_bf16(w[6] * ic - bflo(c.w), w[7] * ic - bfhi(c.w))};
    }
}
__device__ __forceinline__ void phase_pool(const Params& p) {
    const bf16_t* P = (const bf16_t*)(p.ws + OFF_PROJ); bf16_t* PO = (bf16_t*)(p.ws + OFF_E);
    int tid = threadIdx.x; asm volatile("" : "+v"(tid));
    const int wid = __builtin_amdgcn_readfirstlane(tid >> 6), lane = tid & 63;
    for (int wi = blockIdx.x * 8 + wid; wi < T_TOK / 16; wi += gridDim.x * 8) {
        const int grp = wi & 3, t0 = (wi >> 2) * 64 + (lane >> 4) * 16, c8 = grp * 16 + (lane & 15);
        if (grp == 0) pool_run<1>(P, PO, t0, c8); else if (grp == 1) pool_run<2>(P, PO, t0, c8); else if (grp == 2) pool_run<4>(P, PO, t0, c8); else pool_run<8>(P, PO, t0, c8);
    }
}

__device__ __forceinline__ void phase_final(const Params& p) {
    int tid = threadIdx.x; asm volatile("" : "+v"(tid));
    const int wid = tid >> 6, lane = tid & 63;
    const float* ssq = (const float*)(p.ws + OFF_SSQ); const bf16_t* xb = (const bf16_t*)(p.ws + OFF_XB);
    f32x4 g4[4];
#pragma unroll
    for (int i = 0; i < 4; ++i) g4[i] = *(const f32x4*)(p.norm_final + lane * 16 + 4 * i);
    for (int row0 = blockIdx.x * 8 + wid; row0 < T_TOK; row0 += gridDim.x * 32) {
        u32x4 v[4][2]; float rs[4]; bool ok[4];
#pragma unroll
        for (int u = 0; u < 4; ++u) { const int row = row0 + u * gridDim.x * 8; ok[u] = row < T_TOK;
            if (ok[u]) { rs[u] = rowscale(ssq, row); const bf16_t* xp = xb + (size_t)row * 1024 + lane * 16; v[u][0] = *(const u32x4*)xp; v[u][1] = *(const u32x4*)(xp + 8); } }
#pragma unroll
        for (int u = 0; u < 4; ++u) if (ok[u]) { const int row = row0 + u * gridDim.x * 8; float* op = p.xf + (size_t)row * 1024 + lane * 16; const float r = rs[u];
            *(f32x4*)(op) = (f32x4){bflo(v[u][0].x), bfhi(v[u][0].x), bflo(v[u][0].y), bfhi(v[u][0].y)} * r * g4[0];
            *(f32x4*)(op + 4) = (f32x4){bflo(v[u][0].z), bfhi(v[u][0].z), bflo(v[u][0].w), bfhi(v[u][0].w)} * r * g4[1];
            *(f32x4*)(op + 8) = (f32x4){bflo(v[u][1].x), bfhi(v[u][1].x), bflo(v[u][1].y), bfhi(v[u][1].y)} * r * g4[2];
            *(f32x4*)(op + 12) = (f32x4){bflo(v[u][1].z), bfhi(v[u][1].z), bflo(v[u][1].w), bfhi(v[u][1].w)} * r * g4[3]; }
    }
}

__device__ __forceinline__ void phase_rs(const Params& p) {
    int tid = threadIdx.x; asm volatile("" : "+v"(tid));
    const float* ssq = (const float*)(p.ws + OFF_SSQ); float* rs = (float*)(p.ws + OFF_RS);
    for (int row = blockIdx.x * 512 + tid; row < T_TOK; row += gridDim.x * 512) rs[row] = rowscale(ssq, row);
}
__device__ __forceinline__ void grid_barrier(unsigned* bar, unsigned k) {
    asm volatile("s_waitcnt vmcnt(0)" ::: "memory");
    __syncthreads();
    if (threadIdx.x == 0) {
        const unsigned nb = gridDim.x, g = blockIdx.x >> 4, ng = (nb + 15u) >> 4, gsz = (nb - 16u * g) < 16u ? (nb - 16u * g) : 16u;
        __builtin_amdgcn_fence(__ATOMIC_RELEASE, "agent");
        asm volatile("s_waitcnt vmcnt(0)" ::: "memory");
        const unsigned old = __hip_atomic_fetch_add(bar + 64 * g, 1u, __ATOMIC_RELAXED, __HIP_MEMORY_SCOPE_AGENT);
        if (old == k * gsz - 1u) {
            const unsigned old2 = __hip_atomic_fetch_add(bar + 64 * 32, 1u, __ATOMIC_RELAXED, __HIP_MEMORY_SCOPE_AGENT);
            if (old2 == k * ng - 1u) for (unsigned j = 0; j < ng; ++j) __hip_atomic_store(bar + 64 * (64 + j), k, __ATOMIC_RELAXED, __HIP_MEMORY_SCOPE_AGENT);
        }
        while (__hip_atomic_load(bar + 64 * (64 + g), __ATOMIC_RELAXED, __HIP_MEMORY_SCOPE_AGENT) < k) __builtin_amdgcn_s_sleep(2);
        __builtin_amdgcn_fence(__ATOMIC_ACQUIRE, "agent");
        asm volatile("s_waitcnt vmcnt(0)" ::: "memory");
    }
    __syncthreads();
}
__global__ void __launch_bounds__(512, 2) mega(const Params p_arg) {
    extern __shared__ __attribute__((aligned(16))) unsigned char shm[];
    LAS unsigned char* lds = (LAS unsigned char*)shm;
    typedef const Params __attribute__((address_space(4))) * KArgPtr;
    const int phase_lo = p_arg.phase_lo, phase_hi = p_arg.phase_hi;
    pg8::StaticOrder S;
    unsigned bar_k = 0;
    for (int ph = phase_lo; ph < phase_hi; ++ph) {
        KArgPtr kp = (KArgPtr)__builtin_amdgcn_kernarg_segment_ptr(); asm volatile("" : "+s"(kp));
        const Params& p = *(const Params*)kp;
        bf16_t* xb = (bf16_t*)(p.ws + OFF_XB); bf16_t* proj = (bf16_t*)(p.ws + OFF_PROJ); float* ssq = (float*)(p.ws + OFF_SSQ);
        if (ph > phase_lo) {
            if (phase_hi > 1000) cg::this_grid().sync();
            grid_barrier((unsigned*)(p.ws + OFF_BAR), ++bar_k);
        }
        if (ph == 0) { phase_prep(lds, p); continue; }
        if (ph == 19) { phase_final(p); continue; }
        const int layer = (ph - 1) / 9, sub = (ph - 1) % 9;
        const char* W = p.ws + OFF_W + (size_t)layer * SZ_WLAYER;
        switch (sub) {
        case 0: { if (layer > 0) { phase_rs(p); grid_barrier((unsigned*)(p.ws + OFF_BAR), ++bar_k); }
                  pg8::Gemm g{xb, (const bf16_t*)(W + WO_A), T_TOK, NA, 1024, 1024}; S.init(g.M, g.N, gridDim.x, blockIdx.x);
                  EpiA e{(const float*)(p.ws + OFF_RS), proj, (bf16_t*)(p.ws + OFF_LR), ssq}; pg8::gemm_phase(lds, g, S, e); } break;
        case 1: gla_pass<true>(lds, p, layer); break;
        case 2: phase_combine(p); break;
        case 3: gla_light(lds, p, layer); break;
        case 4: { pg8::Gemm g{xb, (const bf16_t*)(W + WO_B), T_TOK, NB, 1024, 1024}; S.init(g.M, g.N, gridDim.x, blockIdx.x);
                  EpiGate e{(const float*)(p.ws + OFF_RS), proj, ssq}; pg8::gemm_phase(lds, g, S, e);
                  phase_pool(p); } break;
        case 5: { { pg8::Gemm g{(const bf16_t*)(p.ws + OFF_E), (const bf16_t*)(W + WO_POOL), T_TOK, 1024, 128, 512}; S.init(g.M, g.N, gridDim.x, blockIdx.x);
                    EpiPool e{proj, p.pool_scale + layer * 1024}; pg8::gemm_phase<EpiPool, 256>(lds, g, S, e); }
                  { pg8::Gemm g{proj + 2048, (const bf16_t*)(W + WO_GA), T_TOK, 1024, 1024, PW}; S.init(g.M, g.N, gridDim.x, blockIdx.x);
                    EpiMerge e{proj}; pg8::gemm_phase(lds, g, S, e); } } break;
        case 6: { pg8::Gemm g{proj, (const bf16_t*)(W + WO_OUT), T_TOK, 1024, 1024, PW}; S.init(g.M, g.N, gridDim.x, blockIdx.x);
                  EpiRes e{xb, ssq}; pg8::gemm_phase(lds, g, S, e); } break;
        case 7: { phase_rs(p); grid_barrier((unsigned*)(p.ws + OFF_BAR), ++bar_k);
                  pg8::Gemm g{xb, (const bf16_t*)(W + WO_F1), T_TOK, 2 * DFF, 1024, 1024}; S.init(g.M, g.N, gridDim.x, blockIdx.x);
                  EpiFfn1 e{(const float*)(p.ws + OFF_RS), proj, ssq}; pg8::gemm_phase(lds, g, S, e); } break;
        case 8: { pg8::Gemm g{proj, (const bf16_t*)(W + WO_F2), T_TOK, 1024, DFF, DFF}; S.init(g.M, g.N, gridDim.x, blockIdx.x);
                  EpiRes e{xb, ssq}; pg8::gemm_phase(lds, g, S, e); } break;
        }
    }
}

extern "C" void kernel_launch(void* const* d_in, const int* in_sizes, int n_in, void* d_out, int out_size, void* d_ws, size_t ws_size, hipStream_t stream) {
    (void)in_sizes; (void)n_in; (void)out_size;
    if (ws_size < WS_NEEDED) return;
    Params p{};
    p.x_in = (const float*)d_in[0]; p.norm_mix = (const float*)d_in[1]; p.w_in = (const float*)d_in[2]; p.wdu_f = (const float*)d_in[3]; p.bd_f = (const float*)d_in[4];
    p.wdu_b = (const float*)d_in[5]; p.bd_b = (const float*)d_in[6]; p.gla_norm = (const float*)d_in[7]; p.w_ga = (const float*)d_in[8]; p.w_pool = (const float*)d_in[9];
    p.pool_scale = (const float*)d_in[10]; p.w_out = (const float*)d_in[11]; p.norm_ffn = (const float*)d_in[12]; p.w_f1 = (const float*)d_in[13]; p.w_f2 = (const float*)d_in[14];
    p.norm_final = (const float*)d_in[15];
    p.xf = (float*)d_out; p.ws = (char*)d_ws;
    hipFuncSetAttribute((const void*)mega, hipFuncAttributeMaxDynamicSharedMemorySize, LDS_BYTES);
    int dev = 0, cus = 0, per = 0;
    hipGetDevice(&dev); hipDeviceGetAttribute(&cus, hipDeviceAttributeMultiprocessorCount, dev);
    hipOccupancyMaxActiveBlocksPerMultiprocessor(&per, mega, 512, LDS_BYTES);
    int grid = cus * (per > 0 ? per : 1); if (grid > 256) grid = 256; if (grid < 1) grid = 1;
#if MK_SINGLE_LAUNCH
    p.phase_lo = 0; p.phase_hi = 20;
    hipMemsetAsync((char*)d_ws + OFF_BAR, 0, 128 * 256, stream);
    void* args[] = {(void*)&p};
    hipLaunchCooperativeKernel((const void*)mega, dim3(grid), dim3(512), args, LDS_BYTES, stream);
#else
    for (int ph = 0; ph < 20; ++ph) { p.phase_lo = ph; p.phase_hi = ph + 1; hipLaunchKernelGGL(mega, dim3(grid), dim3(512), LDS_BYTES, stream, p); }
#endif
}
```

```cpp
#include <hip/hip_runtime.h>
#include <hip/hip_cooperative_groups.h>
namespace cg = cooperative_groups;

#ifndef MK_SINGLE_LAUNCH
#define MK_SINGLE_LAUNCH 1
#endif

#define LAS __attribute__((address_space(3)))
typedef unsigned short bf16_t;
typedef short bf16x8 __attribute__((ext_vector_type(8)));
typedef float f32x4 __attribute__((ext_vector_type(4)));
typedef unsigned u32x4 __attribute__((ext_vector_type(4)));
typedef unsigned u32x2 __attribute__((ext_vector_type(2)));

constexpr int T_TOK = 32768, SEQL = 16384, DM = 1024, PW = 3584, NA = 3840, NB = 2048, DFF = 2816, INW = 5664;
constexpr int LDS_BYTES = 155136;

constexpr size_t SZ_WA = (size_t)NA * 1024 * 2, SZ_WB = (size_t)NB * 1024 * 2, SZ_WGA = (size_t)1024 * 1024 * 2, SZ_WPOOL = (size_t)1024 * 512 * 2,
                 SZ_WOUT = (size_t)1024 * 1024 * 2, SZ_WF1 = (size_t)2 * DFF * 1024 * 2, SZ_WF2 = (size_t)1024 * DFF * 2;
constexpr size_t WO_A = 0, WO_B = WO_A + SZ_WA, WO_GA = WO_B + SZ_WB, WO_POOL = WO_GA + SZ_WGA, WO_OUT = WO_POOL + SZ_WPOOL, WO_F1 = WO_OUT + SZ_WOUT,
                 WO_F2 = WO_F1 + SZ_WF1, SZ_WLAYER = WO_F2 + SZ_WF2;
constexpr size_t OFF_W = 0;
constexpr size_t OFF_XB = OFF_W + 2 * SZ_WLAYER;
constexpr size_t OFF_PROJ = OFF_XB + (size_t)T_TOK * 1024 * 2;
constexpr size_t OFF_LR = OFF_PROJ + (size_t)T_TOK * PW * 2;
constexpr size_t OFF_E = OFF_LR + (size_t)T_TOK * 32 * 4;
constexpr size_t OFF_DLOG = OFF_E + (size_t)16 * 32 * 32768 * 4;
constexpr size_t OFF_O = OFF_DLOG + (size_t)16 * 32 * 128 * 4;
constexpr size_t OFF_SSQ = OFF_O + (size_t)T_TOK * 1024 * 2;
constexpr size_t OFF_BAR = OFF_SSQ + (size_t)T_TOK * 16 * 4;
constexpr size_t OFF_RS = OFF_BAR + 128 * 256;
constexpr size_t WS_NEEDED = OFF_RS + (size_t)T_TOK * 4;

struct Params {
    const float* x_in; const float* norm_mix; const float* w_in; const float* wdu_f; const float* bd_f; const float* wdu_b; const float* bd_b;
    const float* gla_norm; const float* w_ga; const float* w_pool; const float* pool_scale; const float* w_out; const float* norm_ffn;
    const float* w_f1; const float* w_f2; const float* norm_final;
    float* xf; char* ws;
    int phase_lo, phase_hi;
};

typedef float f32x2 __attribute__((ext_vector_type(2)));
typedef __bf16 bf16x2_t __attribute__((ext_vector_type(2)));
__device__ __forceinline__ unsigned cvt_pk_bf16(float lo, float hi) { const f32x2 v = {lo, hi}; const bf16x2_t b = __builtin_convertvector(v, bf16x2_t); return __builtin_bit_cast(unsigned, b); }
__device__ __forceinline__ float bf2f(unsigned short b) { return __uint_as_float(((unsigned)b) << 16); }
__device__ __forceinline__ float bflo(unsigned w) { return __uint_as_float(w << 16); }
__device__ __forceinline__ float bfhi(unsigned w) { return __uint_as_float(w & 0xffff0000u); }
__device__ __forceinline__ unsigned short f2bf(float f) { return (unsigned short)(cvt_pk_bf16(f, 0.f) & 0xffffu); }
__device__ __forceinline__ float sigmoidf_(float x) { return __builtin_amdgcn_rcpf(1.f + __expf(-x)); }

namespace pg8 {
constexpr int BM = 256, BK = 64, HALF = 128, HTB = HALF * BK * 2, STAGE_BYTES = 8 * HTB, NXCD = 8, WGM = 8;
__device__ __forceinline__ int lds_byte(int r, int c) { const int st = (r >> 4) * 2 + (c >> 5), rr = r & 15, cc = c & 31, ob = rr * 64 + cc * 2; return st * 1024 + (ob ^ (((ob >> 9) & 1) << 5)); }
__device__ __forceinline__ void stage_rc(int b, int& R, int& C) { const int st = b / 1024, sb = b % 1024, swz = sb ^ (((sb >> 9) & 1) << 5); R = (st >> 1) * 16 + swz / 64; C = (st & 1) * 32 + (swz % 64) / 2; }
__device__ __forceinline__ int perm32(int rho) { const int n = rho >> 4, i = rho & 15; return 8 * (i >> 2) + 4 * n + (i & 3); }
struct Unit { int pm, pn; };
struct Gemm { const bf16_t* A; const bf16_t* Bt; int M, N, K, lda; };
struct StaticOrder {
    int nM, nN, nwg, G, c;
    __device__ void init(int M, int N, int G_, int c_) { nM = M / BM; nN = N / BM; nwg = nM * nN; G = G_; c = c_; }
    __device__ bool next(int i, Unit& u) const {
        const long L = (long)i * G + c; if (L >= nwg) return false;
        int wgid = (int)L; { const int q = nwg / NXCD, r = nwg % NXCD, xcd = wgid % NXCD, off = wgid / NXCD; wgid = (xcd < r ? xcd * (q + 1) : r * (q + 1) + (xcd - r) * q) + off; }
        const int nig = WGM * nN, gid = wgid / nig, fm = gid * WGM, gsz = (nM - fm) < WGM ? (nM - fm) : WGM;
        u.pm = fm + ((wgid % nig) % gsz); u.pn = (wgid % nig) / gsz; return true;
    }
};

template <class Epi, int APN = 0, bool ALIGN_EPI = true, bool SP2 = true>
__device__ __forceinline__ void gemm_phase(LAS unsigned char* lds, const Gemm g, const StaticOrder& S, const Epi& E) {
    int tid = threadIdx.x; asm volatile("" : "+v"(tid));
    const int wid = __builtin_amdgcn_readfirstlane(tid >> 6), lane = tid & 63, wr = wid >> 2, wc = wid & 3, fr = lane & 15, fq = lane >> 4;
    int K = g.K; asm volatile("" : "+s"(K));
    const int nt = K / BK;
    unsigned voffA[2], voffB[2];
#pragma unroll
    for (int i = 0; i < 2; ++i) { int R, C; stage_rc(tid * 16 + i * 8192, R, C); const int Rb = Epi::PERM ? ((R & ~31) + perm32(R & 31)) : R;
        voffA[i] = (unsigned)(R * g.lda + C) * 2u; voffB[i] = (unsigned)(Rb * K + C) * 2u; }
    const size_t kstep = (size_t)(BK * 2);
    const size_t hstepA = (size_t)HALF * g.lda * 2, hstepB = (size_t)HALF * K * 2;
    const size_t tstepA = 2 * hstepA, tstepB = 2 * hstepB;
    const unsigned ldsw = (unsigned)wid * 1024u;
    const int aoff = lds_byte(wr * 64 + fr, fq * 8), boff = lds_byte(wc * 32 + fr, fq * 8);
#define PG8_SA(b, h) (((b) * 2 + (h)) * HTB)
#define PG8_SB(b, h) ((4 + (b) * 2 + (h)) * HTB)
#define PG8_STAGE(bufoff, gbase, voff) do { _Pragma("unroll") for (int _i = 0; _i < 2; ++_i) \
        __builtin_amdgcn_global_load_lds((const unsigned*)((const char*)(gbase) + (voff)[_i]), (LAS unsigned*)(lds + (bufoff) + ldsw + _i * 8192), 16, 0, 0); } while (0)
#define PG8_LDA(dst, b, h) do { _Pragma("unroll") for (int m = 0; m < 4; ++m) _Pragma("unroll") for (int k = 0; k < 2; ++k) dst[m][k] = *(const LAS bf16x8*)(lds + PG8_SA(b, h) + aoff + m * 2048 + k * 1024); } while (0)
#define PG8_LDB(dst, b, h) do { _Pragma("unroll") for (int n = 0; n < 2; ++n) _Pragma("unroll") for (int k = 0; k < 2; ++k) dst[n][k] = *(const LAS bf16x8*)(lds + PG8_SB(b, h) + boff + n * 2048 + k * 1024); } while (0)
#define PG8_MMA(ai, bj, At, Bt) do { __builtin_amdgcn_s_setprio(1); _Pragma("unroll") for (int m = 0; m < 4; ++m) _Pragma("unroll") for (int n = 0; n < 2; ++n) _Pragma("unroll") for (int k = 0; k < 2; ++k) \
        acc[ai][bj][m][n] = __builtin_amdgcn_mfma_f32_16x16x32_bf16(Bt[n][k], At[m][k], acc[ai][bj][m][n], 0, 0, 0); __builtin_amdgcn_s_setprio(0); } while (0)
#define PG8_WAIT_V(n) asm volatile("s_waitcnt vmcnt(" #n ")" ::: "memory")
#define PG8_WAIT_L(n) asm volatile("s_waitcnt lgkmcnt(" #n ")" ::: "memory")
#define PG8_BAR __builtin_amdgcn_s_barrier()
#define PG8_SCHED __builtin_amdgcn_sched_barrier(0)
    Unit cur, nxt; int ui = 0;
    if (!S.next(0, cur)) return;
    f32x4 acc[2][2][4][2];
#pragma unroll
    for (int a = 0; a < 2; ++a)
#pragma unroll
        for (int b = 0; b < 2; ++b)
#pragma unroll
            for (int m = 0; m < 4; ++m)
#pragma unroll
                for (int n = 0; n < 2; ++n) acc[a][b][m][n] = (f32x4){0.f, 0.f, 0.f, 0.f};
    bf16x8 At[4][2], B0[2][2], B1[2][2];
    const char* cA = (const char*)g.A + (size_t)cur.pm * tstepA + (size_t)cur.pn * APN; const char* cB = (const char*)g.Bt + (size_t)cur.pn * tstepB;
    if constexpr (SP2) {
        PG8_STAGE(PG8_SB(0, 0), cB, voffB); PG8_STAGE(PG8_SB(0, 1), cB + hstepB, voffB); PG8_STAGE(PG8_SA(0, 0), cA, voffA); PG8_STAGE(PG8_SA(0, 1), cA + hstepA, voffA);
        if (wr == 1) PG8_BAR;
        PG8_WAIT_V(2); PG8_BAR;
        PG8_STAGE(PG8_SB(1, 0), cB + kstep, voffB); PG8_STAGE(PG8_SA(1, 0), cA + kstep, voffA); PG8_STAGE(PG8_SB(1, 1), cB + hstepB + kstep, voffB);
        PG8_WAIT_V(6); PG8_BAR;
    } else {
        PG8_STAGE(PG8_SB(0, 0), cB, voffB); PG8_STAGE(PG8_SA(0, 0), cA, voffA); PG8_STAGE(PG8_SB(0, 1), cB + hstepB, voffB); PG8_STAGE(PG8_SA(0, 1), cA + hstepA, voffA);
        if (wr == 1) PG8_BAR;
        PG8_WAIT_V(4); PG8_BAR;
        PG8_STAGE(PG8_SB(1, 0), cB + kstep, voffB); PG8_STAGE(PG8_SA(1, 0), cA + kstep, voffA); PG8_STAGE(PG8_SB(1, 1), cB + hstepB + kstep, voffB);
        PG8_WAIT_V(6); PG8_BAR;
    }
    for (;;) {
        const bool has_next = S.next(ui + 1, nxt);
        const unsigned rsoff = (unsigned)STAGE_BYTES + (unsigned)(ui & 1) * 1024u;
        if constexpr (Epi::NEEDS_RS) { if (wid < 4) __builtin_amdgcn_global_load_lds((const unsigned*)(E.rsv + cur.pm * 256 + wid * 64 + lane), (LAS unsigned*)(lds + rsoff + wid * 256), 4, 0, 0); }
        const char* nA = has_next ? (const char*)g.A + (size_t)nxt.pm * tstepA + (size_t)nxt.pn * APN : cA; const char* nB = has_next ? (const char*)g.Bt + (size_t)nxt.pn * tstepB : cB;
        for (int t = 0; t < nt; t += 2) {
            const bool last = (t == nt - 2);
            const char* a1 = cA + (size_t)(t + 1) * kstep;
            const char* a2 = last ? nA : cA + (size_t)(t + 2) * kstep; const char* b2 = last ? nB : cB + (size_t)(t + 2) * kstep;
            const char* a3 = a2 + kstep; const char* b3 = b2 + kstep;
            if constexpr (SP2) {
            PG8_LDB(B0, 0, 0); PG8_LDB(B1, 0, 1); PG8_SCHED; PG8_LDA(At, 0, 0); PG8_STAGE(PG8_SA(1, 1), a1 + hstepA, voffA);
            PG8_WAIT_V(8); PG8_WAIT_L(0); PG8_BAR; PG8_MMA(0, 0, At, B0); PG8_MMA(0, 1, At, B1); PG8_BAR; PG8_SCHED;
            PG8_LDA(At, 0, 1); PG8_STAGE(PG8_SB(0, 0), b2, voffB); PG8_STAGE(PG8_SB(0, 1), b2 + hstepB, voffB); PG8_STAGE(PG8_SA(0, 0), a2, voffA);
            PG8_WAIT_V(8); PG8_WAIT_L(0); PG8_BAR; PG8_MMA(1, 0, At, B0); PG8_MMA(1, 1, At, B1); PG8_BAR; PG8_SCHED;
            PG8_LDB(B0, 1, 0); PG8_LDB(B1, 1, 1); PG8_SCHED; PG8_LDA(At, 1, 0); PG8_STAGE(PG8_SA(0, 1), a2 + hstepA, voffA);
            PG8_WAIT_V(8); PG8_WAIT_L(0); PG8_BAR; PG8_MMA(0, 0, At, B0); PG8_MMA(0, 1, At, B1); PG8_BAR; PG8_SCHED;
            PG8_LDA(At, 1, 1); PG8_STAGE(PG8_SB(1, 0), b3, voffB); PG8_STAGE(PG8_SB(1, 1), b3 + hstepB, voffB); PG8_STAGE(PG8_SA(1, 0), a3, voffA);
            PG8_WAIT_V(8); PG8_WAIT_L(0); PG8_BAR; PG8_MMA(1, 0, At, B0); PG8_MMA(1, 1, At, B1); PG8_BAR; PG8_SCHED;
            } else {
            PG8_LDB(B0, 0, 0); PG8_SCHED; PG8_LDA(At, 0, 0); PG8_STAGE(PG8_SA(1, 1), a1 + hstepA, voffA);
            PG8_WAIT_L(8); PG8_BAR; PG8_WAIT_L(0); PG8_MMA(0, 0, At, B0); PG8_BAR; PG8_SCHED;
            PG8_LDB(B1, 0, 1); PG8_STAGE(PG8_SB(0, 0), b2, voffB);
            PG8_BAR; PG8_WAIT_L(0); PG8_MMA(0, 1, At, B1); PG8_BAR;
            PG8_LDA(At, 0, 1); PG8_STAGE(PG8_SA(0, 0), a2, voffA);
            PG8_BAR; PG8_WAIT_L(0); PG8_MMA(1, 0, At, B0); PG8_BAR; PG8_SCHED;
            PG8_STAGE(PG8_SB(0, 1), b2 + hstepB, voffB);
            PG8_WAIT_V(6); PG8_BAR; PG8_MMA(1, 1, At, B1); PG8_BAR;
            PG8_LDB(B0, 1, 0); PG8_SCHED; PG8_LDA(At, 1, 0); PG8_STAGE(PG8_SA(0, 1), a2 + hstepA, voffA);
            PG8_WAIT_L(8); PG8_BAR; PG8_WAIT_L(0); PG8_MMA(0, 0, At, B0); PG8_BAR; PG8_SCHED;
            PG8_LDB(B1, 1, 1); PG8_STAGE(PG8_SB(1, 0), b3, voffB);
            PG8_BAR; PG8_WAIT_L(0); PG8_MMA(0, 1, At, B1); PG8_BAR;
            PG8_LDA(At, 1, 1); PG8_STAGE(PG8_SA(1, 0), a3, voffA);
            PG8_BAR; PG8_WAIT_L(0); PG8_MMA(1, 0, At, B0); PG8_BAR; PG8_SCHED;
            PG8_STAGE(PG8_SB(1, 1), b3 + hstepB, voffB);
            PG8_WAIT_V(6); PG8_BAR; PG8_MMA(1, 1, At, B1); PG8_BAR;
            }
        }
        if constexpr (ALIGN_EPI) { if (wr == 0) PG8_BAR; }
        E(acc, cur, wr, wc, fr, fq, (const LAS float*)(lds + rsoff));
        if (!has_next) break;
#pragma unroll
        for (int a = 0; a < 2; ++a)
#pragma unroll
            for (int b = 0; b < 2; ++b)
#pragma unroll
                for (int m = 0; m < 4; ++m)
#pragma unroll
                    for (int n = 0; n < 2; ++n) acc[a][b][m][n] = (f32x4){0.f, 0.f, 0.f, 0.f};
        cur = nxt; cA = nA; cB = nB; ++ui;
        if constexpr (ALIGN_EPI) { if (wr == 1) PG8_BAR; }
    }
    PG8_WAIT_V(0);
    if constexpr (!ALIGN_EPI) { if (wr == 0) PG8_BAR; }
    PG8_BAR;
#undef PG8_SA
#undef PG8_SB
#undef PG8_STAGE
#undef PG8_LDA
#undef PG8_LDB
#undef PG8_MMA
#undef PG8_WAIT_V
#undef PG8_WAIT_L
#undef PG8_BAR
#undef PG8_SCHED
}
}
using pg8::Unit;

__device__ __forceinline__ float rowscale(const float* ssq, int row) {
    const f32x4* s = (const f32x4*)(ssq + (size_t)row * 16);
    const f32x4 a = s[0], b = s[1], c = s[2], d = s[3];
    const float t = ((a[0] + a[1]) + (a[2] + a[3])) + ((b[0] + b[1]) + (b[2] + b[3])) + ((c[0] + c[1]) + (c[2] + c[3])) + ((d[0] + d[1]) + (d[2] + d[3]));
    return rsqrtf(t * (1.f / 1024.f) + 1e-6f);
}
__device__ __forceinline__ u32x4 pack8(const f32x4 v0, const f32x4 v1) {
    u32x4 w; w.x = cvt_pk_bf16(v0[0], v0[1]); w.y = cvt_pk_bf16(v0[2], v0[3]); w.z = cvt_pk_bf16(v1[0], v1[1]); w.w = cvt_pk_bf16(v1[2], v1[3]); return w;
}

struct EpiA {
    static constexpr bool PERM = true;
    static constexpr bool NEEDS_RS = true; const float* rsv;
    bf16_t* P; bf16_t* lr; const float* ssq;
    __device__ __forceinline__ void operator()(const f32x4 (&acc)[2][2][4][2], const Unit& u, int wr, int wc, int fr, int fq, const LAS float* rsl) const {
        const int row0 = u.pm * 256 + wr * 64 + fr;
#pragma unroll
        for (int ai = 0; ai < 2; ++ai)
#pragma unroll
            for (int m = 0; m < 4; ++m) {
                const int row = row0 + ai * 128 + m * 16; const float rs = rsl[ai * 128 + wr * 64 + m * 16 + fr];
                if (u.pn < 14) {
#pragma unroll
                    for (int bj = 0; bj < 2; ++bj) {
                        const f32x4 v0 = acc[ai][bj][m][0] * rs, v1 = acc[ai][bj][m][1] * rs;
                        *(u32x4*)(P + (size_t)row * PW + u.pn * 256 + bj * 128 + wc * 32 + 8 * fq) = pack8(v0, v1);
                    }
                } else if (wc == 0) {
                    const f32x4 v0 = acc[ai][0][m][0] * rs, v1 = acc[ai][0][m][1] * rs;
                    const u32x4 hi = pack8(v0, v1);
                    const f32x4 d0 = (f32x4){v0[0] - bflo(hi.x), v0[1] - bfhi(hi.x), v0[2] - bflo(hi.y), v0[3] - bfhi(hi.y)};
                    const f32x4 d1 = (f32x4){v1[0] - bflo(hi.z), v1[1] - bfhi(hi.z), v1[2] - bflo(hi.w), v1[3] - bfhi(hi.w)};
                    bf16_t* lp = lr + (size_t)row * 64 + (fq >> 1) * 32 + (fq & 1) * 8;
                    *(u32x4*)lp = hi; *(u32x4*)(lp + 16) = pack8(d0, d1);
                }
            }
    }
};
struct EpiGate {
    static constexpr bool PERM = true;
    static constexpr bool NEEDS_RS = true; const float* rsv;
    bf16_t* P; const float* ssq;
    __device__ __forceinline__ void operator()(const f32x4 (&acc)[2][2][4][2], const Unit& u, int wr, int wc, int fr, int fq, const LAS float* rsl) const {
        const int row0 = u.pm * 256 + wr * 64 + fr;
#pragma unroll
        for (int ai = 0; ai < 2; ++ai)
#pragma unroll
            for (int m = 0; m < 4; ++m) {
                const int row = row0 + ai * 128 + m * 16; const float rs = rsl[ai * 128 + wr * 64 + m * 16 + fr];
#pragma unroll
                for (int bj = 0; bj < 2; ++bj) {
                    f32x4 v0 = acc[ai][bj][m][0] * rs, v1 = acc[ai][bj][m][1] * rs;
#pragma unroll
                    for (int j = 0; j < 4; ++j) { v0[j] = sigmoidf_(v0[j]); v1[j] = sigmoidf_(v1[j]); }
                    *(u32x4*)(P + (size_t)row * PW + u.pn * 256 + bj * 128 + wc * 32 + 8 * fq) = pack8(v0, v1);
                }
            }
    }
};
struct EpiPool {
    static constexpr bool PERM = true;
    static constexpr bool NEEDS_RS = false;
    bf16_t* P; const float* pscale;
    __device__ __forceinline__ void operator()(const f32x4 (&acc)[2][2][4][2], const Unit& u, int wr, int wc, int fr, int fq, const LAS float* rsl) const {
        const int row0 = u.pm * 256 + wr * 64 + fr;
#pragma unroll
        for (int bj = 0; bj < 2; ++bj) {
            const int col = u.pn * 256 + bj * 128 + wc * 32 + 8 * fq;
            const f32x4 p0 = *(const f32x4*)(pscale + col), p1 = *(const f32x4*)(pscale + col + 4);
#pragma unroll
            for (int ai = 0; ai < 2; ++ai)
#pragma unroll
                for (int m = 0; m < 4; ++m) {
                    const int row = row0 + ai * 128 + m * 16;
                    bf16_t* ptr = P + (size_t)row * PW + 1024 + col;
                    const u32x4 g = *(const u32x4*)ptr;
                    f32x4 v0 = acc[ai][bj][m][0] * p0, v1 = acc[ai][bj][m][1] * p1;
                    v0[0] *= bflo(g.x); v0[1] *= bfhi(g.x); v0[2] *= bflo(g.y); v0[3] *= bfhi(g.y);
                    v1[0] *= bflo(g.z); v1[1] *= bfhi(g.z); v1[2] *= bflo(g.w); v1[3] *= bfhi(g.w);
                    *(u32x4*)ptr = pack8(v0, v1);
                    if (m & 1) asm volatile("" ::: "memory");
                }
        }
    }
};
struct EpiMerge {
    static constexpr bool PERM = true;
    static constexpr bool NEEDS_RS = false;
    bf16_t* P;
    __device__ __forceinline__ void operator()(const f32x4 (&acc)[2][2][4][2], const Unit& u, int wr, int wc, int fr, int fq, const LAS float* rsl) const {
        const int row0 = u.pm * 256 + wr * 64 + fr;
#pragma unroll
        for (int ai = 0; ai < 2; ++ai)
#pragma unroll
            for (int m = 0; m < 4; ++m) {
                const int row = row0 + ai * 128 + m * 16;
#pragma unroll
                for (int bj = 0; bj < 2; ++bj) {
                    bf16_t* ptr = P + (size_t)row * PW + u.pn * 256 + bj * 128 + wc * 32 + 8 * fq;
                    const u32x4 g = *(const u32x4*)ptr; const u32x4 t = *(const u32x4*)(ptr + 1024);
                    f32x4 v0 = acc[ai][bj][m][0], v1 = acc[ai][bj][m][1];
                    v0[0] = v0[0] * bflo(g.x) + bflo(t.x); v0[1] = v0[1] * bfhi(g.x) + bfhi(t.x); v0[2] = v0[2] * bflo(g.y) + bflo(t.y); v0[3] = v0[3] * bfhi(g.y) + bfhi(t.y);
                    v1[0] = v1[0] * bflo(g.z) + bflo(t.z); v1[1] = v1[1] * bfhi(g.z) + bfhi(t.z); v1[2] = v1[2] * bflo(g.w) + bflo(t.w); v1[3] = v1[3] * bfhi(g.w) + bfhi(t.w);
                    *(u32x4*)ptr = pack8(v0, v1);
                }
                asm volatile("" ::: "memory");
            }
    }
};
struct EpiRes {
    static constexpr bool PERM = true;
    static constexpr bool NEEDS_RS = false;
    bf16_t* xb; float* ssq;
    __device__ __forceinline__ void operator()(const f32x4 (&acc)[2][2][4][2], const Unit& u, int wr, int wc, int fr, int fq, const LAS float* rsl) const {
        const int row0 = u.pm * 256 + wr * 64 + fr;
#pragma unroll
        for (int ai = 0; ai < 2; ++ai)
#pragma unroll
            for (int m = 0; m < 4; ++m) {
                const int row = row0 + ai * 128 + m * 16; float s = 0.f;
#pragma unroll
                for (int bj = 0; bj < 2; ++bj) {
                    bf16_t* ptr = xb + (size_t)row * 1024 + u.pn * 256 + bj * 128 + wc * 32 + 8 * fq;
                    const u32x4 g = *(const u32x4*)ptr;
                    f32x4 v0 = acc[ai][bj][m][0], v1 = acc[ai][bj][m][1];
                    v0[0] += bflo(g.x); v0[1] += bfhi(g.x); v0[2] += bflo(g.y); v0[3] += bfhi(g.y);
                    v1[0] += bflo(g.z); v1[1] += bfhi(g.z); v1[2] += bflo(g.w); v1[3] += bfhi(g.w);
                    *(u32x4*)ptr = pack8(v0, v1);
                    s += (v0[0] * v0[0] + v0[1] * v0[1]) + (v0[2] * v0[2] + v0[3] * v0[3]) + (v1[0] * v1[0] + v1[1] * v1[1]) + (v1[2] * v1[2] + v1[3] * v1[3]);
                }
                s += __shfl_xor(s, 16); s += __shfl_xor(s, 32);
                if (fq == 0) ssq[(size_t)row * 16 + u.pn * 4 + wc] = s;
            }
    }
};
struct EpiFfn1 {
    static constexpr bool PERM = true;
    static constexpr bool NEEDS_RS = true; const float* rsv;
    bf16_t* ACT; const float* ssq;
    __device__ __forceinline__ void operator()(const f32x4 (&acc)[2][2][4][2], const Unit& u, int wr, int wc, int fr, int fq, const LAS float* rsl) const {
        const int row0 = u.pm * 256 + wr * 64 + fr;
#pragma unroll
        for (int ai = 0; ai < 2; ++ai)
#pragma unroll
            for (int m = 0; m < 4; ++m) {
                const int row = row0 + ai * 128 + m * 16; const float rs = rsl[ai * 128 + wr * 64 + m * 16 + fr];
                f32x4 o[2];
#pragma unroll
                for (int n = 0; n < 2; ++n)
#pragma unroll
                    for (int j = 0; j < 4; ++j) { const float gt = acc[ai][0][m][n][j] * rs, up = acc[ai][1][m][n][j] * rs; o[n][j] = gt * sigmoidf_(gt) * up; }
                *(u32x4*)(ACT + (size_t)row * DFF + u.pn * 128 + wc * 32 + 8 * fq) = pack8(o[0], o[1]);
            }
    }
};

struct WJob { const float* src; const float* g; bf16_t* dst; int ld, ldd, vlo, vhi, kw; };
__device__ __forceinline__ WJob wjob_decode(const Params& p, int layer, int j) {
    WJob w; w.g = nullptr; w.vlo = 0; w.vhi = 256; w.kw = 256;
    bf16_t* W = (bf16_t*)(p.ws + OFF_W + (size_t)layer * SZ_WLAYER);
    if (j < 480) { const int nb = j >> 2, kb = j & 3, n0 = nb * 32; int c0;
        if (n0 < 3072) c0 = n0; else if (n0 < 3584) c0 = 3104 + (n0 - 3072); else if (n0 == 3584) c0 = 3072; else { c0 = 0; w.vhi = 0; }
        w.src = p.w_in + (size_t)layer * 1024 * INW + (size_t)kb * 256 * INW + c0; w.ld = INW; w.g = p.norm_mix + layer * 1024 + kb * 256;
        w.dst = (bf16_t*)((char*)W + WO_A) + (size_t)n0 * 1024 + kb * 256; w.ldd = 1024; return w; }
    j -= 480;
    if (j < 256) { const int nb = j >> 2, kb = j & 3, n0 = nb * 32;
        w.src = p.w_in + (size_t)layer * 1024 * INW + (size_t)kb * 256 * INW + 3616 + n0; w.ld = INW; w.g = p.norm_mix + layer * 1024 + kb * 256;
        w.dst = (bf16_t*)((char*)W + WO_B) + (size_t)n0 * 1024 + kb * 256; w.ldd = 1024; return w; }
    j -= 256;
    if (j < 128) { const int nb = j >> 2, kb = j & 3, n0 = nb * 32;
        w.src = p.w_ga + (size_t)layer * 1024 * 1024 + (size_t)kb * 256 * 1024 + n0; w.ld = 1024;
        w.dst = (bf16_t*)((char*)W + WO_GA) + (size_t)n0 * 1024 + kb * 256; w.ldd = 1024; return w; }
    j -= 128;
    if (j < 64) { const int nb = j >> 1, kb = j & 1, n0 = nb * 32, grp = n0 >> 8;
        w.src = p.w_pool + (size_t)layer * 4 * 128 * 256 + (size_t)grp * 128 * 256 + (n0 & 255); w.ld = 256;
        w.vlo = 0; w.vhi = kb == 0 ? 128 : 0; w.kw = kb == 0 ? 128 : 0;
        w.dst = (bf16_t*)((char*)W + WO_POOL) + (size_t)n0 * 128; w.ldd = 128; return w; }
    j -= 64;
    if (j < 128) { const int nb = j >> 2, kb = j & 3, n0 = nb * 32;
        w.src = p.w_out + (size_t)layer * 1024 * 1024 + (size_t)kb * 256 * 1024 + n0; w.ld = 1024;
        w.dst = (bf16_t*)((char*)W + WO_OUT) + (size_t)n0 * 1024 + kb * 256; w.ldd = 1024; return w; }
    j -= 128;
    if (j < 704) { const int nb = j >> 2, kb = j & 3, n0 = nb * 32, pn = n0 >> 8, within = n0 & 255;
        const int c0 = within < 128 ? 128 * pn + within : DFF + 128 * pn + (within - 128);
        w.src = p.w_f1 + (size_t)layer * 1024 * 2 * DFF + (size_t)kb * 256 * 2 * DFF + c0; w.ld = 2 * DFF; w.g = p.norm_ffn + layer * 1024 + kb * 256;
        w.dst = (bf16_t*)((char*)W + WO_F1) + (size_t)n0 * 1024 + kb * 256; w.ldd = 1024; return w; }
    j -= 704;
    { const int nb = j / 11, kb = j % 11, n0 = nb * 32;
        w.src = p.w_f2 + (size_t)layer * DFF * 1024 + (size_t)kb * 256 * 1024 + n0; w.ld = 1024;
        w.dst = (bf16_t*)((char*)W + WO_F2) + (size_t)n0 * DFF + kb * 256; w.ldd = DFF; return w; }
}

__device__ __forceinline__ void phase_prep(LAS unsigned char* lds, const Params& p) {
    int tid = threadIdx.x; asm volatile("" : "+v"(tid));
    const int wid = tid >> 6, lane = tid & 63;
    {
        f32x4 v[4]; WJob w, wn; int buf = 0;
#define PREP_LOAD(W_) do { _Pragma("unroll") for (int ps = 0; ps < 4; ++ps) { const int kk = (tid >> 3) + 64 * ps, c4 = (tid & 7) * 4; \
            v[ps] = (f32x4){0.f, 0.f, 0.f, 0.f}; \
            if (kk >= (W_).vlo && kk < (W_).vhi) { v[ps] = *(const f32x4*)((W_).src + (size_t)kk * (W_).ld + c4); if ((W_).g) v[ps] = v[ps] * (W_).g[kk]; } } } while (0)
        int job = blockIdx.x;
        if (job < 2 * 2112) { w = wjob_decode(p, job / 2112, job % 2112); PREP_LOAD(w); }
        for (; job < 2 * 2112; job += gridDim.x) {
            const int tb = buf * 33792;
#pragma unroll
            for (int ps = 0; ps < 4; ++ps) { const int kk = (tid >> 3) + 64 * ps, c4 = (tid & 7) * 4;
#pragma unroll
                for (int e = 0; e < 4; ++e) *(LAS float*)(lds + tb + (kk * 33 + c4 + e) * 4) = v[ps][e]; }
            __syncthreads();
            const int nj = job + gridDim.x;
            if (nj < 2 * 2112) { wn = wjob_decode(p, nj / 2112, nj % 2112); PREP_LOAD(wn); }
            { const int n = tid & 31, s = tid >> 5; unsigned pk[8];
#pragma unroll
                for (int e = 0; e < 8; ++e) { const float a = *(LAS float*)(lds + tb + ((s * 16 + 2 * e) * 33 + n) * 4), b = *(LAS float*)(lds + tb + ((s * 16 + 2 * e + 1) * 33 + n) * 4); pk[e] = cvt_pk_bf16(a, b); }
                bf16_t* d = w.dst + (size_t)n * w.ldd + s * 16;
                if (s * 16 < w.kw) { *(u32x4*)d = (u32x4){pk[0], pk[1], pk[2], pk[3]}; *(u32x4*)(d + 8) = (u32x4){pk[4], pk[5], pk[6], pk[7]}; } }
            w = wn; buf ^= 1;
        }
#undef PREP_LOAD
        __syncthreads();
    }
    bf16_t* xb = (bf16_t*)(p.ws + OFF_XB); float* ssq = (float*)(p.ws + OFF_SSQ);
    for (int row0 = blockIdx.x * 8 + wid; row0 < T_TOK; row0 += gridDim.x * 16) {
        f32x4 v[2][4]; bool ok[2];
#pragma unroll
        for (int u = 0; u < 2; ++u) { const int row = row0 + u * gridDim.x * 8; ok[u] = row < T_TOK;
            if (ok[u]) { const float* src = p.x_in + (size_t)row * 1024 + lane * 16;
#pragma unroll
                for (int i = 0; i < 4; ++i) v[u][i] = *(const f32x4*)(src + 4 * i); } }
#pragma unroll
        for (int u = 0; u < 2; ++u) if (ok[u]) { const int row = row0 + u * gridDim.x * 8;
            float s = 0.f;
#pragma unroll
            for (int i = 0; i < 4; ++i) s += (v[u][i][0] * v[u][i][0] + v[u][i][1] * v[u][i][1]) + (v[u][i][2] * v[u][i][2] + v[u][i][3] * v[u][i][3]);
#pragma unroll
            for (int o = 32; o >= 1; o >>= 1) s += __shfl_xor(s, o);
            bf16_t* dst = xb + (size_t)row * 1024 + lane * 16;
            *(u32x4*)dst = pack8(v[u][0], v[u][1]); *(u32x4*)(dst + 8) = pack8(v[u][2], v[u][3]);
            if (lane < 16) ssq[(size_t)row * 16 + lane] = lane == 0 ? s : 0.f;
            if (lane == 0) ((float*)(p.ws + OFF_RS))[row] = rsqrtf(s * (1.f / 1024.f) + 1e-6f); }
    }
}

#define MFMA16(a, b, c) __builtin_amdgcn_mfma_f32_16x16x32_bf16((a), (b), (c), 0, 0, 0)
template <bool PASS2>
__device__ __forceinline__ void gla_pass(LAS unsigned char* lds, const Params& p, int layer) {
    constexpr int SQ = 0, SKD = 17408, SV = 35840, SP = 69632, SLR = 78848, SDEC = 84992, SST = 85504, SK = SST, SX = SST + 17408, SCOL = SST + 51200;
    int tid = threadIdx.x; asm volatile("" : "+v"(tid));
    const int wid = __builtin_amdgcn_readfirstlane(tid >> 6), lane = tid & 63, fr = lane & 15, fq = lane >> 4;
    const int dk0 = (tid & 63) * 2;
    bf16_t* P = (bf16_t*)(p.ws + OFF_PROJ);
    const bf16_t* LR = (const bf16_t*)(p.ws + OFF_LR);
    bf16_t* E = (bf16_t*)(p.ws + OFF_E);
    bf16_t* QT = (bf16_t*)(p.ws + OFF_E + (size_t)32 * 1024 * 1024);
    float* DL = (float*)(p.ws + OFF_DLOG);
    bf16_t* O = (bf16_t*)(p.ws + OFF_O);
    for (int item = blockIdx.x; item < 256; item += gridDim.x) {
        const int b = item >> 7, h = (item >> 5) & 3, grp = item & 31;
#pragma unroll 1
        for (int dir = 0; dir < 2; ++dir) {
            const int scan = (b * 4 + h) * 2 + dir;
            bf16x8 wB1, wB2; float biasx;
            { const float* Wc = (dir ? p.wdu_b : p.wdu_f) + (size_t)layer * 16 * 512 + h * 128 + wid * 16 + fr;
              float wv[8]; unsigned h1[4], h2[4];
#pragma unroll
              for (int j = 0; j < 8; ++j) wv[j] = Wc[((fq & 1) * 8 + j) * 512];
#pragma unroll
              for (int jp = 0; jp < 4; ++jp) { const float a = wv[2 * jp], bq = wv[2 * jp + 1]; const unsigned hi = cvt_pk_bf16(a, bq);
                  const unsigned lo = cvt_pk_bf16(a - bflo(hi), bq - bfhi(hi)); h1[jp] = hi; h2[jp] = fq < 2 ? lo : 0u; }
              wB1 = __builtin_bit_cast(bf16x8, (u32x4){h1[0], h1[1], h1[2], h1[3]}); wB2 = __builtin_bit_cast(bf16x8, (u32x4){h2[0], h2[1], h2[2], h2[3]});
              biasx = (dir ? p.bd_b : p.bd_f)[layer * 512 + h * 128 + wid * 16 + fr]; }
            f32x4 accS[8][2];
            bf16_t* Eit = E + (size_t)(scan * 32 + grp) * 32768 + (size_t)(wid * 32 + fr) * 128 + 4 * fq;
#pragma unroll
            for (int m8 = 0; m8 < 8; ++m8)
#pragma unroll
                for (int n = 0; n < 2; ++n) accS[m8][n] = (f32x4){0.f, 0.f, 0.f, 0.f};
            float gtot0 = 0.f, gtot1 = 0.f;
            u32x4 rk[2], rq[2], rv[4]; u32x4 rl = (u32x4){0u, 0u, 0u, 0u};
#define GLA_ISSUE(CC) do { const int chunk_ = dir ? 7 - (CC) : (CC); const int t0_ = b * SEQL + grp * 512 + chunk_ * 64; \
                _Pragma("unroll") for (int it = 0; it < 2; ++it) { const int pi = tid + 512 * it, row = pi >> 4, seg = pi & 15; \
                    const bf16_t* src = P + (size_t)(t0_ + row) * PW + h * 128 + seg * 8; rk[it] = *(const u32x4*)(src + 512); } \
                if (tid < 256) { const int row = tid >> 2, seg = tid & 3; rl = *(const u32x4*)(LR + (size_t)(t0_ + row) * 64 + dir * 32 + seg * 8); } } while (0)
            GLA_ISSUE(0);
#pragma unroll 1
            for (int cc = 0; cc < 8; ++cc) {
                const int chunk = dir ? 7 - cc : cc;
                const int t0 = b * SEQL + grp * 512 + chunk * 64;
#pragma unroll
                for (int it = 0; it < 2; ++it) { const int pi = tid + 512 * it, row = pi >> 4, seg = pi & 15;
                    *(LAS u32x4*)(lds + SK + row * 272 + seg * 16) = rk[it];
                    if (PASS2) rq[it] = *(const u32x4*)(P + (size_t)(t0 + row) * PW + h * 128 + seg * 8); }
#pragma unroll
                for (int it = 0; it < 4; ++it) { const int pi = tid + 512 * it, row = pi >> 5, seg = pi & 31;
                    rv[it] = *(const u32x4*)(P + (size_t)(t0 + row) * PW + 1024 + h * 256 + seg * 8); }
                if (tid < 256) { const int row = tid >> 2, seg = tid & 3; *(LAS u32x4*)(lds + SLR + row * 64 + seg * 16) = rl; }
                __syncthreads();
#pragma unroll 1
                for (int m = 0; m < 4; ++m) {
                    const bf16x8 A = *(LAS bf16x8*)(lds + SLR + (m * 16 + fr) * 64 + fq * 16);
                    f32x4 xx = (f32x4){0.f, 0.f, 0.f, 0.f};
                    xx = MFMA16(A, wB1, xx); xx = MFMA16(A, wB2, xx);
#pragma unroll
                    for (int jj = 0; jj < 4; ++jj) { const float x = xx[jj] + biasx; const float ls = fminf(x, 0.f) - __logf(1.f + __expf(-fabsf(x)));
                        *(LAS float*)(lds + SX + ((m * 16 + 4 * fq + jj) * 132 + wid * 16 + fr) * 4) = ls * 0.0625f; }
                }
                if (PASS2) {
#pragma unroll
                    for (int it = 0; it < 2; ++it) { const int pi = tid + 512 * it, row = pi >> 4, seg = pi & 15; *(LAS u32x4*)(lds + SQ + row * 272 + seg * 16) = rq[it]; } }
                __syncthreads();
                float c0[8], c1[8];
#pragma unroll
                for (int e = 0; e < 8; ++e) { const f32x2 t2 = *(LAS f32x2*)(lds + SX + ((wid * 8 + e) * 132 + dk0) * 4); c0[e] = t2.x; c1[e] = t2.y; }
                if (dir == 0) {
#pragma unroll
                    for (int e = 1; e < 8; ++e) { c0[e] += c0[e - 1]; c1[e] += c1[e - 1]; }
                } else {
#pragma unroll
                    for (int e = 6; e >= 0; --e) { c0[e] += c0[e + 1]; c1[e] += c1[e + 1]; }
                }
                { f32x2 t2; t2.x = dir == 0 ? c0[7] : c0[0]; t2.y = dir == 0 ? c1[7] : c1[0]; *(LAS f32x2*)(lds + SCOL + (wid * 128 + dk0) * 4) = t2; }
                __syncthreads();
                float tot0 = 0.f, tot1 = 0.f, offs0 = 0.f, offs1 = 0.f;
#pragma unroll
                for (int s = 0; s < 8; ++s) { const f32x2 t2 = *(LAS f32x2*)(lds + SCOL + (s * 128 + dk0) * 4); tot0 += t2.x; tot1 += t2.y;
                    const bool inc = dir == 0 ? (s < wid) : (s > wid); offs0 += inc ? t2.x : 0.f; offs1 += inc ? t2.y : 0.f; }
                const float etot0 = __expf(tot0), etot1 = __expf(tot1), eg0 = __expf(gtot0), eg1 = __expf(gtot1);
                unsigned kd0p[4], kd1p[4]; float kd0prev = 0.f, kd1prev = 0.f;
#pragma unroll
                for (int e = 0; e < 8; ++e) { const int i = wid * 8 + e;
                    const float ec0 = __expf(c0[e] + offs0), ec1 = __expf(c1[e] + offs1), inv0 = __builtin_amdgcn_rcpf(ec0), inv1 = __builtin_amdgcn_rcpf(ec1);
                    const unsigned kw = *(LAS unsigned*)(lds + SK + i * 272 + dk0 * 2);
                    const float k0 = bflo(kw), k1 = bfhi(kw);
                    const float kd0 = k0 * (etot0 * inv0), kd1 = k1 * (etot1 * inv1);
                    if (PASS2) { const unsigned qw = *(LAS unsigned*)(lds + SQ + i * 272 + dk0 * 2);
                        const float qe0 = bflo(qw) * 0.08838834764831845f * ec0, qe1 = bfhi(qw) * 0.08838834764831845f * ec1;
                        *(LAS unsigned*)(lds + SQ + i * 272 + dk0 * 2) = cvt_pk_bf16(qe0, qe1);
                        const unsigned qt = cvt_pk_bf16(qe0 * eg0, qe1 * eg1);
                        if (dir == 0) *(unsigned*)(QT + (size_t)(t0 + i) * 512 + h * 128 + dk0) = qt; else *(unsigned*)(P + (size_t)(t0 + i) * PW + h * 128 + dk0) = qt;
                        *(LAS unsigned*)(lds + SK + i * 272 + dk0 * 2) = cvt_pk_bf16(k0 * inv0, k1 * inv1); }
                    if (e & 1) { kd0p[e >> 1] = cvt_pk_bf16(kd0prev, kd0); kd1p[e >> 1] = cvt_pk_bf16(kd1prev, kd1); } else { kd0prev = kd0; kd1prev = kd1; } }
                *(LAS u32x4*)(lds + SKD + dk0 * 144 + wid * 16) = (u32x4){kd0p[0], kd0p[1], kd0p[2], kd0p[3]};
                *(LAS u32x4*)(lds + SKD + (dk0 + 1) * 144 + wid * 16) = (u32x4){kd1p[0], kd1p[1], kd1p[2], kd1p[3]};
                if (wid == 0) { f32x2 t2; t2.x = etot0; t2.y = etot1; *(LAS f32x2*)(lds + SDEC + dk0 * 4) = t2; }
                gtot0 += tot0; gtot1 += tot1;
#pragma unroll
                for (int it = 0; it < 4; ++it) { const int pi = tid + 512 * it, row = pi >> 5, seg = pi & 31;
                    *(LAS u32x4*)(lds + SV + row * 528 + seg * 16) = rv[it]; }
                __syncthreads();
                if (PASS2) {
                    f32x4 accP[2];
#pragma unroll
                    for (int s = 0; s < 2; ++s) { const int tt = wid * 2 + s, ib = tt >> 2, jb = tt & 3; f32x4 a = (f32x4){0.f, 0.f, 0.f, 0.f};
#pragma unroll
                        for (int kb = 0; kb < 4; ++kb) { const bf16x8 A = *(LAS bf16x8*)(lds + SK + (jb * 16 + fr) * 272 + (kb * 32 + fq * 8) * 2);
                            const bf16x8 B = *(LAS bf16x8*)(lds + SQ + (ib * 16 + fr) * 272 + (kb * 32 + fq * 8) * 2); a = MFMA16(A, B, a); }
                        accP[s] = a; }
                    __syncthreads();
#pragma unroll
                    for (int s = 0; s < 2; ++s) { const int tt = wid * 2 + s, ib = tt >> 2, jb = tt & 3; const int i = ib * 16 + fr, jbase = jb * 16 + 4 * fq; float v[4];
#pragma unroll
                        for (int jj = 0; jj < 4; ++jj) { const int j = jbase + jj; const bool keep = dir == 0 ? (j <= i) : (j > i); v[jj] = keep ? accP[s][jj] : 0.f; }
                        *(LAS u32x2*)(lds + SP + i * 144 + jbase * 2) = (u32x2){cvt_pk_bf16(v[0], v[1]), cvt_pk_bf16(v[2], v[3])}; }
#pragma unroll
                    for (int m8 = 0; m8 < 8; ++m8)
#pragma unroll
                        for (int n = 0; n < 2; ++n) { const f32x4 sv = accS[m8][n];
                            *(LAS u32x2*)(lds + SST + (wid * 32 + n * 16 + fr) * 272 + (m8 * 16 + 4 * fq) * 2) = (u32x2){cvt_pk_bf16(sv[0], sv[1]), cvt_pk_bf16(sv[2], sv[3])}; }
                    __syncthreads();
                }
                bf16x8 vf[2][2];
#pragma unroll
                for (int n = 0; n < 2; ++n)
#pragma unroll
                    for (int kb2 = 0; kb2 < 2; ++kb2) { unsigned w[4];
#pragma unroll
                        for (int jp = 0; jp < 4; ++jp) { const unsigned lo = *(LAS unsigned short*)(lds + SV + (kb2 * 32 + fq * 8 + 2 * jp) * 528 + (wid * 32 + n * 16 + fr) * 2);
                            const unsigned hi = *(LAS unsigned short*)(lds + SV + (kb2 * 32 + fq * 8 + 2 * jp + 1) * 528 + (wid * 32 + n * 16 + fr) * 2); w[jp] = lo | (hi << 16); }
                        vf[n][kb2] = __builtin_bit_cast(bf16x8, (u32x4){w[0], w[1], w[2], w[3]}); }
                if (PASS2) {
#pragma unroll
                    for (int n = 0; n < 2; ++n) {
                        f32x4 accO[4];
#pragma unroll
                        for (int m = 0; m < 4; ++m) accO[m] = (f32x4){0.f, 0.f, 0.f, 0.f};
#pragma unroll
                        for (int kb = 0; kb < 4; ++kb) { const bf16x8 A = *(LAS bf16x8*)(lds + SST + (wid * 32 + n * 16 + fr) * 272 + (kb * 32 + fq * 8) * 2);
#pragma unroll
                            for (int m = 0; m < 4; ++m) { const bf16x8 B = *(LAS bf16x8*)(lds + SQ + (m * 16 + fr) * 272 + (kb * 32 + fq * 8) * 2); accO[m] = MFMA16(A, B, accO[m]); } }
#pragma unroll
                        for (int kb2 = 0; kb2 < 2; ++kb2)
#pragma unroll
                            for (int m = 0; m < 4; ++m) { const bf16x8 B = *(LAS bf16x8*)(lds + SP + (m * 16 + fr) * 144 + (kb2 * 32 + fq * 8) * 2); accO[m] = MFMA16(vf[n][kb2], B, accO[m]); }
#pragma unroll
                        for (int m = 0; m < 4; ++m) { bf16_t* dst = O + (size_t)(t0 + m * 16 + fr) * 1024 + h * 256 + wid * 32 + n * 16 + 4 * fq; f32x4 v = accO[m];
                            if (dir) { const u32x2 old = *(const u32x2*)dst; v[0] += bflo(old.x); v[1] += bfhi(old.x); v[2] += bflo(old.y); v[3] += bfhi(old.y); }
                            *(u32x2*)dst = (u32x2){cvt_pk_bf16(v[0], v[1]), cvt_pk_bf16(v[2], v[3])}; }
                        asm volatile("" ::: "memory");
                    }
                }
                if (cc < 7) GLA_ISSUE(cc + 1);
#pragma unroll
                for (int m8 = 0; m8 < 8; ++m8) { const f32x4 d = *(LAS f32x4*)(lds + SDEC + (m8 * 16 + 4 * fq) * 4);
#pragma unroll
                    for (int n = 0; n < 2; ++n) accS[m8][n] = accS[m8][n] * d;
#pragma unroll
                    for (int kb2 = 0; kb2 < 2; ++kb2) { const bf16x8 A = *(LAS bf16x8*)(lds + SKD + (m8 * 16 + fr) * 144 + (kb2 * 32 + fq * 8) * 2);
#pragma unroll
                        for (int n = 0; n < 2; ++n) accS[m8][n] = MFMA16(A, vf[n][kb2], accS[m8][n]); } }
                __syncthreads();
            }
            {
#pragma unroll
                for (int m8 = 0; m8 < 8; ++m8)
#pragma unroll
                    for (int n = 0; n < 2; ++n)
                        *(u32x2*)(Eit + n * 16 * 128 + m8 * 16) = (u32x2){cvt_pk_bf16(accS[m8][n][0], accS[m8][n][1]), cvt_pk_bf16(accS[m8][n][2], accS[m8][n][3])};
                if (wid == 0) { DL[(scan * 32 + grp) * 128 + dk0] = gtot0; DL[(scan * 32 + grp) * 128 + dk0 + 1] = gtot1; }
            }
        }
    }
}

#undef GLA_ISSUE
__device__ __forceinline__ void phase_combine(const Params& p) {
    bf16_t* E = (bf16_t*)(p.ws + OFF_E); const float* DL = (const float*)(p.ws + OFF_DLOG);
    int tid = threadIdx.x; asm volatile("" : "+v"(tid));
    for (int idx = blockIdx.x * 512 + tid; idx < 16 * 4096; idx += gridDim.x * 512) {
        const int scan = idx >> 12, e8 = idx & 4095, dk0 = (e8 & 15) * 8, dir = scan & 1;
        float R[8];
#pragma unroll
        for (int i = 0; i < 8; ++i) R[i] = 0.f;
#pragma unroll 1
        for (int q4 = 0; q4 < 4; ++q4) {
            u32x4 ev[8]; f32x4 d0[8], d1[8];
#pragma unroll
            for (int gg = 0; gg < 8; ++gg) { const int go = q4 * 8 + gg, g = dir ? 31 - go : go;
                ev[gg] = *(const u32x4*)(E + (size_t)(scan * 32 + g) * 32768 + e8 * 8);
                d0[gg] = *(const f32x4*)(DL + (scan * 32 + g) * 128 + dk0); d1[gg] = *(const f32x4*)(DL + (scan * 32 + g) * 128 + dk0 + 4); }
#pragma unroll
            for (int gg = 0; gg < 8; ++gg) { const int go = q4 * 8 + gg, g = dir ? 31 - go : go;
                *(u32x4*)(E + (size_t)(scan * 32 + g) * 32768 + e8 * 8) = (u32x4){cvt_pk_bf16(R[0], R[1]), cvt_pk_bf16(R[2], R[3]), cvt_pk_bf16(R[4], R[5]), cvt_pk_bf16(R[6], R[7])};
                const u32x4 w = ev[gg];
                R[0] = R[0] * __expf(d0[gg][0]) + bflo(w.x); R[1] = R[1] * __expf(d0[gg][1]) + bfhi(w.x); R[2] = R[2] * __expf(d0[gg][2]) + bflo(w.y); R[3] = R[3] * __expf(d0[gg][3]) + bfhi(w.y);
                R[4] = R[4] * __expf(d1[gg][0]) + bflo(w.z); R[5] = R[5] * __expf(d1[gg][1]) + bfhi(w.z); R[6] = R[6] * __expf(d1[gg][2]) + bflo(w.w); R[7] = R[7] * __expf(d1[gg][3]) + bfhi(w.w); }
        }
    }
}

__device__ __forceinline__ void gla_light(LAS unsigned char* lds, const Params& p, int layer) {
    constexpr int SSTF = 0, SSTB = 69632, SSS = 139264;
    int tid = threadIdx.x; asm volatile("" : "+v"(tid));
    const int wid = __builtin_amdgcn_readfirstlane(tid >> 6), lane = tid & 63, fr = lane & 15, fq = lane >> 4, mt = wid & 3, hv = wid >> 2;
    bf16_t* P = (bf16_t*)(p.ws + OFF_PROJ);
    const bf16_t* E = (const bf16_t*)(p.ws + OFF_E);
    const bf16_t* QT = (const bf16_t*)(p.ws + OFF_E + (size_t)32 * 1024 * 1024);
    const bf16_t* O = (const bf16_t*)(p.ws + OFF_O);
    for (int item = blockIdx.x; item < 256; item += gridDim.x) {
        const int b = item >> 7, h = (item >> 5) & 3, grp = item & 31;
        const int scanf = (b * 4 + h) * 2;
        __syncthreads();
#pragma unroll
        for (int it = 0; it < 8; ++it) { const int pi = tid + 512 * it, row = pi >> 4, seg = pi & 15;
            const u32x4 vf_ = *(const u32x4*)(E + (size_t)(scanf * 32 + grp) * 32768 + row * 128 + seg * 8);
            const u32x4 vb_ = *(const u32x4*)(E + (size_t)((scanf + 1) * 32 + grp) * 32768 + row * 128 + seg * 8);
            *(LAS u32x4*)(lds + SSTF + row * 272 + seg * 16) = vf_; *(LAS u32x4*)(lds + SSTB + row * 272 + seg * 16) = vb_; }
        __syncthreads();
        f32x4 gn[8];
#pragma unroll
        for (int n = 0; n < 8; ++n) gn[n] = *(const f32x4*)(p.gla_norm + layer * 1024 + h * 256 + hv * 128 + n * 16 + 4 * fq);
#pragma unroll 1
        for (int cc = 0; cc < 8; ++cc) {
            const size_t tok = (size_t)(b * SEQL + grp * 512 + cc * 64 + mt * 16 + fr);
            bf16x8 bq[2][4];
#pragma unroll
            for (int kb = 0; kb < 4; ++kb) { bq[0][kb] = *(const bf16x8*)(QT + tok * 512 + h * 128 + kb * 32 + fq * 8); bq[1][kb] = *(const bf16x8*)(P + tok * PW + h * 128 + kb * 32 + fq * 8); }
            u32x2 oo[8], rr[8];
#pragma unroll
            for (int n = 0; n < 8; ++n) { oo[n] = *(const u32x2*)(O + tok * 1024 + h * 256 + hv * 128 + n * 16 + 4 * fq);
                rr[n] = *(const u32x2*)(P + tok * PW + 2048 + h * 256 + hv * 128 + n * 16 + 4 * fq); }
            f32x4 accO[8];
#pragma unroll
            for (int n = 0; n < 8; ++n) accO[n] = (f32x4){0.f, 0.f, 0.f, 0.f};
#pragma unroll
            for (int dir = 0; dir < 2; ++dir)
#pragma unroll
                for (int kb = 0; kb < 4; ++kb)
#pragma unroll
                    for (int n = 0; n < 8; ++n) { const bf16x8 A = *(LAS bf16x8*)(lds + (dir ? SSTB : SSTF) + (hv * 128 + n * 16 + fr) * 272 + (kb * 32 + fq * 8) * 2);
                        accO[n] = MFMA16(A, bq[dir][kb], accO[n]); }
            float s = 0.f;
#pragma unroll
            for (int n = 0; n < 8; ++n) { f32x4 v = accO[n]; v[0] += bflo(oo[n].x); v[1] += bfhi(oo[n].x); v[2] += bflo(oo[n].y); v[3] += bfhi(oo[n].y); accO[n] = v;
                s += (v[0] * v[0] + v[1] * v[1]) + (v[2] * v[2] + v[3] * v[3]); }
            s += __shfl_xor(s, 16); s += __shfl_xor(s, 32);
            const int sb = SSS + (cc & 1) * 512;
            if (fq == 0) *(LAS float*)(lds + sb + (hv * 64 + mt * 16 + fr) * 4) = s;
            __syncthreads();
            const float tot = *(LAS float*)(lds + sb + (mt * 16 + fr) * 4) + *(LAS float*)(lds + sb + (64 + mt * 16 + fr) * 4);
            const float rn = rsqrtf(tot * (1.f / 256.f) + 1e-6f);
#pragma unroll
            for (int n = 0; n < 8; ++n) { const float r0 = bflo(rr[n].x), r1 = bfhi(rr[n].x), r2 = bflo(rr[n].y), r3 = bfhi(rr[n].y);
                const f32x4 v = accO[n] * rn * gn[n];
                *(u32x2*)(P + tok * PW + 2048 + h * 256 + hv * 128 + n * 16 + 4 * fq) =
                    (u32x2){cvt_pk_bf16(v[0] * (r0 * sigmoidf_(r0)), v[1] * (r1 * sigmoidf_(r1))), cvt_pk_bf16(v[2] * (r2 * sigmoidf_(r2)), v[3] * (r3 * sigmoidf_(r3)))}; }
        }
    }
}

__device__ __forceinline__ void phase_gating(const Params& p, int layer) {
    int tid = threadIdx.x; asm volatile("" : "+v"(tid));
    const int wid = tid >> 6, lane = tid & 63;
    bf16_t* P = (bf16_t*)(p.ws + OFF_PROJ); const bf16_t* O = (const bf16_t*)(p.ws + OFF_O);
    const float* gn = p.gla_norm + layer * 1024 + lane * 16;
    f32x4 g4[4];
#pragma unroll
    for (int i = 0; i < 4; ++i) g4[i] = *(const f32x4*)(gn + 4 * i);
    for (int t0 = blockIdx.x * 8 + wid; t0 < T_TOK; t0 += gridDim.x * 16) {
        u32x4 oo[2][2], rr[2][2]; bool ok[2];
#pragma unroll
        for (int u = 0; u < 2; ++u) { const int t = t0 + u * gridDim.x * 8; ok[u] = t < T_TOK;
            if (ok[u]) { oo[u][0] = *(const u32x4*)(O + (size_t)t * 1024 + lane * 16); oo[u][1] = *(const u32x4*)(O + (size_t)t * 1024 + lane * 16 + 8);
                const bf16_t* rp = P + (size_t)t * PW + 2048 + lane * 16; rr[u][0] = *(const u32x4*)rp; rr[u][1] = *(const u32x4*)(rp + 8); } }
#pragma unroll
        for (int u = 0; u < 2; ++u) if (ok[u]) { const int t = t0 + u * gridDim.x * 8;
            bf16_t* rp = P + (size_t)t * PW + 2048 + lane * 16;
            const u32x4 o0 = oo[u][0], o1 = oo[u][1], r0 = rr[u][0], r1 = rr[u][1];
            float ov[16], rv[16];
            ov[0] = bflo(o0.x); ov[1] = bfhi(o0.x); ov[2] = bflo(o0.y); ov[3] = bfhi(o0.y); ov[4] = bflo(o0.z); ov[5] = bfhi(o0.z); ov[6] = bflo(o0.w); ov[7] = bfhi(o0.w);
            ov[8] = bflo(o1.x); ov[9] = bfhi(o1.x); ov[10] = bflo(o1.y); ov[11] = bfhi(o1.y); ov[12] = bflo(o1.z); ov[13] = bfhi(o1.z); ov[14] = bflo(o1.w); ov[15] = bfhi(o1.w);
            rv[0] = bflo(r0.x); rv[1] = bfhi(r0.x); rv[2] = bflo(r0.y); rv[3] = bfhi(r0.y); rv[4] = bflo(r0.z); rv[5] = bfhi(r0.z); rv[6] = bflo(r0.w); rv[7] = bfhi(r0.w);
            rv[8] = bflo(r1.x); rv[9] = bfhi(r1.x); rv[10] = bflo(r1.y); rv[11] = bfhi(r1.y); rv[12] = bflo(r1.z); rv[13] = bfhi(r1.z); rv[14] = bflo(r1.w); rv[15] = bfhi(r1.w);
            float s = 0.f;
#pragma unroll
            for (int i = 0; i < 16; ++i) s += ov[i] * ov[i];
            s += __shfl_xor(s, 8); s += __shfl_xor(s, 4); s += __shfl_xor(s, 2); s += __shfl_xor(s, 1);
            const float rn = rsqrtf(s * (1.f / 256.f) + 1e-6f);
            float out[16];
#pragma unroll
            for (int i = 0; i < 16; ++i) { const float r = rv[i]; out[i] = ov[i] * rn * g4[i >> 2][i & 3] * (r * sigmoidf_(r)); }
            *(u32x4*)rp = (u32x4){cvt_pk_bf16(out[0], out[1]), cvt_pk_bf16(out[2], out[3]), cvt_pk_bf16(out[4], out[5]), cvt_pk_bf16(out[6], out[7])};
            *(u32x4*)(rp + 8) = (u32x4){cvt_pk_bf16(out[8], out[9]), cvt_pk_bf16(out[10], out[11]), cvt_pk_bf16(out[12], out[13]), cvt_pk_bf16(out[14], out[15])}; }
    }
}

template <int HW>
__device__ __forceinline__ void pool_run(const bf16_t* P, bf16_t* PO, int t0, int c8) {
    constexpr int NR = 16 + 2 * HW - 1;
    const int pos0 = t0 & (SEQL - 1);
    const bf16_t* base = P + (size_t)t0 * PW + 3072 + c8 * 8;
    u32x4 v[NR];
#pragma unroll
    for (int k = 0; k < NR; ++k) { const int off = k - HW, tt = pos0 + off;
        v[k] = (tt >= 0 && tt < SEQL) ? *(const u32x4*)(base + (long)off * PW) : (u32x4){0u, 0u, 0u, 0u}; }
    float w[8];
#pragma unroll
    for (int i = 0; i < 8; ++i) w[i] = 0.f;
#pragma unroll
    for (int k = 0; k < 2 * HW; ++k) { w[0] += bflo(v[k].x); w[1] += bfhi(v[k].x); w[2] += bflo(v[k].y); w[3] += bfhi(v[k].y); w[4] += bflo(v[k].z); w[5] += bfhi(v[k].z); w[6] += bflo(v[k].w); w[7] += bfhi(v[k].w); }
#pragma unroll
    for (int i = 0; i < 16; ++i) {
        if (i > 0) { const u32x4 a = v[i + 2 * HW - 1], s = v[i - 1];
            w[0] += bflo(a.x) - bflo(s.x); w[1] += bfhi(a.x) - bfhi(s.x); w[2] += bflo(a.y) - bflo(s.y); w[3] += bfhi(a.y) - bfhi(s.y);
            w[4] += bflo(a.z) - bflo(s.z); w[5] += bfhi(a.z) - bfhi(s.z); w[6] += bflo(a.w) - bflo(s.w); w[7] += bfhi(a.w) - bfhi(s.w); }
        const int pos = pos0 + i, lo = pos - HW < 0 ? 0 : pos - HW, hi = pos + HW > SEQL ? SEQL : pos + HW;
        const float ic = 1.f / (float)(hi - lo);
        const u32x4 c = v[HW + i];
        *(u32x4*)(PO + (size_t)(t0 + i) * 512 + c8 * 8) = (u32x4){cvt_pk_bf16(w[0] * ic - bflo(c.x), w[1] * ic - bfhi(c.x)), cvt_pk_bf16(w[2] * ic - bflo(c.y), w[3] * ic - bfhi(c.y)),
                                                                 cvt_pk_bf16(w[4] * ic - bflo(c.z), w[5] * ic - bfhi(c.z)), cvt_pk_bf16(w[6] * ic - bflo(c.w), w[7] * ic - bfhi(c.w))};
    }
}
__device__ __forceinline__ void phase_pool(const Params& p) {
    const bf16_t* P = (const bf16_t*)(p.ws + OFF_PROJ); bf16_t* PO = (bf16_t*)(p.ws + OFF_E);
    int tid = threadIdx.x; asm volatile("" : "+v"(tid));
    const int wid = __builtin_amdgcn_readfirstlane(tid >> 6), lane = tid & 63;
    for (int wi = blockIdx.x * 8 + wid; wi < T_TOK / 16; wi += gridDim.x * 8) {
        const int grp = wi & 3, t0 = (wi >> 2) * 64 + (lane >> 4) * 16, c8 = grp * 16 + (lane & 15);
        if (grp == 0) pool_run<1>(P, PO, t0, c8); else if (grp == 1) pool_run<2>(P, PO, t0, c8); else if (grp == 2) pool_run<4>(P, PO, t0, c8); else pool_run<8>(P, PO, t0, c8);
    }
}

__device__ __forceinline__ void phase_final(const Params& p) {
    int tid = threadIdx.x; asm volatile("" : "+v"(tid));
    const int wid = tid >> 6, lane = tid & 63;
    const float* ssq = (const float*)(p.ws + OFF_SSQ); const bf16_t* xb = (const bf16_t*)(p.ws + OFF_XB);
    f32x4 g4[4];
#pragma unroll
    for (int i = 0; i < 4; ++i) g4[i] = *(const f32x4*)(p.norm_final + lane * 16 + 4 * i);
    for (int row0 = blockIdx.x * 8 + wid; row0 < T_TOK; row0 += gridDim.x * 32) {
        u32x4 v[4][2]; float rs[4]; bool ok[4];
#pragma unroll
        for (int u = 0; u < 4; ++u) { const int row = row0 + u * gridDim.x * 8; ok[u] = row < T_TOK;
            if (ok[u]) { rs[u] = rowscale(ssq, row); const bf16_t* xp = xb + (size_t)row * 1024 + lane * 16; v[u][0] = *(const u32x4*)xp; v[u][1] = *(const u32x4*)(xp + 8); } }
#pragma unroll
        for (int u = 0; u < 4; ++u) if (ok[u]) { const int row = row0 + u * gridDim.x * 8; float* op = p.xf + (size_t)row * 1024 + lane * 16; const float r = rs[u];
            *(f32x4*)(op) = (f32x4){bflo(v[u][0].x), bfhi(v[u][0].x), bflo(v[u][0].y), bfhi(v[u][0].y)} * r * g4[0];
            *(f32x4*)(op + 4) = (f32x4){bflo(v[u][0].z), bfhi(v[u][0].z), bflo(v[u][0].w), bfhi(v[u][0].w)} * r * g4[1];
            *(f32x4*)(op + 8) = (f32x4){bflo(v[u][1].x), bfhi(v[u][1].x), bflo(v[u][1].y), bfhi(v[u][1].y)} * r * g4[2];
            *(f32x4*)(op + 12) = (f32x4){bflo(v[u][1].z), bfhi(v[u][1].z), bflo(v[u][1].w), bfhi(v[u][1].w)} * r * g4[3]; }
    }
}

__device__ __forceinline__ void phase_rs(const Params& p) {
    int tid = threadIdx.x; asm volatile("" : "+v"(tid));
    const float* ssq = (const float*)(p.ws + OFF_SSQ); float* rs = (float*)(p.ws + OFF_RS);
    for (int row = blockIdx.x * 512 + tid; row < T_TOK; row += gridDim.x * 512) rs[row] = rowscale(ssq, row);
}
__device__ __forceinline__ void grid_barrier(unsigned* bar, unsigned k) {
    asm volatile("s_waitcnt vmcnt(0)" ::: "memory");
    __syncthreads();
    if (threadIdx.x == 0) {
        const unsigned nb = gridDim.x, g = blockIdx.x >> 4, ng = (nb + 15u) >> 4, gsz = (nb - 16u * g) < 16u ? (nb - 16u * g) : 16u;
        __builtin_amdgcn_fence(__ATOMIC_RELEASE, "agent");
        asm volatile("s_waitcnt vmcnt(0)" ::: "memory");
        const unsigned old = __hip_atomic_fetch_add(bar + 64 * g, 1u, __ATOMIC_RELAXED, __HIP_MEMORY_SCOPE_AGENT);
        if (old == k * gsz - 1u) {
            const unsigned old2 = __hip_atomic_fetch_add(bar + 64 * 32, 1u, __ATOMIC_RELAXED, __HIP_MEMORY_SCOPE_AGENT);
            if (old2 == k * ng - 1u) for (unsigned j = 0; j < ng; ++j) __hip_atomic_store(bar + 64 * (64 + j), k, __ATOMIC_RELAXED, __HIP_MEMORY_SCOPE_AGENT);
        }
        while (__hip_atomic_load(bar + 64 * (64 + g), __ATOMIC_RELAXED, __HIP_MEMORY_SCOPE_AGENT) < k) __builtin_amdgcn_s_sleep(2);
        __builtin_amdgcn_fence(__ATOMIC_ACQUIRE, "agent");
        asm volatile("s_waitcnt vmcnt(0)" ::: "memory");
    }
    __syncthreads();
}
__global__ void __launch_bounds__(512, 2) mega(const Params p_arg) {
    extern __shared__ __attribute__((aligned(16))) unsigned char shm[];
    LAS unsigned char* lds = (LAS unsigned char*)shm;
    typedef const Params __attribute__((address_space(4))) * KArgPtr;
    const int phase_lo = p_arg.phase_lo, phase_hi = p_arg.phase_hi;
    pg8::StaticOrder S;
    unsigned bar_k = 0;
    for (int ph = phase_lo; ph < phase_hi; ++ph) {
        KArgPtr kp = (KArgPtr)__builtin_amdgcn_kernarg_segment_ptr(); asm volatile("" : "+s"(kp));
        const Params& p = *(const Params*)kp;
        bf16_t* xb = (bf16_t*)(p.ws + OFF_XB); bf16_t* proj = (bf16_t*)(p.ws + OFF_PROJ); float* ssq = (float*)(p.ws + OFF_SSQ);
        if (ph > phase_lo) {
            if (phase_hi > 1000) cg::this_grid().sync();
            grid_barrier((unsigned*)(p.ws + OFF_BAR), ++bar_k);
        }
        if (ph == 0) { phase_prep(lds, p); continue; }
        if (ph == 19) { phase_final(p); continue; }
        const int layer = (ph - 1) / 9, sub = (ph - 1) % 9;
        const char* W = p.ws + OFF_W + (size_t)layer * SZ_WLAYER;
        switch (sub) {
        case 0: { if (layer > 0) { phase_rs(p); grid_barrier((unsigned*)(p.ws + OFF_BAR), ++bar_k); }
                  pg8::Gemm g{xb, (const bf16_t*)(W + WO_A), T_TOK, NA, 1024, 1024}; S.init(g.M, g.N, gridDim.x, blockIdx.x);
                  EpiA e{(const float*)(p.ws + OFF_RS), proj, (bf16_t*)(p.ws + OFF_LR), ssq}; pg8::gemm_phase(lds, g, S, e); } break;
        case 1: gla_pass<true>(lds, p, layer); break;
        case 2: phase_combine(p); break;
        case 3: gla_light(lds, p, layer); break;
        case 4: { pg8::Gemm g{xb, (const bf16_t*)(W + WO_B), T_TOK, NB, 1024, 1024}; S.init(g.M, g.N, gridDim.x, blockIdx.x);
                  EpiGate e{(const float*)(p.ws + OFF_RS), proj, ssq}; pg8::gemm_phase(lds, g, S, e);
                  phase_pool(p); } break;
        case 5: { { pg8::Gemm g{(const bf16_t*)(p.ws + OFF_E), (const bf16_t*)(W + WO_POOL), T_TOK, 1024, 128, 512}; S.init(g.M, g.N, gridDim.x, blockIdx.x);
                    EpiPool e{proj, p.pool_scale + layer * 1024}; pg8::gemm_phase<EpiPool, 256>(lds, g, S, e); }
                  { pg8::Gemm g{proj + 2048, (const bf16_t*)(W + WO_GA), T_TOK, 1024, 1024, PW}; S.init(g.M, g.N, gridDim.x, blockIdx.x);
                    EpiMerge e{proj}; pg8::gemm_phase(lds, g, S, e); } } break;
        case 6: { pg8::Gemm g{proj, (const bf16_t*)(W + WO_OUT), T_TOK, 1024, 1024, PW}; S.init(g.M, g.N, gridDim.x, blockIdx.x);
                  EpiRes e{xb, ssq}; pg8::gemm_phase(lds, g, S, e); } break;
        case 7: { phase_rs(p); grid_barrier((unsigned*)(p.ws + OFF_BAR), ++bar_k);
                  pg8::Gemm g{xb, (const bf16_t*)(W + WO_F1), T_TOK, 2 * DFF, 1024, 1024}; S.init(g.M, g.N, gridDim.x, blockIdx.x);
                  EpiFfn1 e{(const float*)(p.ws + OFF_RS), proj, ssq}; pg8::gemm_phase(lds, g, S, e); } break;
        case 8: { pg8::Gemm g{proj, (const bf16_t*)(W + WO_F2), T_TOK, 1024, DFF, DFF}; S.init(g.M, g.N, gridDim.x, blockIdx.x);
                  EpiRes e{xb, ssq}; pg8::gemm_phase(lds, g, S, e); } break;
        }
    }
}

extern "C" void kernel_launch(void* const* d_in, const int* in_sizes, int n_in, void* d_out, int out_size, void* d_ws, size_t ws_size, hipStream_t stream) {
    (void)in_sizes; (void)n_in; (void)out_size;
    if (ws_size < WS_NEEDED) return;
    Params p{};
    p.x_in = (const float*)d_in[0]; p.norm_mix = (const float*)d_in[1]; p.w_in = (const float*)d_in[2]; p.wdu_f = (const float*)d_in[3]; p.bd_f = (const float*)d_in[4];
    p.wdu_b = (const float*)d_in[5]; p.bd_b = (const float*)d_in[6]; p.gla_norm = (const float*)d_in[7]; p.w_ga = (const float*)d_in[8]; p.w_pool = (const float*)d_in[9];
    p.pool_scale = (const float*)d_in[10]; p.w_out = (const float*)d_in[11]; p.norm_ffn = (const float*)d_in[12]; p.w_f1 = (const float*)d_in[13]; p.w_f2 = (const float*)d_in[14];
    p.norm_final = (const float*)d_in[15];
    p.xf = (float*)d_out; p.ws = (char*)d_ws;
    hipFuncSetAttribute((const void*)mega, hipFuncAttributeMaxDynamicSharedMemorySize, LDS_BYTES);
    int dev = 0, cus = 0, per = 0;
    hipGetDevice(&dev); hipDeviceGetAttribute(&cus, hipDeviceAttributeMultiprocessorCount, dev);
    hipOccupancyMaxActiveBlocksPerMultiprocessor(&per, mega, 512, LDS_BYTES);
    int grid = cus * (per > 0 ? per : 1); if (grid > 256) grid = 256; if (grid < 1) grid = 1;
#if MK_SINGLE_LAUNCH
    p.phase_lo = 0; p.phase_hi = 20;
    hipMemsetAsync((char*)d_ws + OFF_BAR, 0, 128 * 256, stream);
    void* args[] = {(void*)&p};
    hipLaunchCooperativeKernel((const void*)mega, dim3(grid), dim3(512), args, LDS_BYTES, stream);
#else
    for (int ph = 0; ph < 20; ++ph) { p.phase_lo = ph; p.phase_hi = ph + 1; hipLaunchKernelGGL(mega, dim3(grid), dim3(512), LDS_BYTES, stream, p); }
#endif
}
```

```cpp
#include <hip/hip_runtime.h>
#include <hip/hip_cooperative_groups.h>
namespace cg = cooperative_groups;

#ifndef MK_SINGLE_LAUNCH
#define MK_SINGLE_LAUNCH 1
#endif

#define LAS __attribute__((address_space(3)))
typedef unsigned short bf16_t;
typedef short bf16x8 __attribute__((ext_vector_type(8)));
typedef float f32x4 __attribute__((ext_vector_type(4)));
typedef unsigned u32x4 __attribute__((ext_vector_type(4)));
typedef unsigned u32x2 __attribute__((ext_vector_type(2)));

constexpr int T_TOK = 32768, SEQL = 16384, DM = 1024, PW = 3584, NA = 3840, NB = 2048, DFF = 2816, INW = 5664;
constexpr int LDS_BYTES = 155136;

constexpr size_t SZ_WA = (size_t)NA * 1024 * 2, SZ_WB = (size_t)NB * 1024 * 2, SZ_WGA = (size_t)1024 * 1024 * 2, SZ_WPOOL = (size_t)1024 * 512 * 2,
                 SZ_WOUT = (size_t)1024 * 1024 * 2, SZ_WF1 = (size_t)2 * DFF * 1024 * 2, SZ_WF2 = (size_t)1024 * DFF * 2;
constexpr size_t WO_A = 0, WO_B = WO_A + SZ_WA, WO_GA = WO_B + SZ_WB, WO_POOL = WO_GA + SZ_WGA, WO_OUT = WO_POOL + SZ_WPOOL, WO_F1 = WO_OUT + SZ_WOUT,
                 WO_F2 = WO_F1 + SZ_WF1, SZ_WLAYER = WO_F2 + SZ_WF2;
constexpr size_t OFF_W = 0;
constexpr size_t OFF_XB = OFF_W + 2 * SZ_WLAYER;
constexpr size_t OFF_PROJ = OFF_XB + (size_t)T_TOK * 1024 * 2;
constexpr size_t OFF_LR = OFF_PROJ + (size_t)T_TOK * PW * 2;
constexpr size_t OFF_E = OFF_LR + (size_t)T_TOK * 32 * 4;
constexpr size_t OFF_DLOG = OFF_E + (size_t)16 * 32 * 32768 * 4;
constexpr size_t OFF_O = OFF_DLOG + (size_t)16 * 32 * 128 * 4;
constexpr size_t OFF_SSQ = OFF_O + (size_t)T_TOK * 1024 * 2;
constexpr size_t OFF_BAR = OFF_SSQ + (size_t)T_TOK * 16 * 4;
constexpr size_t OFF_RS = OFF_BAR + 128 * 256;
constexpr size_t OFF_XCH = OFF_RS + (size_t)T_TOK * 4;
constexpr size_t WS_NEEDED = OFF_XCH + (size_t)128 * 4 * 256 * 4;

struct Params {
    const float* x_in; const float* norm_mix; const float* w_in; const float* wdu_f; const float* bd_f; const float* wdu_b; const float* bd_b;
    const float* gla_norm; const float* w_ga; const float* w_pool; const float* pool_scale; const float* w_out; const float* norm_ffn;
    const float* w_f1; const float* w_f2; const float* norm_final;
    float* xf; char* ws;
    int phase_lo, phase_hi;
};

typedef float f32x2 __attribute__((ext_vector_type(2)));
typedef __bf16 bf16x2_t __attribute__((ext_vector_type(2)));
__device__ __forceinline__ int bid_() { int v = __builtin_amdgcn_readfirstlane((int)blockIdx.x); asm volatile("" : "+s"(v)); return v; }
__device__ __forceinline__ int nblk_() { int v = __builtin_amdgcn_readfirstlane((int)gridDim.x); asm volatile("" : "+s"(v)); return v; }
__device__ __forceinline__ unsigned cvt_pk_bf16(float lo, float hi) { const f32x2 v = {lo, hi}; const bf16x2_t b = __builtin_convertvector(v, bf16x2_t); return __builtin_bit_cast(unsigned, b); }
__device__ __forceinline__ float bf2f(unsigned short b) { return __uint_as_float(((unsigned)b) << 16); }
__device__ __forceinline__ float bflo(unsigned w) { return __uint_as_float(w << 16); }
__device__ __forceinline__ float bfhi(unsigned w) { return __uint_as_float(w & 0xffff0000u); }
__device__ __forceinline__ unsigned short f2bf(float f) { return (unsigned short)(cvt_pk_bf16(f, 0.f) & 0xffffu); }
__device__ __forceinline__ float sigmoidf_(float x) { return __builtin_amdgcn_rcpf(1.f + __expf(-x)); }

namespace pg8 {
constexpr int BM = 256, BK = 64, HALF = 128, HTB = HALF * BK * 2, STAGE_BYTES = 8 * HTB, NXCD = 8, WGM = 8;
__device__ __forceinline__ int lds_byte(int r, int c) { const int st = (r >> 4) * 2 + (c >> 5), rr = r & 15, cc = c & 31, ob = rr * 64 + cc * 2; return st * 1024 + (ob ^ (((ob >> 9) & 1) << 5)); }
__device__ __forceinline__ void stage_rc(int b, int& R, int& C) { const int st = b / 1024, sb = b % 1024, swz = sb ^ (((sb >> 9) & 1) << 5); R = (st >> 1) * 16 + swz / 64; C = (st & 1) * 32 + (swz % 64) / 2; }
__device__ __forceinline__ int perm32(int rho) { const int n = rho >> 4, i = rho & 15; return 8 * (i >> 2) + 4 * n + (i & 3); }
struct Unit { int pm, pn; };
struct Gemm { const bf16_t* A; const bf16_t* Bt; int M, N, K, lda; };
struct StaticOrder {
    int nM, nN, nwg, G, c;
    __device__ void init(int M, int N, int G_, int c_) { nM = M / BM; nN = N / BM; nwg = nM * nN; G = G_; c = c_; }
    __device__ bool next(int i, Unit& u) const {
        const long L = (long)i * G + c; if (L >= nwg) return false;
        int wgid = (int)L; { const int q = nwg / NXCD, r = nwg % NXCD, xcd = wgid % NXCD, off = wgid / NXCD; wgid = (xcd < r ? xcd * (q + 1) : r * (q + 1) + (xcd - r) * q) + off; }
        const int nig = WGM * nN, gid = wgid / nig, fm = gid * WGM, gsz = (nM - fm) < WGM ? (nM - fm) : WGM;
        u.pm = fm + ((wgid % nig) % gsz); u.pn = (wgid % nig) / gsz; return true;
    }
};

template <class Epi, int APN = 0, bool ALIGN_EPI = true, bool SP2 = true>
__device__ __forceinline__ void gemm_phase(LAS unsigned char* lds, const Gemm g, const StaticOrder& S, const Epi& E) {
    int tid = threadIdx.x; asm volatile("" : "+v"(tid));
    const int wid = __builtin_amdgcn_readfirstlane(tid >> 6), lane = tid & 63, wr = wid >> 2, wc = wid & 3, fr = lane & 15, fq = lane >> 4;
    int K = g.K; asm volatile("" : "+s"(K));
    const int nt = K / BK;
    unsigned voffA[2], voffB[2];
#pragma unroll
    for (int i = 0; i < 2; ++i) { int R, C; stage_rc(tid * 16 + i * 8192, R, C); const int Rb = Epi::PERM ? ((R & ~31) + perm32(R & 31)) : R;
        voffA[i] = (unsigned)(R * g.lda + C) * 2u; voffB[i] = (unsigned)(Rb * K + C) * 2u; }
    const size_t kstep = (size_t)(BK * 2);
    const size_t hstepA = (size_t)HALF * g.lda * 2, hstepB = (size_t)HALF * K * 2;
    const size_t tstepA = 2 * hstepA, tstepB = 2 * hstepB;
    const unsigned ldsw = (unsigned)wid * 1024u;
    const int aoff = lds_byte(wr * 64 + fr, fq * 8), boff = lds_byte(wc * 32 + fr, fq * 8);
#define PG8_SA(b, h) (((b) * 2 + (h)) * HTB)
#define PG8_SB(b, h) ((4 + (b) * 2 + (h)) * HTB)
#define PG8_STAGE(bufoff, gbase, voff) do { _Pragma("unroll") for (int _i = 0; _i < 2; ++_i) \
        __builtin_amdgcn_global_load_lds((const unsigned*)((const char*)(gbase) + (voff)[_i]), (LAS unsigned*)(lds + (bufoff) + ldsw + _i * 8192), 16, 0, 0); } while (0)
#define PG8_LDA(dst, b, h) do { _Pragma("unroll") for (int m = 0; m < 4; ++m) _Pragma("unroll") for (int k = 0; k < 2; ++k) dst[m][k] = *(const LAS bf16x8*)(lds + PG8_SA(b, h) + aoff + m * 2048 + k * 1024); } while (0)
#define PG8_LDB(dst, b, h) do { _Pragma("unroll") for (int n = 0; n < 2; ++n) _Pragma("unroll") for (int k = 0; k < 2; ++k) dst[n][k] = *(const LAS bf16x8*)(lds + PG8_SB(b, h) + boff + n * 2048 + k * 1024); } while (0)
#define PG8_MMA(ai, bj, At, Bt) do { __builtin_amdgcn_s_setprio(1); _Pragma("unroll") for (int m = 0; m < 4; ++m) _Pragma("unroll") for (int n = 0; n < 2; ++n) _Pragma("unroll") for (int k = 0; k < 2; ++k) \
        acc[ai][bj][m][n] = __builtin_amdgcn_mfma_f32_16x16x32_bf16(Bt[n][k], At[m][k], acc[ai][bj][m][n], 0, 0, 0); __builtin_amdgcn_s_setprio(0); } while (0)
#define PG8_WAIT_V(n) asm volatile("s_waitcnt vmcnt(" #n ")" ::: "memory")
#define PG8_WAIT_L(n) asm volatile("s_waitcnt lgkmcnt(" #n ")" ::: "memory")
#define PG8_BAR __builtin_amdgcn_s_barrier()
#define PG8_SCHED __builtin_amdgcn_sched_barrier(0)
    Unit cur, nxt; int ui = 0;
    if (!S.next(0, cur)) return;
    f32x4 acc[2][2][4][2];
#pragma unroll
    for (int a = 0; a < 2; ++a)
#pragma unroll
        for (int b = 0; b < 2; ++b)
#pragma unroll
            for (int m = 0; m < 4; ++m)
#pragma unroll
                for (int n = 0; n < 2; ++n) acc[a][b][m][n] = (f32x4){0.f, 0.f, 0.f, 0.f};
    bf16x8 At[4][2], B0[2][2], B1[2][2];
    const char* cA = (const char*)g.A + (size_t)cur.pm * tstepA + (size_t)cur.pn * APN; const char* cB = (const char*)g.Bt + (size_t)cur.pn * tstepB;
    if constexpr (SP2) {
        PG8_STAGE(PG8_SB(0, 0), cB, voffB); PG8_STAGE(PG8_SB(0, 1), cB + hstepB, voffB); PG8_STAGE(PG8_SA(0, 0), cA, voffA); PG8_STAGE(PG8_SA(0, 1), cA + hstepA, voffA);
        if (wr == 1) PG8_BAR;
        PG8_WAIT_V(2); PG8_BAR;
        PG8_STAGE(PG8_SB(1, 0), cB + kstep, voffB); PG8_STAGE(PG8_SA(1, 0), cA + kstep, voffA); PG8_STAGE(PG8_SB(1, 1), cB + hstepB + kstep, voffB);
        PG8_WAIT_V(6); PG8_BAR;
    } else {
        PG8_STAGE(PG8_SB(0, 0), cB, voffB); PG8_STAGE(PG8_SA(0, 0), cA, voffA); PG8_STAGE(PG8_SB(0, 1), cB + hstepB, voffB); PG8_STAGE(PG8_SA(0, 1), cA + hstepA, voffA);
        if (wr == 1) PG8_BAR;
        PG8_WAIT_V(4); PG8_BAR;
        PG8_STAGE(PG8_SB(1, 0), cB + kstep, voffB); PG8_STAGE(PG8_SA(1, 0), cA + kstep, voffA); PG8_STAGE(PG8_SB(1, 1), cB + hstepB + kstep, voffB);
        PG8_WAIT_V(6); PG8_BAR;
    }
    for (;;) {
        const bool has_next = S.next(ui + 1, nxt);
        const unsigned rsoff = (unsigned)STAGE_BYTES + (unsigned)(ui & 1) * 1024u;
        if constexpr (Epi::NEEDS_RS) { if (wid < 4) __builtin_amdgcn_global_load_lds((const unsigned*)(E.rsv + cur.pm * 256 + wid * 64 + lane), (LAS unsigned*)(lds + rsoff + wid * 256), 4, 0, 0); }
        const char* nA = has_next ? (const char*)g.A + (size_t)nxt.pm * tstepA + (size_t)nxt.pn * APN : cA; const char* nB = has_next ? (const char*)g.Bt + (size_t)nxt.pn * tstepB : cB;
        for (int t = 0; t < nt; t += 2) {
            const bool last = (t == nt - 2);
            const char* a1 = cA + (size_t)(t + 1) * kstep;
            const char* a2 = last ? nA : cA + (size_t)(t + 2) * kstep; const char* b2 = last ? nB : cB + (size_t)(t + 2) * kstep;
            const char* a3 = a2 + kstep; const char* b3 = b2 + kstep;
            if constexpr (SP2) {
            PG8_LDB(B0, 0, 0); PG8_LDB(B1, 0, 1); PG8_SCHED; PG8_LDA(At, 0, 0); PG8_STAGE(PG8_SA(1, 1), a1 + hstepA, voffA);
            PG8_WAIT_V(8); PG8_WAIT_L(0); PG8_BAR; PG8_MMA(0, 0, At, B0); PG8_MMA(0, 1, At, B1); PG8_BAR; PG8_SCHED;
            PG8_LDA(At, 0, 1); PG8_STAGE(PG8_SB(0, 0), b2, voffB); PG8_STAGE(PG8_SB(0, 1), b2 + hstepB, voffB); PG8_STAGE(PG8_SA(0, 0), a2, voffA);
            PG8_WAIT_V(8); PG8_WAIT_L(0); PG8_BAR; PG8_MMA(1, 0, At, B0); PG8_MMA(1, 1, At, B1); PG8_BAR; PG8_SCHED;
            PG8_LDB(B0, 1, 0); PG8_LDB(B1, 1, 1); PG8_SCHED; PG8_LDA(At, 1, 0); PG8_STAGE(PG8_SA(0, 1), a2 + hstepA, voffA);
            PG8_WAIT_V(8); PG8_WAIT_L(0); PG8_BAR; PG8_MMA(0, 0, At, B0); PG8_MMA(0, 1, At, B1); PG8_BAR; PG8_SCHED;
            PG8_LDA(At, 1, 1); PG8_STAGE(PG8_SB(1, 0), b3, voffB); PG8_STAGE(PG8_SB(1, 1), b3 + hstepB, voffB); PG8_STAGE(PG8_SA(1, 0), a3, voffA);
            PG8_WAIT_V(8); PG8_WAIT_L(0); PG8_BAR; PG8_MMA(1, 0, At, B0); PG8_MMA(1, 1, At, B1); PG8_BAR; PG8_SCHED;
            } else {
            PG8_LDB(B0, 0, 0); PG8_SCHED; PG8_LDA(At, 0, 0); PG8_STAGE(PG8_SA(1, 1), a1 + hstepA, voffA);
            PG8_WAIT_L(8); PG8_BAR; PG8_WAIT_L(0); PG8_MMA(0, 0, At, B0); PG8_BAR; PG8_SCHED;
            PG8_LDB(B1, 0, 1); PG8_STAGE(PG8_SB(0, 0), b2, voffB);
            PG8_BAR; PG8_WAIT_L(0); PG8_MMA(0, 1, At, B1); PG8_BAR;
            PG8_LDA(At, 0, 1); PG8_STAGE(PG8_SA(0, 0), a2, voffA);
            PG8_BAR; PG8_WAIT_L(0); PG8_MMA(1, 0, At, B0); PG8_BAR; PG8_SCHED;
            PG8_STAGE(PG8_SB(0, 1), b2 + hstepB, voffB);
            PG8_WAIT_V(6); PG8_BAR; PG8_MMA(1, 1, At, B1); PG8_BAR;
            PG8_LDB(B0, 1, 0); PG8_SCHED; PG8_LDA(At, 1, 0); PG8_STAGE(PG8_SA(0, 1), a2 + hstepA, voffA);
            PG8_WAIT_L(8); PG8_BAR; PG8_WAIT_L(0); PG8_MMA(0, 0, At, B0); PG8_BAR; PG8_SCHED;
            PG8_LDB(B1, 1, 1); PG8_STAGE(PG8_SB(1, 0), b3, voffB);
            PG8_BAR; PG8_WAIT_L(0); PG8_MMA(0, 1, At, B1); PG8_BAR;
            PG8_LDA(At, 1, 1); PG8_STAGE(PG8_SA(1, 0), a3, voffA);
            PG8_BAR; PG8_WAIT_L(0); PG8_MMA(1, 0, At, B0); PG8_BAR; PG8_SCHED;
            PG8_STAGE(PG8_SB(1, 1), b3 + hstepB, voffB);
            PG8_WAIT_V(6); PG8_BAR; PG8_MMA(1, 1, At, B1); PG8_BAR;
            }
        }
        if constexpr (ALIGN_EPI) { if (wr == 0) PG8_BAR; }
        E(acc, cur, wr, wc, fr, fq, (const LAS float*)(lds + rsoff));
        if (!has_next) break;
#pragma unroll
        for (int a = 0; a < 2; ++a)
#pragma unroll
            for (int b = 0; b < 2; ++b)
#pragma unroll
                for (int m = 0; m < 4; ++m)
#pragma unroll
                    for (int n = 0; n < 2; ++n) acc[a][b][m][n] = (f32x4){0.f, 0.f, 0.f, 0.f};
        cur = nxt; cA = nA; cB = nB; ++ui;
        if constexpr (ALIGN_EPI) { if (wr == 1) PG8_BAR; }
    }
    PG8_WAIT_V(0);
    if constexpr (!ALIGN_EPI) { if (wr == 0) PG8_BAR; }
    PG8_BAR;
#undef PG8_SA
#undef PG8_SB
#undef PG8_STAGE
#undef PG8_LDA
#undef PG8_LDB
#undef PG8_MMA
#undef PG8_WAIT_V
#undef PG8_WAIT_L
#undef PG8_BAR
#undef PG8_SCHED
}
}
using pg8::Unit;

__device__ __forceinline__ float rowscale(const float* ssq, int row) {
    const f32x4* s = (const f32x4*)(ssq + (size_t)row * 16);
    const f32x4 a = s[0], b = s[1], c = s[2], d = s[3];
    const float t = ((a[0] + a[1]) + (a[2] + a[3])) + ((b[0] + b[1]) + (b[2] + b[3])) + ((c[0] + c[1]) + (c[2] + c[3])) + ((d[0] + d[1]) + (d[2] + d[3]));
    return rsqrtf(t * (1.f / 1024.f) + 1e-6f);
}
__device__ __forceinline__ u32x4 pack8(const f32x4 v0, const f32x4 v1) {
    u32x4 w; w.x = cvt_pk_bf16(v0[0], v0[1]); w.y = cvt_pk_bf16(v0[2], v0[3]); w.z = cvt_pk_bf16(v1[0], v1[1]); w.w = cvt_pk_bf16(v1[2], v1[3]); return w;
}

struct EpiA {
    static constexpr bool PERM = true;
    static constexpr bool NEEDS_RS = true; const float* rsv;
    bf16_t* P; bf16_t* lr; const float* ssq;
    __device__ __forceinline__ void operator()(const f32x4 (&acc)[2][2][4][2], const Unit& u, int wr, int wc, int fr, int fq, const LAS float* rsl) const {
        const int row0 = u.pm * 256 + wr * 64 + fr;
#pragma unroll
        for (int ai = 0; ai < 2; ++ai)
#pragma unroll
            for (int m = 0; m < 4; ++m) {
                const int row = row0 + ai * 128 + m * 16; const float rs = rsl[ai * 128 + wr * 64 + m * 16 + fr];
                if (u.pn < 14) {
#pragma unroll
                    for (int bj = 0; bj < 2; ++bj) {
                        const f32x4 v0 = acc[ai][bj][m][0] * rs, v1 = acc[ai][bj][m][1] * rs;
                        *(u32x4*)(P + (size_t)row * PW + u.pn * 256 + bj * 128 + wc * 32 + 8 * fq) = pack8(v0, v1);
                    }
                } else if (wc == 0) {
                    const f32x4 v0 = acc[ai][0][m][0] * rs, v1 = acc[ai][0][m][1] * rs;
                    const u32x4 hi = pack8(v0, v1);
                    const f32x4 d0 = (f32x4){v0[0] - bflo(hi.x), v0[1] - bfhi(hi.x), v0[2] - bflo(hi.y), v0[3] - bfhi(hi.y)};
                    const f32x4 d1 = (f32x4){v1[0] - bflo(hi.z), v1[1] - bfhi(hi.z), v1[2] - bflo(hi.w), v1[3] - bfhi(hi.w)};
                    bf16_t* lp = lr + (size_t)row * 64 + (fq >> 1) * 32 + (fq & 1) * 8;
                    *(u32x4*)lp = hi; *(u32x4*)(lp + 16) = pack8(d0, d1);
                }
            }
    }
};
struct EpiGate {
    static constexpr bool PERM = true;
    static constexpr bool NEEDS_RS = true; const float* rsv;
    bf16_t* P; const float* ssq;
    __device__ __forceinline__ void operator()(const f32x4 (&acc)[2][2][4][2], const Unit& u, int wr, int wc, int fr, int fq, const LAS float* rsl) const {
        const int row0 = u.pm * 256 + wr * 64 + fr;
#pragma unroll
        for (int ai = 0; ai < 2; ++ai)
#pragma unroll
            for (int m = 0; m < 4; ++m) {
                const int row = row0 + ai * 128 + m * 16; const float rs = rsl[ai * 128 + wr * 64 + m * 16 + fr];
#pragma unroll
                for (int bj = 0; bj < 2; ++bj) {
                    f32x4 v0 = acc[ai][bj][m][0] * rs, v1 = acc[ai][bj][m][1] * rs;
#pragma unroll
                    for (int j = 0; j < 4; ++j) { v0[j] = sigmoidf_(v0[j]); v1[j] = sigmoidf_(v1[j]); }
                    *(u32x4*)(P + (size_t)row * PW + u.pn * 256 + bj * 128 + wc * 32 + 8 * fq) = pack8(v0, v1);
                }
                asm volatile("" ::: "memory");
            }
    }
};
struct EpiPool {
    static constexpr bool PERM = true;
    static constexpr bool NEEDS_RS = false;
    bf16_t* P; const float* pscale;
    __device__ __forceinline__ void operator()(const f32x4 (&acc)[2][2][4][2], const Unit& u, int wr, int wc, int fr, int fq, const LAS float* rsl) const {
        const int row0 = u.pm * 256 + wr * 64 + fr;
#pragma unroll
        for (int bj = 0; bj < 2; ++bj) {
            const int col = u.pn * 256 + bj * 128 + wc * 32 + 8 * fq;
            const f32x4 p0 = *(const f32x4*)(pscale + col), p1 = *(const f32x4*)(pscale + col + 4);
#pragma unroll
            for (int ai = 0; ai < 2; ++ai)
#pragma unroll
                for (int m = 0; m < 4; ++m) {
                    const int row = row0 + ai * 128 + m * 16;
                    bf16_t* ptr = P + (size_t)row * PW + 1024 + col;
                    const u32x4 g = *(const u32x4*)ptr;
                    f32x4 v0 = acc[ai][bj][m][0] * p0, v1 = acc[ai][bj][m][1] * p1;
                    v0[0] *= bflo(g.x); v0[1] *= bfhi(g.x); v0[2] *= bflo(g.y); v0[3] *= bfhi(g.y);
                    v1[0] *= bflo(g.z); v1[1] *= bfhi(g.z); v1[2] *= bflo(g.w); v1[3] *= bfhi(g.w);
                    *(u32x4*)ptr = pack8(v0, v1);
                    if (m & 1) asm volatile("" ::: "memory");
                }
        }
    }
};
struct EpiMerge {
    static constexpr bool PERM = true;
    static constexpr bool NEEDS_RS = false;
    bf16_t* P;
    __device__ __forceinline__ void operator()(const f32x4 (&acc)[2][2][4][2], const Unit& u, int wr, int wc, int fr, int fq, const LAS float* rsl) const {
        const int row0 = u.pm * 256 + wr * 64 + fr;
#pragma unroll
        for (int ai = 0; ai < 2; ++ai)
#pragma unroll
            for (int m = 0; m < 4; ++m) {
                const int row = row0 + ai * 128 + m * 16;
#pragma unroll
                for (int bj = 0; bj < 2; ++bj) {
                    bf16_t* ptr = P + (size_t)row * PW + u.pn * 256 + bj * 128 + wc * 32 + 8 * fq;
                    const u32x4 g = *(const u32x4*)ptr; const u32x4 t = *(const u32x4*)(ptr + 1024);
                    f32x4 v0 = acc[ai][bj][m][0], v1 = acc[ai][bj][m][1];
                    v0[0] = v0[0] * bflo(g.x) + bflo(t.x); v0[1] = v0[1] * bfhi(g.x) + bfhi(t.x); v0[2] = v0[2] * bflo(g.y) + bflo(t.y); v0[3] = v0[3] * bfhi(g.y) + bfhi(t.y);
                    v1[0] = v1[0] * bflo(g.z) + bflo(t.z); v1[1] = v1[1] * bfhi(g.z) + bfhi(t.z); v1[2] = v1[2] * bflo(g.w) + bflo(t.w); v1[3] = v1[3] * bfhi(g.w) + bfhi(t.w);
                    *(u32x4*)ptr = pack8(v0, v1);
                }
                asm volatile("" ::: "memory");
            }
    }
};
struct EpiRes {
    static constexpr bool PERM = true;
    static constexpr bool NEEDS_RS = false;
    bf16_t* xb; float* ssq;
    __device__ __forceinline__ void operator()(const f32x4 (&acc)[2][2][4][2], const Unit& u, int wr, int wc, int fr, int fq, const LAS float* rsl) const {
        const int row0 = u.pm * 256 + wr * 64 + fr;
#pragma unroll
        for (int ai = 0; ai < 2; ++ai)
#pragma unroll
            for (int m = 0; m < 4; ++m) {
                const int row = row0 + ai * 128 + m * 16; float s = 0.f;
#pragma unroll
                for (int bj = 0; bj < 2; ++bj) {
                    bf16_t* ptr = xb + (size_t)row * 1024 + u.pn * 256 + bj * 128 + wc * 32 + 8 * fq;
                    const u32x4 g = *(const u32x4*)ptr;
                    f32x4 v0 = acc[ai][bj][m][0], v1 = acc[ai][bj][m][1];
                    v0[0] += bflo(g.x); v0[1] += bfhi(g.x); v0[2] += bflo(g.y); v0[3] += bfhi(g.y);
                    v1[0] += bflo(g.z); v1[1] += bfhi(g.z); v1[2] += bflo(g.w); v1[3] += bfhi(g.w);
                    *(u32x4*)ptr = pack8(v0, v1);
                    s += (v0[0] * v0[0] + v0[1] * v0[1]) + (v0[2] * v0[2] + v0[3] * v0[3]) + (v1[0] * v1[0] + v1[1] * v1[1]) + (v1[2] * v1[2] + v1[3] * v1[3]);
                }
                s += __shfl_xor(s, 16); s += __shfl_xor(s, 32);
                if (fq == 0) ssq[(size_t)row * 16 + u.pn * 4 + wc] = s;
            }
    }
};
struct EpiResFinal {
    static constexpr bool PERM = true;
    static constexpr bool NEEDS_RS = false;
    char* ws; LAS unsigned char* lx;
    __device__ __forceinline__ void operator()(const f32x4 (&acc)[2][2][4][2], const Unit& u, int wr, int wc, int fr, int fq, const LAS float* rsl) const {
        const int row0 = u.pm * 256 + wr * 64 + fr, tid = threadIdx.x;
        const Params __attribute__((address_space(4)))* kp = (const Params __attribute__((address_space(4)))*)__builtin_amdgcn_kernarg_segment_ptr();
        const bf16_t* xb = (const bf16_t*)(ws + OFF_XB); float* out = kp->xf; const float* gfin = kp->norm_final;
        float* xch = (float*)(ws + OFF_XCH); unsigned* cnt = (unsigned*)(ws + OFF_BAR) + 6144;
#pragma unroll
        for (int ai = 0; ai < 2; ++ai) {
#pragma unroll
            for (int m = 0; m < 4; ++m) { float s = 0.f;
                u32x4 g2[2];
#pragma unroll
                for (int bj = 0; bj < 2; ++bj) g2[bj] = *(const u32x4*)(xb + (size_t)(row0 + ai * 128 + m * 16) * 1024 + u.pn * 256 + bj * 128 + wc * 32 + 8 * fq);
#pragma unroll
                for (int bj = 0; bj < 2; ++bj) { const u32x4 gg = g2[bj]; f32x4 v0 = acc[ai][bj][m][0], v1 = acc[ai][bj][m][1];
                    v0[0] += bflo(gg.x); v0[1] += bfhi(gg.x); v0[2] += bflo(gg.y); v0[3] += bfhi(gg.y); v1[0] += bflo(gg.z); v1[1] += bfhi(gg.z); v1[2] += bflo(gg.w); v1[3] += bfhi(gg.w);
                    s += (v0[0] * v0[0] + v0[1] * v0[1]) + (v0[2] * v0[2] + v0[3] * v0[3]) + (v1[0] * v1[0] + v1[1] * v1[1]) + (v1[2] * v1[2] + v1[3] * v1[3]); }
                s += __shfl_xor(s, 16); s += __shfl_xor(s, 32);
                if (fq == 0) *(LAS float*)(lx + ((ai * 128 + wr * 64 + m * 16 + fr) * 4 + wc) * 4) = s;
                if (m & 1) asm volatile("" ::: "memory"); }
        }
        __builtin_amdgcn_s_waitcnt(0xc07f);
        __builtin_amdgcn_s_barrier();
        if (tid < 256) { const f32x4 q = *(LAS f32x4*)(lx + tid * 16);
            __hip_atomic_store(xch + (size_t)(u.pm * 4 + u.pn) * 256 + tid, (q[0] + q[1]) + (q[2] + q[3]), __ATOMIC_RELAXED, __HIP_MEMORY_SCOPE_AGENT); }
        asm volatile("s_waitcnt vmcnt(0)" ::: "memory");
        __builtin_amdgcn_s_barrier();
        if (tid == 0) { __hip_atomic_fetch_add(cnt + 16 * u.pm, 1u, __ATOMIC_RELAXED, __HIP_MEMORY_SCOPE_AGENT);
            unsigned polls = 0; while (__hip_atomic_load(cnt + 16 * u.pm, __ATOMIC_RELAXED, __HIP_MEMORY_SCOPE_AGENT) < 4u && ++polls < (1u << 22)) __builtin_amdgcn_s_sleep(1); }
        __builtin_amdgcn_s_barrier();
        if (tid < 256) { float t = 0.f;
#pragma unroll
            for (int j = 0; j < 4; ++j) t += __hip_atomic_load(xch + (size_t)(u.pm * 4 + j) * 256 + tid, __ATOMIC_RELAXED, __HIP_MEMORY_SCOPE_AGENT);
            *(LAS float*)(lx + 4096 + tid * 4) = rsqrtf(t * (1.f / 1024.f) + 1e-6f); }
        __builtin_amdgcn_s_waitcnt(0xc07f);
        __builtin_amdgcn_s_barrier();
        f32x4 wf[2][2];
#pragma unroll
        for (int bj = 0; bj < 2; ++bj) { const int col = u.pn * 256 + bj * 128 + wc * 32 + 8 * fq; wf[bj][0] = *(const f32x4*)(gfin + col); wf[bj][1] = *(const f32x4*)(gfin + col + 4); }
#pragma unroll
        for (int ai = 0; ai < 2; ++ai)
#pragma unroll
            for (int m = 0; m < 4; ++m) { const float rs = *(LAS float*)(lx + 4096 + (ai * 128 + wr * 64 + m * 16 + fr) * 4);
                u32x4 g2[2];
#pragma unroll
                for (int bj = 0; bj < 2; ++bj) g2[bj] = *(const u32x4*)(xb + (size_t)(row0 + ai * 128 + m * 16) * 1024 + u.pn * 256 + bj * 128 + wc * 32 + 8 * fq);
#pragma unroll
                for (int bj = 0; bj < 2; ++bj) { const u32x4 gg = g2[bj]; f32x4 v0 = acc[ai][bj][m][0], v1 = acc[ai][bj][m][1];
                    v0[0] += bflo(gg.x); v0[1] += bfhi(gg.x); v0[2] += bflo(gg.y); v0[3] += bfhi(gg.y); v1[0] += bflo(gg.z); v1[1] += bfhi(gg.z); v1[2] += bflo(gg.w); v1[3] += bfhi(gg.w);
                    float* op = out + (size_t)(row0 + ai * 128 + m * 16) * 1024 + u.pn * 256 + bj * 128 + wc * 32 + 8 * fq;
                    *(f32x4*)op = v0 * rs * wf[bj][0]; *(f32x4*)(op + 4) = v1 * rs * wf[bj][1]; }
                if (m & 1) asm volatile("" ::: "memory"); }
    }
};
struct EpiFfn1 {
    static constexpr bool PERM = true;
    static constexpr bool NEEDS_RS = true; const float* rsv;
    bf16_t* ACT; const float* ssq;
    __device__ __forceinline__ void operator()(const f32x4 (&acc)[2][2][4][2], const Unit& u, int wr, int wc, int fr, int fq, const LAS float* rsl) const {
        const int row0 = u.pm * 256 + wr * 64 + fr;
#pragma unroll
        for (int ai = 0; ai < 2; ++ai)
#pragma unroll
            for (int m = 0; m < 4; ++m) {
                const int row = row0 + ai * 128 + m * 16; const float rs = rsl[ai * 128 + wr * 64 + m * 16 + fr];
                f32x4 o[2];
#pragma unroll
                for (int n = 0; n < 2; ++n)
#pragma unroll
                    for (int j = 0; j < 4; ++j) { const float gt = acc[ai][0][m][n][j] * rs, up = acc[ai][1][m][n][j] * rs; o[n][j] = gt * sigmoidf_(gt) * up; }
                *(u32x4*)(ACT + (size_t)row * DFF + u.pn * 128 + wc * 32 + 8 * fq) = pack8(o[0], o[1]);
                asm volatile("" ::: "memory");
            }
    }
};

struct WJob { const float* src; const float* g; bf16_t* dst; int ld, ldd, vlo, vhi, kw; };
__device__ __forceinline__ WJob wjob_decode(const Params& p, int layer, int j) {
    WJob w; w.g = nullptr; w.vlo = 0; w.vhi = 256; w.kw = 256;
    bf16_t* W = (bf16_t*)(p.ws + OFF_W + (size_t)layer * SZ_WLAYER);
    if (j < 480) { const int nb = j >> 2, kb = j & 3, n0 = nb * 32; int c0;
        if (n0 < 3072) c0 = n0; else if (n0 < 3584) c0 = 3104 + (n0 - 3072); else if (n0 == 3584) c0 = 3072; else { c0 = 0; w.vhi = 0; }
        w.src = p.w_in + (size_t)layer * 1024 * INW + (size_t)kb * 256 * INW + c0; w.ld = INW; w.g = p.norm_mix + layer * 1024 + kb * 256;
        w.dst = (bf16_t*)((char*)W + WO_A) + (size_t)n0 * 1024 + kb * 256; w.ldd = 1024; return w; }
    j -= 480;
    if (j < 256) { const int nb = j >> 2, kb = j & 3, n0 = nb * 32;
        w.src = p.w_in + (size_t)layer * 1024 * INW + (size_t)kb * 256 * INW + 3616 + n0; w.ld = INW; w.g = p.norm_mix + layer * 1024 + kb * 256;
        w.dst = (bf16_t*)((char*)W + WO_B) + (size_t)n0 * 1024 + kb * 256; w.ldd = 1024; return w; }
    j -= 256;
    if (j < 128) { const int nb = j >> 2, kb = j & 3, n0 = nb * 32;
        w.src = p.w_ga + (size_t)layer * 1024 * 1024 + (size_t)kb * 256 * 1024 + n0; w.ld = 1024;
        w.dst = (bf16_t*)((char*)W + WO_GA) + (size_t)n0 * 1024 + kb * 256; w.ldd = 1024; return w; }
    j -= 128;
    if (j < 64) { const int nb = j >> 1, kb = j & 1, n0 = nb * 32, grp = n0 >> 8;
        w.src = p.w_pool + (size_t)layer * 4 * 128 * 256 + (size_t)grp * 128 * 256 + (n0 & 255); w.ld = 256;
        w.vlo = 0; w.vhi = kb == 0 ? 128 : 0; w.kw = kb == 0 ? 128 : 0;
        w.dst = (bf16_t*)((char*)W + WO_POOL) + (size_t)n0 * 128; w.ldd = 128; return w; }
    j -= 64;
    if (j < 128) { const int nb = j >> 2, kb = j & 3, n0 = nb * 32;
        w.src = p.w_out + (size_t)layer * 1024 * 1024 + (size_t)kb * 256 * 1024 + n0; w.ld = 1024;
        w.dst = (bf16_t*)((char*)W + WO_OUT) + (size_t)n0 * 1024 + kb * 256; w.ldd = 1024; return w; }
    j -= 128;
    if (j < 704) { const int nb = j >> 2, kb = j & 3, n0 = nb * 32, pn = n0 >> 8, within = n0 & 255;
        const int c0 = within < 128 ? 128 * pn + within : DFF + 128 * pn + (within - 128);
        w.src = p.w_f1 + (size_t)layer * 1024 * 2 * DFF + (size_t)kb * 256 * 2 * DFF + c0; w.ld = 2 * DFF; w.g = p.norm_ffn + layer * 1024 + kb * 256;
        w.dst = (bf16_t*)((char*)W + WO_F1) + (size_t)n0 * 1024 + kb * 256; w.ldd = 1024; return w; }
    j -= 704;
    { const int nb = j / 11, kb = j % 11, n0 = nb * 32;
        w.src = p.w_f2 + (size_t)layer * DFF * 1024 + (size_t)kb * 256 * 1024 + n0; w.ld = 1024;
        w.dst = (bf16_t*)((char*)W + WO_F2) + (size_t)n0 * DFF + kb * 256; w.ldd = DFF; return w; }
}

__device__ __forceinline__ void phase_prep(LAS unsigned char* lds, const Params& p) {
    int tid = threadIdx.x; asm volatile("" : "+v"(tid));
    const int wid = tid >> 6, lane = tid & 63;
    {
        f32x4 v[4]; WJob w, wn; int buf = 0;
#define PREP_LOAD(W_) do { _Pragma("unroll") for (int ps = 0; ps < 4; ++ps) { const int kk = (tid >> 3) + 64 * ps, c4 = (tid & 7) * 4; \
            v[ps] = (f32x4){0.f, 0.f, 0.f, 0.f}; \
            if (kk >= (W_).vlo && kk < (W_).vhi) { v[ps] = *(const f32x4*)((W_).src + (size_t)kk * (W_).ld + c4); if ((W_).g) v[ps] = v[ps] * (W_).g[kk]; } } } while (0)
        int job = bid_();
        if (job < 2 * 2112) { w = wjob_decode(p, job / 2112, job % 2112); PREP_LOAD(w); }
        for (; job < 2 * 2112; job += nblk_()) {
            const int tb = buf * 33792;
#pragma unroll
            for (int ps = 0; ps < 4; ++ps) { const int kk = (tid >> 3) + 64 * ps, c4 = (tid & 7) * 4;
#pragma unroll
                for (int e = 0; e < 4; ++e) *(LAS float*)(lds + tb + (kk * 33 + c4 + e) * 4) = v[ps][e]; }
            __syncthreads();
            const int nj = job + nblk_();
            if (nj < 2 * 2112) { wn = wjob_decode(p, nj / 2112, nj % 2112); PREP_LOAD(wn); }
            { const int n = tid & 31, s = tid >> 5; unsigned pk[8];
#pragma unroll
                for (int e = 0; e < 8; ++e) { const float a = *(LAS float*)(lds + tb + ((s * 16 + 2 * e) * 33 + n) * 4), b = *(LAS float*)(lds + tb + ((s * 16 + 2 * e + 1) * 33 + n) * 4); pk[e] = cvt_pk_bf16(a, b); }
                bf16_t* d = w.dst + (size_t)n * w.ldd + s * 16;
                if (s * 16 < w.kw) { *(u32x4*)d = (u32x4){pk[0], pk[1], pk[2], pk[3]}; *(u32x4*)(d + 8) = (u32x4){pk[4], pk[5], pk[6], pk[7]}; } }
            w = wn; buf ^= 1;
        }
#undef PREP_LOAD
        __syncthreads();
    }
    bf16_t* xb = (bf16_t*)(p.ws + OFF_XB); float* ssq = (float*)(p.ws + OFF_SSQ);
    for (int row0 = bid_() * 8 + wid; row0 < T_TOK; row0 += nblk_() * 16) {
        f32x4 v[2][4]; bool ok[2];
#pragma unroll
        for (int u = 0; u < 2; ++u) { const int row = row0 + u * nblk_() * 8; ok[u] = row < T_TOK;
            if (ok[u]) { const float* src = p.x_in + (size_t)row * 1024 + lane * 16;
#pragma unroll
                for (int i = 0; i < 4; ++i) v[u][i] = *(const f32x4*)(src + 4 * i); } }
#pragma unroll
        for (int u = 0; u < 2; ++u) if (ok[u]) { const int row = row0 + u * nblk_() * 8;
            float s = 0.f;
#pragma unroll
            for (int i = 0; i < 4; ++i) s += (v[u][i][0] * v[u][i][0] + v[u][i][1] * v[u][i][1]) + (v[u][i][2] * v[u][i][2] + v[u][i][3] * v[u][i][3]);
#pragma unroll
            for (int o = 32; o >= 1; o >>= 1) s += __shfl_xor(s, o);
            bf16_t* dst = xb + (size_t)row * 1024 + lane * 16;
            *(u32x4*)dst = pack8(v[u][0], v[u][1]); *(u32x4*)(dst + 8) = pack8(v[u][2], v[u][3]);
            if (lane < 16) ssq[(size_t)row * 16 + lane] = lane == 0 ? s : 0.f;
            if (lane == 0) ((float*)(p.ws + OFF_RS))[row] = rsqrtf(s * (1.f / 1024.f) + 1e-6f); }
    }
}

#define MFMA16(a, b, c) __builtin_amdgcn_mfma_f32_16x16x32_bf16((a), (b), (c), 0, 0, 0)
template <bool PASS2>
__device__ __forceinline__ void gla_pass(LAS unsigned char* lds, const Params& p, int layer) {
    constexpr int SQ = 0, SKD = 17408, SV = 35840, SP = 69632, SLR = 78848, SDEC = 84992, SST = 85504, SK = SST, SX = SST + 17408, SCOL = SST + 51200;
    int tid = threadIdx.x; asm volatile("" : "+v"(tid));
    const int wid = __builtin_amdgcn_readfirstlane(tid >> 6), lane = tid & 63, fr = lane & 15, fq = lane >> 4;
    const int dk0 = (tid & 63) * 2;
    bf16_t* P = (bf16_t*)(p.ws + OFF_PROJ);
    const bf16_t* LR = (const bf16_t*)(p.ws + OFF_LR);
    bf16_t* QT = (bf16_t*)(p.ws + OFF_E + (size_t)32 * 1024 * 1024);
    bf16_t* O = (bf16_t*)(p.ws + OFF_O);
    for (int item = bid_(); item < 256; item += nblk_()) {
        const int b = item >> 7, h = (item >> 5) & 3, grp = item & 31;
#pragma unroll 1
        for (int dir = 0; dir < 2; ++dir) {
            const int scan = (b * 4 + h) * 2 + dir;
            bf16x8 wB1, wB2; float biasx;
            { const float* Wc = (dir ? p.wdu_b : p.wdu_f) + (size_t)layer * 16 * 512 + h * 128 + wid * 16 + fr;
              float wv[8]; unsigned h1[4], h2[4];
#pragma unroll
              for (int j = 0; j < 8; ++j) wv[j] = Wc[((fq & 1) * 8 + j) * 512];
#pragma unroll
              for (int jp = 0; jp < 4; ++jp) { const float a = wv[2 * jp], bq = wv[2 * jp + 1]; const unsigned hi = cvt_pk_bf16(a, bq);
                  const unsigned lo = cvt_pk_bf16(a - bflo(hi), bq - bfhi(hi)); h1[jp] = hi; h2[jp] = fq < 2 ? lo : 0u; }
              wB1 = __builtin_bit_cast(bf16x8, (u32x4){h1[0], h1[1], h1[2], h1[3]}); wB2 = __builtin_bit_cast(bf16x8, (u32x4){h2[0], h2[1], h2[2], h2[3]});
              biasx = (dir ? p.bd_b : p.bd_f)[layer * 512 + h * 128 + wid * 16 + fr]; }
            f32x4 accS[8][2];
#pragma unroll
            for (int m8 = 0; m8 < 8; ++m8)
#pragma unroll
                for (int n = 0; n < 2; ++n) accS[m8][n] = (f32x4){0.f, 0.f, 0.f, 0.f};
            float gtot0 = 0.f, gtot1 = 0.f;
            u32x4 rk[2], rq[2], rv[4]; u32x4 rl = (u32x4){0u, 0u, 0u, 0u};
#define GLA_ISSUE(CC) do { const int chunk_ = dir ? 7 - (CC) : (CC); const int t0_ = b * SEQL + grp * 512 + chunk_ * 64; \
                _Pragma("unroll") for (int it = 0; it < 2; ++it) { const int pi = tid + 512 * it, row = pi >> 4, seg = pi & 15; \
                    const bf16_t* src = P + (size_t)(t0_ + row) * PW + h * 128 + seg * 8; rk[it] = *(const u32x4*)(src + 512); } \
                if (tid < 256) { const int row = tid >> 2, seg = tid & 3; rl = *(const u32x4*)(LR + (size_t)(t0_ + row) * 64 + dir * 32 + seg * 8); } } while (0)
            GLA_ISSUE(0);
#pragma unroll 1
            for (int cc = 0; cc < 8; ++cc) {
                const int chunk = dir ? 7 - cc : cc;
                const int t0 = b * SEQL + grp * 512 + chunk * 64;
#pragma unroll
                for (int it = 0; it < 2; ++it) { const int pi = tid + 512 * it, row = pi >> 4, seg = pi & 15;
                    *(LAS u32x4*)(lds + SK + row * 272 + seg * 16) = rk[it];
                    if (PASS2) rq[it] = *(const u32x4*)(P + (size_t)(t0 + row) * PW + h * 128 + seg * 8); }
#pragma unroll
                for (int it = 0; it < 4; ++it) { const int pi = tid + 512 * it, row = pi >> 5, seg = pi & 31;
                    rv[it] = *(const u32x4*)(P + (size_t)(t0 + row) * PW + 1024 + h * 256 + seg * 8); }
                if (tid < 256) { const int row = tid >> 2, seg = tid & 3; *(LAS u32x4*)(lds + SLR + row * 64 + seg * 16) = rl; }
                __syncthreads();
#pragma unroll 1
                for (int m = 0; m < 4; ++m) {
                    const bf16x8 A = *(LAS bf16x8*)(lds + SLR + (m * 16 + fr) * 64 + fq * 16);
                    f32x4 xx = (f32x4){0.f, 0.f, 0.f, 0.f};
                    xx = MFMA16(A, wB1, xx); xx = MFMA16(A, wB2, xx);
#pragma unroll
                    for (int jj = 0; jj < 4; ++jj) { const float x = xx[jj] + biasx; const float ls = fminf(x, 0.f) - __logf(1.f + __expf(-fabsf(x)));
                        *(LAS float*)(lds + SX + ((m * 16 + 4 * fq + jj) * 132 + wid * 16 + fr) * 4) = ls * 0.0625f; }
                }
                if (PASS2) {
#pragma unroll
                    for (int it = 0; it < 2; ++it) { const int pi = tid + 512 * it, row = pi >> 4, seg = pi & 15; *(LAS u32x4*)(lds + SQ + row * 272 + seg * 16) = rq[it]; } }
                __syncthreads();
                float c0[8], c1[8];
#pragma unroll
                for (int e = 0; e < 8; ++e) { const f32x2 t2 = *(LAS f32x2*)(lds + SX + ((wid * 8 + e) * 132 + dk0) * 4); c0[e] = t2.x; c1[e] = t2.y; }
                if (dir == 0) {
#pragma unroll
                    for (int e = 1; e < 8; ++e) { c0[e] += c0[e - 1]; c1[e] += c1[e - 1]; }
                } else {
#pragma unroll
                    for (int e = 6; e >= 0; --e) { c0[e] += c0[e + 1]; c1[e] += c1[e + 1]; }
                }
                { f32x2 t2; t2.x = dir == 0 ? c0[7] : c0[0]; t2.y = dir == 0 ? c1[7] : c1[0]; *(LAS f32x2*)(lds + SCOL + (wid * 128 + dk0) * 4) = t2; }
                __syncthreads();
                float tot0 = 0.f, tot1 = 0.f, offs0 = 0.f, offs1 = 0.f;
#pragma unroll
                for (int s = 0; s < 8; ++s) { const f32x2 t2 = *(LAS f32x2*)(lds + SCOL + (s * 128 + dk0) * 4); tot0 += t2.x; tot1 += t2.y;
                    const bool inc = dir == 0 ? (s < wid) : (s > wid); offs0 += inc ? t2.x : 0.f; offs1 += inc ? t2.y : 0.f; }
                const float etot0 = __expf(tot0), etot1 = __expf(tot1), eg0 = __expf(gtot0), eg1 = __expf(gtot1);
                unsigned kd0p[4], kd1p[4]; float kd0prev = 0.f, kd1prev = 0.f;
#pragma unroll
                for (int e = 0; e < 8; ++e) { const int i = wid * 8 + e;
                    const float ec0 = __expf(c0[e] + offs0), ec1 = __expf(c1[e] + offs1), inv0 = __builtin_amdgcn_rcpf(ec0), inv1 = __builtin_amdgcn_rcpf(ec1);
                    const unsigned kw = *(LAS unsigned*)(lds + SK + i * 272 + dk0 * 2);
                    const float k0 = bflo(kw), k1 = bfhi(kw);
                    const float kd0 = k0 * (etot0 * inv0), kd1 = k1 * (etot1 * inv1);
                    if (PASS2) { const unsigned qw = *(LAS unsigned*)(lds + SQ + i * 272 + dk0 * 2);
                        const float qe0 = bflo(qw) * 0.08838834764831845f * ec0, qe1 = bfhi(qw) * 0.08838834764831845f * ec1;
                        *(LAS unsigned*)(lds + SQ + i * 272 + dk0 * 2) = cvt_pk_bf16(qe0, qe1);
                        const unsigned qt = cvt_pk_bf16(qe0 * eg0, qe1 * eg1);
                        if (dir == 0) *(unsigned*)(QT + (size_t)(t0 + i) * 512 + h * 128 + dk0) = qt; else *(unsigned*)(P + (size_t)(t0 + i) * PW + h * 128 + dk0) = qt;
                        *(LAS unsigned*)(lds + SK + i * 272 + dk0 * 2) = cvt_pk_bf16(k0 * inv0, k1 * inv1); }
                    if (e & 1) { kd0p[e >> 1] = cvt_pk_bf16(kd0prev, kd0); kd1p[e >> 1] = cvt_pk_bf16(kd1prev, kd1); } else { kd0prev = kd0; kd1prev = kd1; } }
                *(LAS u32x4*)(lds + SKD + dk0 * 144 + wid * 16) = (u32x4){kd0p[0], kd0p[1], kd0p[2], kd0p[3]};
                *(LAS u32x4*)(lds + SKD + (dk0 + 1) * 144 + wid * 16) = (u32x4){kd1p[0], kd1p[1], kd1p[2], kd1p[3]};
                if (wid == 0) { f32x2 t2; t2.x = etot0; t2.y = etot1; *(LAS f32x2*)(lds + SDEC + dk0 * 4) = t2; }
                gtot0 += tot0; gtot1 += tot1;
#pragma unroll
                for (int it = 0; it < 4; ++it) { const int pi = tid + 512 * it, row = pi >> 5, seg = pi & 31;
                    *(LAS u32x4*)(lds + SV + row * 528 + seg * 16) = rv[it]; }
                __syncthreads();
                if (PASS2) {
                    f32x4 accP[2];
#pragma unroll
                    for (int s = 0; s < 2; ++s) { const int tt = wid * 2 + s, ib = tt >> 2, jb = tt & 3; f32x4 a = (f32x4){0.f, 0.f, 0.f, 0.f};
#pragma unroll
                        for (int kb = 0; kb < 4; ++kb) { const bf16x8 A = *(LAS bf16x8*)(lds + SK + (jb * 16 + fr) * 272 + (kb * 32 + fq * 8) * 2);
                            const bf16x8 B = *(LAS bf16x8*)(lds + SQ + (ib * 16 + fr) * 272 + (kb * 32 + fq * 8) * 2); a = MFMA16(A, B, a); }
                        accP[s] = a; }
                    __syncthreads();
#pragma unroll
                    for (int s = 0; s < 2; ++s) { const int tt = wid * 2 + s, ib = tt >> 2, jb = tt & 3; const int i = ib * 16 + fr, jbase = jb * 16 + 4 * fq; float v[4];
#pragma unroll
                        for (int jj = 0; jj < 4; ++jj) { const int j = jbase + jj; const bool keep = dir == 0 ? (j <= i) : (j > i); v[jj] = keep ? accP[s][jj] : 0.f; }
                        *(LAS u32x2*)(lds + SP + i * 144 + jbase * 2) = (u32x2){cvt_pk_bf16(v[0], v[1]), cvt_pk_bf16(v[2], v[3])}; }
#pragma unroll
                    for (int m8 = 0; m8 < 8; ++m8)
#pragma unroll
                        for (int n = 0; n < 2; ++n) { const f32x4 sv = accS[m8][n];
                            *(LAS u32x2*)(lds + SST + (wid * 32 + n * 16 + fr) * 272 + (m8 * 16 + 4 * fq) * 2) = (u32x2){cvt_pk_bf16(sv[0], sv[1]), cvt_pk_bf16(sv[2], sv[3])}; }
                    __syncthreads();
                }
                bf16x8 vf[2][2];
#pragma unroll
                for (int n = 0; n < 2; ++n)
#pragma unroll
                    for (int kb2 = 0; kb2 < 2; ++kb2) { unsigned w[4];
#pragma unroll
                        for (int jp = 0; jp < 4; ++jp) { const unsigned lo = *(LAS unsigned short*)(lds + SV + (kb2 * 32 + fq * 8 + 2 * jp) * 528 + (wid * 32 + n * 16 + fr) * 2);
                            const unsigned hi = *(LAS unsigned short*)(lds + SV + (kb2 * 32 + fq * 8 + 2 * jp + 1) * 528 + (wid * 32 + n * 16 + fr) * 2); w[jp] = lo | (hi << 16); }
                        vf[n][kb2] = __builtin_bit_cast(bf16x8, (u32x4){w[0], w[1], w[2], w[3]}); }
                if (PASS2) {
#pragma unroll
                    for (int n = 0; n < 2; ++n) {
                        f32x4 accO[4];
#pragma unroll
                        for (int m = 0; m < 4; ++m) accO[m] = (f32x4){0.f, 0.f, 0.f, 0.f};
#pragma unroll
                        for (int kb = 0; kb < 4; ++kb) { const bf16x8 A = *(LAS bf16x8*)(lds + SST + (wid * 32 + n * 16 + fr) * 272 + (kb * 32 + fq * 8) * 2);
#pragma unroll
                            for (int m = 0; m < 4; ++m) { const bf16x8 B = *(LAS bf16x8*)(lds + SQ + (m * 16 + fr) * 272 + (kb * 32 + fq * 8) * 2); accO[m] = MFMA16(A, B, accO[m]); } }
#pragma unroll
                        for (int kb2 = 0; kb2 < 2; ++kb2)
#pragma unroll
                            for (int m = 0; m < 4; ++m) { const bf16x8 B = *(LAS bf16x8*)(lds + SP + (m * 16 + fr) * 144 + (kb2 * 32 + fq * 8) * 2); accO[m] = MFMA16(vf[n][kb2], B, accO[m]); }
#pragma unroll
                        for (int m = 0; m < 4; ++m) { bf16_t* dst = O + (size_t)(t0 + m * 16 + fr) * 1024 + h * 256 + wid * 32 + n * 16 + 4 * fq; f32x4 v = accO[m];
                            if (dir) { const u32x2 old = *(const u32x2*)dst; v[0] += bflo(old.x); v[1] += bfhi(old.x); v[2] += bflo(old.y); v[3] += bfhi(old.y); }
                            *(u32x2*)dst = (u32x2){cvt_pk_bf16(v[0], v[1]), cvt_pk_bf16(v[2], v[3])}; }
                        asm volatile("" ::: "memory");
                    }
                }
                if (cc < 7) GLA_ISSUE(cc + 1);
#pragma unroll
                for (int m8 = 0; m8 < 8; ++m8) { const f32x4 d = *(LAS f32x4*)(lds + SDEC + (m8 * 16 + 4 * fq) * 4);
#pragma unroll
                    for (int n = 0; n < 2; ++n) accS[m8][n] = accS[m8][n] * d;
#pragma unroll
                    for (int kb2 = 0; kb2 < 2; ++kb2) { const bf16x8 A = *(LAS bf16x8*)(lds + SKD + (m8 * 16 + fr) * 144 + (kb2 * 32 + fq * 8) * 2);
#pragma unroll
                        for (int n = 0; n < 2; ++n) accS[m8][n] = MFMA16(A, vf[n][kb2], accS[m8][n]); } }
                __syncthreads();
            }
            {
                char* wsl = p.ws; asm volatile("" : "+s"(wsl));
                bf16_t* Eit = (bf16_t*)(wsl + OFF_E) + (size_t)(scan * 32 + grp) * 32768 + (size_t)(wid * 32 + fr) * 128 + 4 * fq;
                float* DL = (float*)(wsl + OFF_DLOG);
#pragma unroll
                for (int m8 = 0; m8 < 8; ++m8)
#pragma unroll
                    for (int n = 0; n < 2; ++n)
                        *(u32x2*)(Eit + n * 16 * 128 + m8 * 16) = (u32x2){cvt_pk_bf16(accS[m8][n][0], accS[m8][n][1]), cvt_pk_bf16(accS[m8][n][2], accS[m8][n][3])};
                if (wid == 0) { DL[(scan * 32 + grp) * 128 + dk0] = gtot0; DL[(scan * 32 + grp) * 128 + dk0 + 1] = gtot1; }
            }
        }
    }
}

#undef GLA_ISSUE
__device__ __forceinline__ void phase_combine(const Params& p) {
    bf16_t* E = (bf16_t*)(p.ws + OFF_E); const float* DL = (const float*)(p.ws + OFF_DLOG);
    int tid = threadIdx.x; asm volatile("" : "+v"(tid));
    for (int idx = bid_() * 512 + tid; idx < 16 * 4096; idx += nblk_() * 512) {
        const int scan = idx >> 12, e8 = idx & 4095, dk0 = (e8 & 15) * 8, dir = scan & 1;
        float R[8];
#pragma unroll
        for (int i = 0; i < 8; ++i) R[i] = 0.f;
#pragma unroll 1
        for (int q4 = 0; q4 < 4; ++q4) {
            u32x4 ev[8]; f32x4 d0[8], d1[8];
#pragma unroll
            for (int gg = 0; gg < 8; ++gg) { const int go = q4 * 8 + gg, g = dir ? 31 - go : go;
                ev[gg] = *(const u32x4*)(E + (size_t)(scan * 32 + g) * 32768 + e8 * 8);
                d0[gg] = *(const f32x4*)(DL + (scan * 32 + g) * 128 + dk0); d1[gg] = *(const f32x4*)(DL + (scan * 32 + g) * 128 + dk0 + 4); }
#pragma unroll
            for (int gg = 0; gg < 8; ++gg) { const int go = q4 * 8 + gg, g = dir ? 31 - go : go;
                *(u32x4*)(E + (size_t)(scan * 32 + g) * 32768 + e8 * 8) = (u32x4){cvt_pk_bf16(R[0], R[1]), cvt_pk_bf16(R[2], R[3]), cvt_pk_bf16(R[4], R[5]), cvt_pk_bf16(R[6], R[7])};
                const u32x4 w = ev[gg];
                R[0] = R[0] * __expf(d0[gg][0]) + bflo(w.x); R[1] = R[1] * __expf(d0[gg][1]) + bfhi(w.x); R[2] = R[2] * __expf(d0[gg][2]) + bflo(w.y); R[3] = R[3] * __expf(d0[gg][3]) + bfhi(w.y);
                R[4] = R[4] * __expf(d1[gg][0]) + bflo(w.z); R[5] = R[5] * __expf(d1[gg][1]) + bfhi(w.z); R[6] = R[6] * __expf(d1[gg][2]) + bflo(w.w); R[7] = R[7] * __expf(d1[gg][3]) + bfhi(w.w); }
        }
    }
}

__device__ __forceinline__ void gla_light(LAS unsigned char* lds, const Params& p, int layer) {
    constexpr int SSTF = 0, SSTB = 69632, SSS = 139264;
    int tid = threadIdx.x; asm volatile("" : "+v"(tid));
    const int wid = __builtin_amdgcn_readfirstlane(tid >> 6), lane = tid & 63, fr = lane & 15, fq = lane >> 4, mt = wid & 3, hv = wid >> 2;
    bf16_t* P = (bf16_t*)(p.ws + OFF_PROJ);
    const bf16_t* E = (const bf16_t*)(p.ws + OFF_E);
    const bf16_t* QT = (const bf16_t*)(p.ws + OFF_E + (size_t)32 * 1024 * 1024);
    const bf16_t* O = (const bf16_t*)(p.ws + OFF_O);
    for (int item = bid_(); item < 256; item += nblk_()) {
        const int b = item >> 7, h = (item >> 5) & 3, grp = item & 31;
        const int scanf = (b * 4 + h) * 2;
        __syncthreads();
#pragma unroll
        for (int it = 0; it < 8; ++it) { const int pi = tid + 512 * it, row = pi >> 4, seg = pi & 15;
            const u32x4 vf_ = *(const u32x4*)(E + (size_t)(scanf * 32 + grp) * 32768 + row * 128 + seg * 8);
            const u32x4 vb_ = *(const u32x4*)(E + (size_t)((scanf + 1) * 32 + grp) * 32768 + row * 128 + seg * 8);
            *(LAS u32x4*)(lds + SSTF + row * 272 + seg * 16) = vf_; *(LAS u32x4*)(lds + SSTB + row * 272 + seg * 16) = vb_; }
        __syncthreads();
        f32x4 gn[8];
#pragma unroll
        for (int n = 0; n < 8; ++n) gn[n] = *(const f32x4*)(p.gla_norm + layer * 1024 + h * 256 + hv * 128 + n * 16 + 4 * fq);
#pragma unroll 1
        for (int cc = 0; cc < 8; ++cc) {
            const size_t tok = (size_t)(b * SEQL + grp * 512 + cc * 64 + mt * 16 + fr);
            bf16x8 bq[2][4];
#pragma unroll
            for (int kb = 0; kb < 4; ++kb) { bq[0][kb] = *(const bf16x8*)(QT + tok * 512 + h * 128 + kb * 32 + fq * 8); bq[1][kb] = *(const bf16x8*)(P + tok * PW + h * 128 + kb * 32 + fq * 8); }
            u32x2 oo[8], rr[8];
#pragma unroll
            for (int n = 0; n < 8; ++n) { oo[n] = *(const u32x2*)(O + tok * 1024 + h * 256 + hv * 128 + n * 16 + 4 * fq);
                rr[n] = *(const u32x2*)(P + tok * PW + 2048 + h * 256 + hv * 128 + n * 16 + 4 * fq); }
            f32x4 accO[8];
#pragma unroll
            for (int n = 0; n < 8; ++n) accO[n] = (f32x4){0.f, 0.f, 0.f, 0.f};
#pragma unroll
            for (int dir = 0; dir < 2; ++dir)
#pragma unroll
                for (int kb = 0; kb < 4; ++kb)
#pragma unroll
                    for (int n = 0; n < 8; ++n) { const bf16x8 A = *(LAS bf16x8*)(lds + (dir ? SSTB : SSTF) + (hv * 128 + n * 16 + fr) * 272 + (kb * 32 + fq * 8) * 2);
                        accO[n] = MFMA16(A, bq[dir][kb], accO[n]); }
            float s = 0.f;
#pragma unroll
            for (int n = 0; n < 8; ++n) { f32x4 v = accO[n]; v[0] += bflo(oo[n].x); v[1] += bfhi(oo[n].x); v[2] += bflo(oo[n].y); v[3] += bfhi(oo[n].y); accO[n] = v;
                s += (v[0] * v[0] + v[1] * v[1]) + (v[2] * v[2] + v[3] * v[3]); }
            s += __shfl_xor(s, 16); s += __shfl_xor(s, 32);
            const int sb = SSS + (cc & 1) * 512;
            if (fq == 0) *(LAS float*)(lds + sb + (hv * 64 + mt * 16 + fr) * 4) = s;
            __syncthreads();
            const float tot = *(LAS float*)(lds + sb + (mt * 16 + fr) * 4) + *(LAS float*)(lds + sb + (64 + mt * 16 + fr) * 4);
            const float rn = rsqrtf(tot * (1.f / 256.f) + 1e-6f);
#pragma unroll
            for (int n = 0; n < 8; ++n) { const float r0 = bflo(rr[n].x), r1 = bfhi(rr[n].x), r2 = bflo(rr[n].y), r3 = bfhi(rr[n].y);
                const f32x4 v = accO[n] * rn * gn[n];
                *(u32x2*)(P + tok * PW + 2048 + h * 256 + hv * 128 + n * 16 + 4 * fq) =
                    (u32x2){cvt_pk_bf16(v[0] * (r0 * sigmoidf_(r0)), v[1] * (r1 * sigmoidf_(r1))), cvt_pk_bf16(v[2] * (r2 * sigmoidf_(r2)), v[3] * (r3 * sigmoidf_(r3)))}; }
        }
    }
}

__device__ __forceinline__ void phase_gating(const Params& p, int layer) {
    int tid = threadIdx.x; asm volatile("" : "+v"(tid));
    const int wid = tid >> 6, lane = tid & 63;
    bf16_t* P = (bf16_t*)(p.ws + OFF_PROJ); const bf16_t* O = (const bf16_t*)(p.ws + OFF_O);
    const float* gn = p.gla_norm + layer * 1024 + lane * 16;
    f32x4 g4[4];
#pragma unroll
    for (int i = 0; i < 4; ++i) g4[i] = *(const f32x4*)(gn + 4 * i);
    for (int t0 = bid_() * 8 + wid; t0 < T_TOK; t0 += nblk_() * 16) {
        u32x4 oo[2][2], rr[2][2]; bool ok[2];
#pragma unroll
        for (int u = 0; u < 2; ++u) { const int t = t0 + u * nblk_() * 8; ok[u] = t < T_TOK;
            if (ok[u]) { oo[u][0] = *(const u32x4*)(O + (size_t)t * 1024 + lane * 16); oo[u][1] = *(const u32x4*)(O + (size_t)t * 1024 + lane * 16 + 8);
                const bf16_t* rp = P + (size_t)t * PW + 2048 + lane * 16; rr[u][0] = *(const u32x4*)rp; rr[u][1] = *(const u32x4*)(rp + 8); } }
#pragma unroll
        for (int u = 0; u < 2; ++u) if (ok[u]) { const int t = t0 + u * nblk_() * 8;
            bf16_t* rp = P + (size_t)t * PW + 2048 + lane * 16;
            const u32x4 o0 = oo[u][0], o1 = oo[u][1], r0 = rr[u][0], r1 = rr[u][1];
            float ov[16], rv[16];
            ov[0] = bflo(o0.x); ov[1] = bfhi(o0.x); ov[2] = bflo(o0.y); ov[3] = bfhi(o0.y); ov[4] = bflo(o0.z); ov[5] = bfhi(o0.z); ov[6] = bflo(o0.w); ov[7] = bfhi(o0.w);
            ov[8] = bflo(o1.x); ov[9] = bfhi(o1.x); ov[10] = bflo(o1.y); ov[11] = bfhi(o1.y); ov[12] = bflo(o1.z); ov[13] = bfhi(o1.z); ov[14] = bflo(o1.w); ov[15] = bfhi(o1.w);
            rv[0] = bflo(r0.x); rv[1] = bfhi(r0.x); rv[2] = bflo(r0.y); rv[3] = bfhi(r0.y); rv[4] = bflo(r0.z); rv[5] = bfhi(r0.z); rv[6] = bflo(r0.w); rv[7] = bfhi(r0.w);
            rv[8] = bflo(r1.x); rv[9] = bfhi(r1.x); rv[10] = bflo(r1.y); rv[11] = bfhi(r1.y); rv[12] = bflo(r1.z); rv[13] = bfhi(r1.z); rv[14] = bflo(r1.w); rv[15] = bfhi(r1.w);
            float s = 0.f;
#pragma unroll
            for (int i = 0; i < 16; ++i) s += ov[i] * ov[i];
            s += __shfl_xor(s, 8); s += __shfl_xor(s, 4); s += __shfl_xor(s, 2); s += __shfl_xor(s, 1);
            const float rn = rsqrtf(s * (1.f / 256.f) + 1e-6f);
            float out[16];
#pragma unroll
            for (int i = 0; i < 16; ++i) { const float r = rv[i]; out[i] = ov[i] * rn * g4[i >> 2][i & 3] * (r * sigmoidf_(r)); }
            *(u32x4*)rp = (u32x4){cvt_pk_bf16(out[0], out[1]), cvt_pk_bf16(out[2], out[3]), cvt_pk_bf16(out[4], out[5]), cvt_pk_bf16(out[6], out[7])};
            *(u32x4*)(rp + 8) = (u32x4){cvt_pk_bf16(out[8], out[9]), cvt_pk_bf16(out[10], out[11]), cvt_pk_bf16(out[12], out[13]), cvt_pk_bf16(out[14], out[15])}; }
    }
}

template <int HW, int RL>
__device__ __forceinline__ void pool_run(const bf16_t* P, bf16_t* PO, int t0, int c8) {
    constexpr int NR = RL + 2 * HW - 1;
    const int pos0 = t0 & (SEQL - 1);
    const bf16_t* base = P + (size_t)t0 * PW + 3072 + c8 * 8;
    u32x4 v[NR];
#pragma unroll
    for (int k = 0; k < NR; ++k) { const int off = k - HW, tt = pos0 + off;
        v[k] = (tt >= 0 && tt < SEQL) ? *(const u32x4*)(base + (long)off * PW) : (u32x4){0u, 0u, 0u, 0u}; }
    float w[8];
#pragma unroll
    for (int i = 0; i < 8; ++i) w[i] = 0.f;
#pragma unroll
    for (int k = 0; k < 2 * HW; ++k) { w[0] += bflo(v[k].x); w[1] += bfhi(v[k].x); w[2] += bflo(v[k].y); w[3] += bfhi(v[k].y); w[4] += bflo(v[k].z); w[5] += bfhi(v[k].z); w[6] += bflo(v[k].w); w[7] += bfhi(v[k].w); }
#pragma unroll
    for (int i = 0; i < RL; ++i) {
        if (i > 0) { const u32x4 a = v[i + 2 * HW - 1], s = v[i - 1];
            w[0] += bflo(a.x) - bflo(s.x); w[1] += bfhi(a.x) - bfhi(s.x); w[2] += bflo(a.y) - bflo(s.y); w[3] += bfhi(a.y) - bfhi(s.y);
            w[4] += bflo(a.z) - bflo(s.z); w[5] += bfhi(a.z) - bfhi(s.z); w[6] += bflo(a.w) - bflo(s.w); w[7] += bfhi(a.w) - bfhi(s.w); }
        const int pos = pos0 + i, lo = pos - HW < 0 ? 0 : pos - HW, hi = pos + HW > SEQL ? SEQL : pos + HW;
        const float ic = 1.f / (float)(hi - lo);
        const u32x4 c = v[HW + i];
        *(u32x4*)(PO + (size_t)(t0 + i) * 512 + c8 * 8) = (u32x4){cvt_pk_bf16(w[0] * ic - bflo(c.x), w[1] * ic - bfhi(c.x)), cvt_pk_bf16(w[2] * ic - bflo(c.y), w[3] * ic - bfhi(c.y)),
                                                                 cvt_pk_bf16(w[4] * ic - bflo(c.z), w[5] * ic - bfhi(c.z)), cvt_pk_bf16(w[6] * ic - bflo(c.w), w[7] * ic - bfhi(c.w))};
    }
}
__device__ __forceinline__ void phase_pool(const Params& p) {
    const bf16_t* P = (const bf16_t*)(p.ws + OFF_PROJ); bf16_t* PO = (bf16_t*)(p.ws + OFF_E);
    int tid = threadIdx.x; asm volatile("" : "+v"(tid));
    const int wid = __builtin_amdgcn_readfirstlane(tid >> 6), lane = tid & 63;
    for (int wi = blockIdx.x * 8 + wid; wi < T_TOK / 16; wi += gridDim.x * 8) {
        const int grp = wi & 3, t0 = (wi >> 2) * 64 + (lane >> 4) * 16, c8 = grp * 16 + (lane & 15);
        if (grp == 0) pool_run<1, 16>(P, PO, t0, c8); else if (grp == 1) pool_run<2, 16>(P, PO, t0, c8); else if (grp == 2) pool_run<4, 16>(P, PO, t0, c8); else { pool_run<8, 8>(P, PO, t0, c8); pool_run<8, 8>(P, PO, t0 + 8, c8); }
    }
}

__device__ __forceinline__ void phase_final(const Params& p) {
    int tid = threadIdx.x; asm volatile("" : "+v"(tid));
    const int wid = tid >> 6, lane = tid & 63;
    const float* ssq = (const float*)(p.ws + OFF_SSQ); const bf16_t* xb = (const bf16_t*)(p.ws + OFF_XB);
    f32x4 g4[4];
#pragma unroll
    for (int i = 0; i < 4; ++i) g4[i] = *(const f32x4*)(p.norm_final + lane * 16 + 4 * i);
    for (int row0 = bid_() * 8 + wid; row0 < T_TOK; row0 += nblk_() * 32) {
        u32x4 v[4][2]; float rs[4]; bool ok[4];
#pragma unroll
        for (int u = 0; u < 4; ++u) { const int row = row0 + u * nblk_() * 8; ok[u] = row < T_TOK;
            if (ok[u]) { rs[u] = rowscale(ssq, row); const bf16_t* xp = xb + (size_t)row * 1024 + lane * 16; v[u][0] = *(const u32x4*)xp; v[u][1] = *(const u32x4*)(xp + 8); } }
#pragma unroll
        for (int u = 0; u < 4; ++u) if (ok[u]) { const int row = row0 + u * nblk_() * 8; float* op = p.xf + (size_t)row * 1024 + lane * 16; const float r = rs[u];
            *(f32x4*)(op) = (f32x4){bflo(v[u][0].x), bfhi(v[u][0].x), bflo(v[u][0].y), bfhi(v[u][0].y)} * r * g4[0];
            *(f32x4*)(op + 4) = (f32x4){bflo(v[u][0].z), bfhi(v[u][0].z), bflo(v[u][0].w), bfhi(v[u][0].w)} * r * g4[1];
            *(f32x4*)(op + 8) = (f32x4){bflo(v[u][1].x), bfhi(v[u][1].x), bflo(v[u][1].y), bfhi(v[u][1].y)} * r * g4[2];
            *(f32x4*)(op + 12) = (f32x4){bflo(v[u][1].z), bfhi(v[u][1].z), bflo(v[u][1].w), bfhi(v[u][1].w)} * r * g4[3]; }
    }
}

__device__ __forceinline__ void phase_rs(const Params& p) {
    int tid = threadIdx.x; asm volatile("" : "+v"(tid));
    const float* ssq = (const float*)(p.ws + OFF_SSQ); float* rs = (float*)(p.ws + OFF_RS);
    for (int row = bid_() * 512 + tid; row < T_TOK; row += nblk_() * 512) rs[row] = rowscale(ssq, row);
}
__device__ __forceinline__ void grid_barrier(unsigned* bar, unsigned k) {
    asm volatile("s_waitcnt vmcnt(0)" ::: "memory");
    __syncthreads();
    if (threadIdx.x == 0) {
        const unsigned nb = nblk_(), g = bid_() >> 4, ng = (nb + 15u) >> 4, gsz = (nb - 16u * g) < 16u ? (nb - 16u * g) : 16u;
        __builtin_amdgcn_fence(__ATOMIC_RELEASE, "agent");
        asm volatile("s_waitcnt vmcnt(0)" ::: "memory");
        const unsigned old = __hip_atomic_fetch_add(bar + 64 * g, 1u, __ATOMIC_RELAXED, __HIP_MEMORY_SCOPE_AGENT);
        if (old == k * gsz - 1u) {
            const unsigned old2 = __hip_atomic_fetch_add(bar + 64 * 32, 1u, __ATOMIC_RELAXED, __HIP_MEMORY_SCOPE_AGENT);
            if (old2 == k * ng - 1u) for (unsigned j = 0; j < ng; ++j) __hip_atomic_store(bar + 64 * (64 + j), k, __ATOMIC_RELAXED, __HIP_MEMORY_SCOPE_AGENT);
        }
        while (__hip_atomic_load(bar + 64 * (64 + g), __ATOMIC_RELAXED, __HIP_MEMORY_SCOPE_AGENT) < k) __builtin_amdgcn_s_sleep(2);
        __builtin_amdgcn_fence(__ATOMIC_ACQUIRE, "agent");
        asm volatile("s_waitcnt vmcnt(0)" ::: "memory");
    }
    __syncthreads();
}
__global__ void __launch_bounds__(512, 2) mega(const Params p_arg) {
    extern __shared__ __attribute__((aligned(16))) unsigned char shm[];
    LAS unsigned char* lds = (LAS unsigned char*)shm;
    typedef const Params __attribute__((address_space(4))) * KArgPtr;
    const int phase_lo = p_arg.phase_lo, phase_hi = p_arg.phase_hi;
    pg8::StaticOrder S;
    unsigned bar_k = 0;
    for (int ph = phase_lo; ph < phase_hi; ++ph) {
        KArgPtr kp = (KArgPtr)__builtin_amdgcn_kernarg_segment_ptr(); asm volatile("" : "+s"(kp));
        const Params& p = *(const Params*)kp;
        bf16_t* xb = (bf16_t*)(p.ws + OFF_XB); bf16_t* proj = (bf16_t*)(p.ws + OFF_PROJ); float* ssq = (float*)(p.ws + OFF_SSQ);
        if (ph > phase_lo) {
            if (phase_hi > 1000) cg::this_grid().sync();
            grid_barrier((unsigned*)(p.ws + OFF_BAR), ++bar_k);
        }
        if (ph == 0) { phase_prep(lds, p); continue; }
        if (ph == 19) { phase_final(p); continue; }
        const int layer = (ph - 1) / 9, sub = (ph - 1) % 9;
        const char* W = p.ws + OFF_W + (size_t)layer * SZ_WLAYER;
        switch (sub) {
        case 0: { if (layer > 0) { phase_rs(p); grid_barrier((unsigned*)(p.ws + OFF_BAR), ++bar_k); }
                  pg8::Gemm g{xb, (const bf16_t*)(W + WO_A), T_TOK, NA, 1024, 1024}; S.init(g.M, g.N, nblk_(), bid_());
                  EpiA e{(const float*)(p.ws + OFF_RS), proj, (bf16_t*)(p.ws + OFF_LR), ssq}; pg8::gemm_phase(lds, g, S, e); } break;
        case 1: gla_pass<true>(lds, p, layer); break;
        case 2: phase_combine(p); break;
        case 3: gla_light(lds, p, layer); break;
        case 4: { pg8::Gemm g{xb, (const bf16_t*)(W + WO_B), T_TOK, NB, 1024, 1024}; S.init(g.M, g.N, nblk_(), bid_());
                  EpiGate e{(const float*)(p.ws + OFF_RS), proj, ssq}; pg8::gemm_phase(lds, g, S, e);
                  phase_pool(p); } break;
        case 5: { { pg8::Gemm g{(const bf16_t*)(p.ws + OFF_E), (const bf16_t*)(W + WO_POOL), T_TOK, 1024, 128, 512}; S.init(g.M, g.N, nblk_(), bid_());
                    EpiPool e{proj, p.pool_scale + layer * 1024}; pg8::gemm_phase<EpiPool, 256>(lds, g, S, e); }
                  { pg8::Gemm g{proj + 2048, (const bf16_t*)(W + WO_GA), T_TOK, 1024, 1024, PW}; S.init(g.M, g.N, nblk_(), bid_());
                    EpiMerge e{proj}; pg8::gemm_phase(lds, g, S, e); } } break;
        case 6: { pg8::Gemm g{proj, (const bf16_t*)(W + WO_OUT), T_TOK, 1024, 1024, PW}; S.init(g.M, g.N, nblk_(), bid_());
                  EpiRes e{xb, ssq}; pg8::gemm_phase(lds, g, S, e); } break;
        case 7: { phase_rs(p); grid_barrier((unsigned*)(p.ws + OFF_BAR), ++bar_k);
                  pg8::Gemm g{xb, (const bf16_t*)(W + WO_F1), T_TOK, 2 * DFF, 1024, 1024}; S.init(g.M, g.N, nblk_(), bid_());
                  EpiFfn1 e{(const float*)(p.ws + OFF_RS), proj, ssq}; pg8::gemm_phase(lds, g, S, e); } break;
        case 8: { pg8::Gemm g{proj, (const bf16_t*)(W + WO_F2), T_TOK, 1024, DFF, DFF}; S.init(g.M, g.N, nblk_(), bid_());
                  if (layer == 1) { EpiResFinal e{p.ws, lds + pg8::STAGE_BYTES + 2048}; pg8::gemm_phase(lds, g, S, e); }
                  else { EpiRes e{xb, ssq}; pg8::gemm_phase(lds, g, S, e); } } break;
        }
    }
}

extern "C" void kernel_launch(void* const* d_in, const int* in_sizes, int n_in, void* d_out, int out_size, void* d_ws, size_t ws_size, hipStream_t stream) {
    (void)in_sizes; (void)n_in; (void)out_size;
    if (ws_size < WS_NEEDED) return;
    Params p{};
    p.x_in = (const float*)d_in[0]; p.norm_mix = (const float*)d_in[1]; p.w_in = (const float*)d_in[2]; p.wdu_f = (const float*)d_in[3]; p.bd_f = (const float*)d_in[4];
    p.wdu_b = (const float*)d_in[5]; p.bd_b = (const float*)d_in[6]; p.gla_norm = (const float*)d_in[7]; p.w_ga = (const float*)d_in[8]; p.w_pool = (const float*)d_in[9];
    p.pool_scale = (const float*)d_in[10]; p.w_out = (const float*)d_in[11]; p.norm_ffn = (const float*)d_in[12]; p.w_f1 = (const float*)d_in[13]; p.w_f2 = (const float*)d_in[14];
    p.norm_final = (const float*)d_in[15];
    p.xf = (float*)d_out; p.ws = (char*)d_ws;
    hipFuncSetAttribute((const void*)mega, hipFuncAttributeMaxDynamicSharedMemorySize, LDS_BYTES);
    int dev = 0, cus = 0, per = 0;
    hipGetDevice(&dev); hipDeviceGetAttribute(&cus, hipDeviceAttributeMultiprocessorCount, dev);
    hipOccupancyMaxActiveBlocksPerMultiprocessor(&per, mega, 512, LDS_BYTES);
    int grid = cus * (per > 0 ? per : 1); if (grid > 256) grid = 256; if (grid < 1) grid = 1;
#if MK_SINGLE_LAUNCH
    p.phase_lo = 0; p.phase_hi = 19;
    hipMemsetAsync((char*)d_ws + OFF_BAR, 0, 128 * 256, stream);
    void* args[] = {(void*)&p};
    hipLaunchCooperativeKernel((const void*)mega, dim3(grid), dim3(512), args, LDS_BYTES, stream);
#else
    for (int ph = 0; ph < 20; ++ph) { p.phase_lo = ph; p.phase_hi = ph + 1; hipLaunchKernelGGL(mega, dim3(grid), dim3(512), LDS_BYTES, stream, p); }
#endif
}
```

```cpp
#include <hip/hip_runtime.h>
#include <hip/hip_cooperative_groups.h>
namespace cg = cooperative_groups;

#ifndef MK_SINGLE_LAUNCH
#define MK_SINGLE_LAUNCH 1
#endif

#define LAS __attribute__((address_space(3)))
typedef unsigned short bf16_t;
typedef short bf16x8 __attribute__((ext_vector_type(8)));
typedef short s16x4 __attribute__((ext_vector_type(4)));
typedef float f32x4 __attribute__((ext_vector_type(4)));
typedef unsigned u32x4 __attribute__((ext_vector_type(4)));
typedef unsigned u32x2 __attribute__((ext_vector_type(2)));

constexpr int T_TOK = 32768, SEQL = 16384, DM = 1024, PW = 3584, NA = 3840, NB = 2048, DFF = 2816, INW = 5664;
constexpr int LDS_BYTES = 155136;

constexpr size_t SZ_WA = (size_t)NA * 1024 * 2, SZ_WB = (size_t)NB * 1024 * 2, SZ_WGA = (size_t)1024 * 1024 * 2, SZ_WPOOL = (size_t)1024 * 512 * 2,
                 SZ_WOUT = (size_t)1024 * 1024 * 2, SZ_WF1 = (size_t)2 * DFF * 1024 * 2, SZ_WF2 = (size_t)1024 * DFF * 2;
constexpr size_t WO_A = 0, WO_B = WO_A + SZ_WA, WO_GA = WO_B + SZ_WB, WO_POOL = WO_GA + SZ_WGA, WO_OUT = WO_POOL + SZ_WPOOL, WO_F1 = WO_OUT + SZ_WOUT,
                 WO_F2 = WO_F1 + SZ_WF1, SZ_WLAYER = WO_F2 + SZ_WF2;
constexpr size_t OFF_W = 0;
constexpr size_t OFF_XB = OFF_W + 2 * SZ_WLAYER;
constexpr size_t OFF_PROJ = OFF_XB + (size_t)T_TOK * 1024 * 2;
constexpr size_t OFF_LR = OFF_PROJ + (size_t)T_TOK * PW * 2;
constexpr size_t OFF_E = OFF_LR + (size_t)T_TOK * 32 * 4;
constexpr size_t OFF_DLOG = OFF_E + (size_t)16 * 32 * 32768 * 4;
constexpr size_t OFF_O = OFF_DLOG + (size_t)16 * 32 * 128 * 4;
constexpr size_t OFF_SSQ = OFF_O + (size_t)T_TOK * 1024 * 2;
constexpr size_t OFF_BAR = OFF_SSQ + (size_t)T_TOK * 16 * 4;
constexpr size_t OFF_RS = OFF_BAR + 128 * 256;
constexpr size_t OFF_XCH = OFF_RS + (size_t)T_TOK * 4;
constexpr size_t WS_NEEDED = OFF_XCH + (size_t)128 * 4 * 256 * 4;

struct Params {
    const float* x_in; const float* norm_mix; const float* w_in; const float* wdu_f; const float* bd_f; const float* wdu_b; const float* bd_b;
    const float* gla_norm; const float* w_ga; const float* w_pool; const float* pool_scale; const float* w_out; const float* norm_ffn;
    const float* w_f1; const float* w_f2; const float* norm_final;
    float* xf; char* ws;
    int phase_lo, phase_hi;
};

typedef float f32x2 __attribute__((ext_vector_type(2)));
typedef __bf16 bf16x2_t __attribute__((ext_vector_type(2)));
__device__ __forceinline__ int bid_() { int v = __builtin_amdgcn_readfirstlane((int)blockIdx.x); asm volatile("" : "+s"(v)); return v; }
__device__ __forceinline__ int nblk_() { int v = __builtin_amdgcn_readfirstlane((int)gridDim.x); asm volatile("" : "+s"(v)); return v; }
__device__ __forceinline__ unsigned cvt_pk_bf16(float lo, float hi) { const f32x2 v = {lo, hi}; const bf16x2_t b = __builtin_convertvector(v, bf16x2_t); return __builtin_bit_cast(unsigned, b); }
__device__ __forceinline__ float bf2f(unsigned short b) { return __uint_as_float(((unsigned)b) << 16); }
__device__ __forceinline__ float bflo(unsigned w) { return __uint_as_float(w << 16); }
__device__ __forceinline__ float bfhi(unsigned w) { return __uint_as_float(w & 0xffff0000u); }
__device__ __forceinline__ unsigned short f2bf(float f) { return (unsigned short)(cvt_pk_bf16(f, 0.f) & 0xffffu); }
__device__ __forceinline__ float sigmoidf_(float x) { return __builtin_amdgcn_rcpf(1.f + __expf(-x)); }

namespace pg8 {
constexpr int BM = 256, BK = 64, HALF = 128, HTB = HALF * BK * 2, STAGE_BYTES = 8 * HTB, NXCD = 8, WGM = 8;
__device__ __forceinline__ int lds_byte(int r, int c) { const int st = (r >> 4) * 2 + (c >> 5), rr = r & 15, cc = c & 31, ob = rr * 64 + cc * 2; return st * 1024 + (ob ^ (((ob >> 9) & 1) << 5)); }
__device__ __forceinline__ void stage_rc(int b, int& R, int& C) { const int st = b / 1024, sb = b % 1024, swz = sb ^ (((sb >> 9) & 1) << 5); R = (st >> 1) * 16 + swz / 64; C = (st & 1) * 32 + (swz % 64) / 2; }
__device__ __forceinline__ int perm32(int rho) { const int n = rho >> 4, i = rho & 15; return 8 * (i >> 2) + 4 * n + (i & 3); }
struct Unit { int pm, pn; };
struct Gemm { const bf16_t* A; const bf16_t* Bt; int M, N, K, lda; };
struct StaticOrder {
    int nM, nN, nwg, G, c;
    __device__ void init(int M, int N, int G_, int c_) { nM = M / BM; nN = N / BM; nwg = nM * nN; G = G_; c = c_; }
    __device__ bool next(int i, Unit& u) const {
        const long L = (long)i * G + c; if (L >= nwg) return false;
        int wgid = (int)L; { const int q = nwg / NXCD, r = nwg % NXCD, xcd = wgid % NXCD, off = wgid / NXCD; wgid = (xcd < r ? xcd * (q + 1) : r * (q + 1) + (xcd - r) * q) + off; }
        const int nig = WGM * nN, gid = wgid / nig, fm = gid * WGM, gsz = (nM - fm) < WGM ? (nM - fm) : WGM;
        u.pm = fm + ((wgid % nig) % gsz); u.pn = (wgid % nig) / gsz; return true;
    }
};

template <class Epi, int APN = 0, bool ALIGN_EPI = true, bool SP2 = true>
__device__ __forceinline__ void gemm_phase(LAS unsigned char* lds, const Gemm g, const StaticOrder& S, const Epi& E) {
    int tid = threadIdx.x; asm volatile("" : "+v"(tid));
    const int wid = __builtin_amdgcn_readfirstlane(tid >> 6), lane = tid & 63, wr = wid >> 2, wc = wid & 3, fr = lane & 15, fq = lane >> 4;
    int K = g.K; asm volatile("" : "+s"(K));
    const int nt = K / BK;
    unsigned voffA[2], voffB[2];
#pragma unroll
    for (int i = 0; i < 2; ++i) { int R, C; stage_rc(tid * 16 + i * 8192, R, C); const int Rb = Epi::PERM ? ((R & ~31) + perm32(R & 31)) : R;
        voffA[i] = (unsigned)(R * g.lda + C) * 2u; voffB[i] = (unsigned)(Rb * K + C) * 2u; }
    const size_t kstep = (size_t)(BK * 2);
    const size_t hstepA = (size_t)HALF * g.lda * 2, hstepB = (size_t)HALF * K * 2;
    const size_t tstepA = 2 * hstepA, tstepB = 2 * hstepB;
    const unsigned ldsw = (unsigned)wid * 1024u;
    const int aoff = lds_byte(wr * 64 + fr, fq * 8), boff = lds_byte(wc * 32 + fr, fq * 8);
#define PG8_SA(b, h) (((b) * 2 + (h)) * HTB)
#define PG8_SB(b, h) ((4 + (b) * 2 + (h)) * HTB)
#define PG8_STAGE(bufoff, gbase, voff) do { _Pragma("unroll") for (int _i = 0; _i < 2; ++_i) \
        __builtin_amdgcn_global_load_lds((const unsigned*)((const char*)(gbase) + (voff)[_i]), (LAS unsigned*)(lds + (bufoff) + ldsw + _i * 8192), 16, 0, 0); } while (0)
#define PG8_LDA(dst, b, h) do { _Pragma("unroll") for (int m = 0; m < 4; ++m) _Pragma("unroll") for (int k = 0; k < 2; ++k) dst[m][k] = *(const LAS bf16x8*)(lds + PG8_SA(b, h) + aoff + m * 2048 + k * 1024); } while (0)
#define PG8_LDB(dst, b, h) do { _Pragma("unroll") for (int n = 0; n < 2; ++n) _Pragma("unroll") for (int k = 0; k < 2; ++k) dst[n][k] = *(const LAS bf16x8*)(lds + PG8_SB(b, h) + boff + n * 2048 + k * 1024); } while (0)
#define PG8_MMA(ai, bj, At, Bt) do { __builtin_amdgcn_s_setprio(1); _Pragma("unroll") for (int m = 0; m < 4; ++m) _Pragma("unroll") for (int n = 0; n < 2; ++n) _Pragma("unroll") for (int k = 0; k < 2; ++k) \
        acc[ai][bj][m][n] = __builtin_amdgcn_mfma_f32_16x16x32_bf16(Bt[n][k], At[m][k], acc[ai][bj][m][n], 0, 0, 0); __builtin_amdgcn_s_setprio(0); } while (0)
#define PG8_WAIT_V(n) asm volatile("s_waitcnt vmcnt(" #n ")" ::: "memory")
#define PG8_WAIT_L(n) asm volatile("s_waitcnt lgkmcnt(" #n ")" ::: "memory")
#define PG8_BAR __builtin_amdgcn_s_barrier()
#define PG8_SCHED __builtin_amdgcn_sched_barrier(0)
    Unit cur, nxt; int ui = 0;
    if (!S.next(0, cur)) return;
    f32x4 acc[2][2][4][2];
#pragma unroll
    for (int a = 0; a < 2; ++a)
#pragma unroll
        for (int b = 0; b < 2; ++b)
#pragma unroll
            for (int m = 0; m < 4; ++m)
#pragma unroll
                for (int n = 0; n < 2; ++n) acc[a][b][m][n] = (f32x4){0.f, 0.f, 0.f, 0.f};
    bf16x8 At[4][2], B0[2][2], B1[2][2];
    const char* cA = (const char*)g.A + (size_t)cur.pm * tstepA + (size_t)cur.pn * APN; const char* cB = (const char*)g.Bt + (size_t)cur.pn * tstepB;
    if constexpr (SP2) {
        PG8_STAGE(PG8_SB(0, 0), cB, voffB); PG8_STAGE(PG8_SB(0, 1), cB + hstepB, voffB); PG8_STAGE(PG8_SA(0, 0), cA, voffA); PG8_STAGE(PG8_SA(0, 1), cA + hstepA, voffA);
        if (wr == 1) PG8_BAR;
        PG8_WAIT_V(2); PG8_BAR;
        PG8_STAGE(PG8_SB(1, 0), cB + kstep, voffB); PG8_STAGE(PG8_SA(1, 0), cA + kstep, voffA); PG8_STAGE(PG8_SB(1, 1), cB + hstepB + kstep, voffB);
        PG8_WAIT_V(6); PG8_BAR;
    } else {
        PG8_STAGE(PG8_SB(0, 0), cB, voffB); PG8_STAGE(PG8_SA(0, 0), cA, voffA); PG8_STAGE(PG8_SB(0, 1), cB + hstepB, voffB); PG8_STAGE(PG8_SA(0, 1), cA + hstepA, voffA);
        if (wr == 1) PG8_BAR;
        PG8_WAIT_V(4); PG8_BAR;
        PG8_STAGE(PG8_SB(1, 0), cB + kstep, voffB); PG8_STAGE(PG8_SA(1, 0), cA + kstep, voffA); PG8_STAGE(PG8_SB(1, 1), cB + hstepB + kstep, voffB);
        PG8_WAIT_V(6); PG8_BAR;
    }
    for (;;) {
        const bool has_next = S.next(ui + 1, nxt);
        const unsigned rsoff = (unsigned)STAGE_BYTES + (unsigned)(ui & 1) * 1024u;
        if constexpr (Epi::NEEDS_RS) { if (wid < 4) __builtin_amdgcn_global_load_lds((const unsigned*)(E.rsv + cur.pm * 256 + wid * 64 + lane), (LAS unsigned*)(lds + rsoff + wid * 256), 4, 0, 0); }
        const char* nA = has_next ? (const char*)g.A + (size_t)nxt.pm * tstepA + (size_t)nxt.pn * APN : cA; const char* nB = has_next ? (const char*)g.Bt + (size_t)nxt.pn * tstepB : cB;
        for (int t = 0; t < nt; t += 2) {
            const bool last = (t == nt - 2);
            const char* a1 = cA + (size_t)(t + 1) * kstep;
            const char* a2 = last ? nA : cA + (size_t)(t + 2) * kstep; const char* b2 = last ? nB : cB + (size_t)(t + 2) * kstep;
            const char* a3 = a2 + kstep; const char* b3 = b2 + kstep;
            if constexpr (SP2) {
            PG8_LDB(B0, 0, 0); PG8_LDB(B1, 0, 1); PG8_SCHED; PG8_LDA(At, 0, 0); PG8_STAGE(PG8_SA(1, 1), a1 + hstepA, voffA);
            PG8_WAIT_V(8); PG8_WAIT_L(0); PG8_BAR; PG8_MMA(0, 0, At, B0); PG8_MMA(0, 1, At, B1); PG8_BAR; PG8_SCHED;
            PG8_LDA(At, 0, 1); PG8_STAGE(PG8_SB(0, 0), b2, voffB); PG8_STAGE(PG8_SB(0, 1), b2 + hstepB, voffB); PG8_STAGE(PG8_SA(0, 0), a2, voffA);
            PG8_WAIT_V(8); PG8_WAIT_L(0); PG8_BAR; PG8_MMA(1, 0, At, B0); PG8_MMA(1, 1, At, B1); PG8_BAR; PG8_SCHED;
            PG8_LDB(B0, 1, 0); PG8_LDB(B1, 1, 1); PG8_SCHED; PG8_LDA(At, 1, 0); PG8_STAGE(PG8_SA(0, 1), a2 + hstepA, voffA);
            PG8_WAIT_V(8); PG8_WAIT_L(0); PG8_BAR; PG8_MMA(0, 0, At, B0); PG8_MMA(0, 1, At, B1); PG8_BAR; PG8_SCHED;
            PG8_LDA(At, 1, 1); PG8_STAGE(PG8_SB(1, 0), b3, voffB); PG8_STAGE(PG8_SB(1, 1), b3 + hstepB, voffB); PG8_STAGE(PG8_SA(1, 0), a3, voffA);
            PG8_WAIT_V(8); PG8_WAIT_L(0); PG8_BAR; PG8_MMA(1, 0, At, B0); PG8_MMA(1, 1, At, B1); PG8_BAR; PG8_SCHED;
            } else {
            PG8_LDB(B0, 0, 0); PG8_SCHED; PG8_LDA(At, 0, 0); PG8_STAGE(PG8_SA(1, 1), a1 + hstepA, voffA);
            PG8_WAIT_L(8); PG8_BAR; PG8_WAIT_L(0); PG8_MMA(0, 0, At, B0); PG8_BAR; PG8_SCHED;
            PG8_LDB(B1, 0, 1); PG8_STAGE(PG8_SB(0, 0), b2, voffB);
            PG8_BAR; PG8_WAIT_L(0); PG8_MMA(0, 1, At, B1); PG8_BAR;
            PG8_LDA(At, 0, 1); PG8_STAGE(PG8_SA(0, 0), a2, voffA);
            PG8_BAR; PG8_WAIT_L(0); PG8_MMA(1, 0, At, B0); PG8_BAR; PG8_SCHED;
            PG8_STAGE(PG8_SB(0, 1), b2 + hstepB, voffB);
            PG8_WAIT_V(6); PG8_BAR; PG8_MMA(1, 1, At, B1); PG8_BAR;
            PG8_LDB(B0, 1, 0); PG8_SCHED; PG8_LDA(At, 1, 0); PG8_STAGE(PG8_SA(0, 1), a2 + hstepA, voffA);
            PG8_WAIT_L(8); PG8_BAR; PG8_WAIT_L(0); PG8_MMA(0, 0, At, B0); PG8_BAR; PG8_SCHED;
            PG8_LDB(B1, 1, 1); PG8_STAGE(PG8_SB(1, 0), b3, voffB);
            PG8_BAR; PG8_WAIT_L(0); PG8_MMA(0, 1, At, B1); PG8_BAR;
            PG8_LDA(At, 1, 1); PG8_STAGE(PG8_SA(1, 0), a3, voffA);
            PG8_BAR; PG8_WAIT_L(0); PG8_MMA(1, 0, At, B0); PG8_BAR; PG8_SCHED;
            PG8_STAGE(PG8_SB(1, 1), b3 + hstepB, voffB);
            PG8_WAIT_V(6); PG8_BAR; PG8_MMA(1, 1, At, B1); PG8_BAR;
            }
        }
        if constexpr (ALIGN_EPI) { if (wr == 0) PG8_BAR; }
        E(acc, cur, wr, wc, fr, fq, (const LAS float*)(lds + rsoff));
        if (!has_next) break;
#pragma unroll
        for (int a = 0; a < 2; ++a)
#pragma unroll
            for (int b = 0; b < 2; ++b)
#pragma unroll
                for (int m = 0; m < 4; ++m)
#pragma unroll
                    for (int n = 0; n < 2; ++n) acc[a][b][m][n] = (f32x4){0.f, 0.f, 0.f, 0.f};
        cur = nxt; cA = nA; cB = nB; ++ui;
        if constexpr (ALIGN_EPI) { if (wr == 1) PG8_BAR; }
    }
    PG8_WAIT_V(0);
    if constexpr (!ALIGN_EPI) { if (wr == 0) PG8_BAR; }
    PG8_BAR;
#undef PG8_SA
#undef PG8_SB
#undef PG8_STAGE
#undef PG8_LDA
#undef PG8_LDB
#undef PG8_MMA
#undef PG8_WAIT_V
#undef PG8_WAIT_L
#undef PG8_BAR
#undef PG8_SCHED
}
}
using pg8::Unit;

__device__ __forceinline__ float rowscale(const float* ssq, int row) {
    const f32x4* s = (const f32x4*)(ssq + (size_t)row * 16);
    const f32x4 a = s[0], b = s[1], c = s[2], d = s[3];
    const float t = ((a[0] + a[1]) + (a[2] + a[3])) + ((b[0] + b[1]) + (b[2] + b[3])) + ((c[0] + c[1]) + (c[2] + c[3])) + ((d[0] + d[1]) + (d[2] + d[3]));
    return rsqrtf(t * (1.f / 1024.f) + 1e-6f);
}
__device__ __forceinline__ u32x4 pack8(const f32x4 v0, const f32x4 v1) {
    u32x4 w; w.x = cvt_pk_bf16(v0[0], v0[1]); w.y = cvt_pk_bf16(v0[2], v0[3]); w.z = cvt_pk_bf16(v1[0], v1[1]); w.w = cvt_pk_bf16(v1[2], v1[3]); return w;
}

struct EpiA {
    static constexpr bool PERM = true;
    static constexpr bool NEEDS_RS = true; const float* rsv;
    bf16_t* P; bf16_t* lr; const float* ssq;
    __device__ __forceinline__ void operator()(const f32x4 (&acc)[2][2][4][2], const Unit& u, int wr, int wc, int fr, int fq, const LAS float* rsl) const {
        const int row0 = u.pm * 256 + wr * 64 + fr;
#pragma unroll
        for (int ai = 0; ai < 2; ++ai)
#pragma unroll
            for (int m = 0; m < 4; ++m) {
                const int row = row0 + ai * 128 + m * 16; const float rs = rsl[ai * 128 + wr * 64 + m * 16 + fr];
                if (u.pn < 14) {
#pragma unroll
                    for (int bj = 0; bj < 2; ++bj) {
                        const f32x4 v0 = acc[ai][bj][m][0] * rs, v1 = acc[ai][bj][m][1] * rs;
                        *(u32x4*)(P + (size_t)row * PW + u.pn * 256 + bj * 128 + wc * 32 + 8 * fq) = pack8(v0, v1);
                    }
                } else if (wc == 0) {
                    const f32x4 v0 = acc[ai][0][m][0] * rs, v1 = acc[ai][0][m][1] * rs;
                    const u32x4 hi = pack8(v0, v1);
                    const f32x4 d0 = (f32x4){v0[0] - bflo(hi.x), v0[1] - bfhi(hi.x), v0[2] - bflo(hi.y), v0[3] - bfhi(hi.y)};
                    const f32x4 d1 = (f32x4){v1[0] - bflo(hi.z), v1[1] - bfhi(hi.z), v1[2] - bflo(hi.w), v1[3] - bfhi(hi.w)};
                    bf16_t* lp = lr + (size_t)row * 64 + (fq >> 1) * 32 + (fq & 1) * 8;
                    *(u32x4*)lp = hi; *(u32x4*)(lp + 16) = pack8(d0, d1);
                }
            }
    }
};
struct EpiGate {
    static constexpr bool PERM = true;
    static constexpr bool NEEDS_RS = true; const float* rsv;
    bf16_t* P; const float* ssq;
    __device__ __forceinline__ void operator()(const f32x4 (&acc)[2][2][4][2], const Unit& u, int wr, int wc, int fr, int fq, const LAS float* rsl) const {
        const int row0 = u.pm * 256 + wr * 64 + fr;
#pragma unroll
        for (int ai = 0; ai < 2; ++ai)
#pragma unroll
            for (int m = 0; m < 4; ++m) {
                const int row = row0 + ai * 128 + m * 16; const float rs = rsl[ai * 128 + wr * 64 + m * 16 + fr];
#pragma unroll
                for (int bj = 0; bj < 2; ++bj) {
                    f32x4 v0 = acc[ai][bj][m][0] * rs, v1 = acc[ai][bj][m][1] * rs;
#pragma unroll
                    for (int j = 0; j < 4; ++j) { v0[j] = sigmoidf_(v0[j]); v1[j] = sigmoidf_(v1[j]); }
                    *(u32x4*)(P + (size_t)row * PW + u.pn * 256 + bj * 128 + wc * 32 + 8 * fq) = pack8(v0, v1);
                }
                asm volatile("" ::: "memory");
            }
    }
};
struct EpiPool {
    static constexpr bool PERM = true;
    static constexpr bool NEEDS_RS = false;
    bf16_t* P; const float* pscale;
    __device__ __forceinline__ void operator()(const f32x4 (&acc)[2][2][4][2], const Unit& u, int wr, int wc, int fr, int fq, const LAS float* rsl) const {
        const int row0 = u.pm * 256 + wr * 64 + fr;
#pragma unroll
        for (int bj = 0; bj < 2; ++bj) {
            const int col = u.pn * 256 + bj * 128 + wc * 32 + 8 * fq;
            const f32x4 p0 = *(const f32x4*)(pscale + col), p1 = *(const f32x4*)(pscale + col + 4);
#pragma unroll
            for (int ai = 0; ai < 2; ++ai)
#pragma unroll
                for (int m = 0; m < 4; ++m) {
                    const int row = row0 + ai * 128 + m * 16;
                    bf16_t* ptr = P + (size_t)row * PW + 1024 + col;
                    const u32x4 g = *(const u32x4*)ptr;
                    f32x4 v0 = acc[ai][bj][m][0] * p0, v1 = acc[ai][bj][m][1] * p1;
                    v0[0] *= bflo(g.x); v0[1] *= bfhi(g.x); v0[2] *= bflo(g.y); v0[3] *= bfhi(g.y);
                    v1[0] *= bflo(g.z); v1[1] *= bfhi(g.z); v1[2] *= bflo(g.w); v1[3] *= bfhi(g.w);
                    *(u32x4*)ptr = pack8(v0, v1);
                    if (m & 1) asm volatile("" ::: "memory");
                }
        }
    }
};
struct EpiMerge {
    static constexpr bool PERM = true;
    static constexpr bool NEEDS_RS = false;
    bf16_t* P;
    __device__ __forceinline__ void operator()(const f32x4 (&acc)[2][2][4][2], const Unit& u, int wr, int wc, int fr, int fq, const LAS float* rsl) const {
        const int row0 = u.pm * 256 + wr * 64 + fr;
#pragma unroll
        for (int ai = 0; ai < 2; ++ai)
#pragma unroll
            for (int m = 0; m < 4; ++m) {
                const int row = row0 + ai * 128 + m * 16;
#pragma unroll
                for (int bj = 0; bj < 2; ++bj) {
                    bf16_t* ptr = P + (size_t)row * PW + u.pn * 256 + bj * 128 + wc * 32 + 8 * fq;
                    const u32x4 g = *(const u32x4*)ptr; const u32x4 t = *(const u32x4*)(ptr + 1024);
                    f32x4 v0 = acc[ai][bj][m][0], v1 = acc[ai][bj][m][1];
                    v0[0] = v0[0] * bflo(g.x) + bflo(t.x); v0[1] = v0[1] * bfhi(g.x) + bfhi(t.x); v0[2] = v0[2] * bflo(g.y) + bflo(t.y); v0[3] = v0[3] * bfhi(g.y) + bfhi(t.y);
                    v1[0] = v1[0] * bflo(g.z) + bflo(t.z); v1[1] = v1[1] * bfhi(g.z) + bfhi(t.z); v1[2] = v1[2] * bflo(g.w) + bflo(t.w); v1[3] = v1[3] * bfhi(g.w) + bfhi(t.w);
                    *(u32x4*)ptr = pack8(v0, v1);
                }
                asm volatile("" ::: "memory");
            }
    }
};
struct EpiRes {
    static constexpr bool PERM = true;
    static constexpr bool NEEDS_RS = false;
    bf16_t* xb; float* ssq;
    __device__ __forceinline__ void operator()(const f32x4 (&acc)[2][2][4][2], const Unit& u, int wr, int wc, int fr, int fq, const LAS float* rsl) const {
        const int row0 = u.pm * 256 + wr * 64 + fr;
#pragma unroll
        for (int ai = 0; ai < 2; ++ai)
#pragma unroll
            for (int m = 0; m < 4; ++m) {
                const int row = row0 + ai * 128 + m * 16; float s = 0.f;
#pragma unroll
                for (int bj = 0; bj < 2; ++bj) {
                    bf16_t* ptr = xb + (size_t)row * 1024 + u.pn * 256 + bj * 128 + wc * 32 + 8 * fq;
                    const u32x4 g = *(const u32x4*)ptr;
                    f32x4 v0 = acc[ai][bj][m][0], v1 = acc[ai][bj][m][1];
                    v0[0] += bflo(g.x); v0[1] += bfhi(g.x); v0[2] += bflo(g.y); v0[3] += bfhi(g.y);
                    v1[0] += bflo(g.z); v1[1] += bfhi(g.z); v1[2] += bflo(g.w); v1[3] += bfhi(g.w);
                    *(u32x4*)ptr = pack8(v0, v1);
                    s += (v0[0] * v0[0] + v0[1] * v0[1]) + (v0[2] * v0[2] + v0[3] * v0[3]) + (v1[0] * v1[0] + v1[1] * v1[1]) + (v1[2] * v1[2] + v1[3] * v1[3]);
                }
                s += __shfl_xor(s, 16); s += __shfl_xor(s, 32);
                if (fq == 0) ssq[(size_t)row * 16 + u.pn * 4 + wc] = s;
            }
    }
};
struct EpiResFinal {
    static constexpr bool PERM = true;
    static constexpr bool NEEDS_RS = false;
    char* ws; LAS unsigned char* lx;
    __device__ __forceinline__ void operator()(const f32x4 (&acc)[2][2][4][2], const Unit& u, int wr, int wc, int fr, int fq, const LAS float* rsl) const {
        const int row0 = u.pm * 256 + wr * 64 + fr, tid = threadIdx.x;
        const Params __attribute__((address_space(4)))* kp = (const Params __attribute__((address_space(4)))*)__builtin_amdgcn_kernarg_segment_ptr();
        const bf16_t* xb = (const bf16_t*)(ws + OFF_XB); float* out = kp->xf; const float* gfin = kp->norm_final;
        float* xch = (float*)(ws + OFF_XCH); unsigned* cnt = (unsigned*)(ws + OFF_BAR) + 6144;
#pragma unroll
        for (int ai = 0; ai < 2; ++ai) {
#pragma unroll
            for (int m = 0; m < 4; ++m) { float s = 0.f;
                u32x4 g2[2];
#pragma unroll
                for (int bj = 0; bj < 2; ++bj) g2[bj] = *(const u32x4*)(xb + (size_t)(row0 + ai * 128 + m * 16) * 1024 + u.pn * 256 + bj * 128 + wc * 32 + 8 * fq);
#pragma unroll
                for (int bj = 0; bj < 2; ++bj) { const u32x4 gg = g2[bj]; f32x4 v0 = acc[ai][bj][m][0], v1 = acc[ai][bj][m][1];
                    v0[0] += bflo(gg.x); v0[1] += bfhi(gg.x); v0[2] += bflo(gg.y); v0[3] += bfhi(gg.y); v1[0] += bflo(gg.z); v1[1] += bfhi(gg.z); v1[2] += bflo(gg.w); v1[3] += bfhi(gg.w);
                    s += (v0[0] * v0[0] + v0[1] * v0[1]) + (v0[2] * v0[2] + v0[3] * v0[3]) + (v1[0] * v1[0] + v1[1] * v1[1]) + (v1[2] * v1[2] + v1[3] * v1[3]); }
                s += __shfl_xor(s, 16); s += __shfl_xor(s, 32);
                if (fq == 0) *(LAS float*)(lx + ((ai * 128 + wr * 64 + m * 16 + fr) * 4 + wc) * 4) = s;
                if (m & 1) asm volatile("" ::: "memory"); }
        }
        __builtin_amdgcn_s_waitcnt(0xc07f);
        __builtin_amdgcn_s_barrier();
        if (tid < 256) { const f32x4 q = *(LAS f32x4*)(lx + tid * 16);
            __hip_atomic_store(xch + (size_t)(u.pm * 4 + u.pn) * 256 + tid, (q[0] + q[1]) + (q[2] + q[3]), __ATOMIC_RELAXED, __HIP_MEMORY_SCOPE_AGENT); }
        asm volatile("s_waitcnt vmcnt(0)" ::: "memory");
        __builtin_amdgcn_s_barrier();
        if (tid == 0) { __hip_atomic_fetch_add(cnt + 16 * u.pm, 1u, __ATOMIC_RELAXED, __HIP_MEMORY_SCOPE_AGENT);
            unsigned polls = 0; while (__hip_atomic_load(cnt + 16 * u.pm, __ATOMIC_RELAXED, __HIP_MEMORY_SCOPE_AGENT) < 4u && ++polls < (1u << 22)) __builtin_amdgcn_s_sleep(1); }
        __builtin_amdgcn_s_barrier();
        if (tid < 256) { float t = 0.f;
#pragma unroll
            for (int j = 0; j < 4; ++j) t += __hip_atomic_load(xch + (size_t)(u.pm * 4 + j) * 256 + tid, __ATOMIC_RELAXED, __HIP_MEMORY_SCOPE_AGENT);
            *(LAS float*)(lx + 4096 + tid * 4) = rsqrtf(t * (1.f / 1024.f) + 1e-6f); }
        __builtin_amdgcn_s_waitcnt(0xc07f);
        __builtin_amdgcn_s_barrier();
        f32x4 wf[2][2];
#pragma unroll
        for (int bj = 0; bj < 2; ++bj) { const int col = u.pn * 256 + bj * 128 + wc * 32 + 8 * fq; wf[bj][0] = *(const f32x4*)(gfin + col); wf[bj][1] = *(const f32x4*)(gfin + col + 4); }
#pragma unroll
        for (int ai = 0; ai < 2; ++ai)
#pragma unroll
            for (int m = 0; m < 4; ++m) { const float rs = *(LAS float*)(lx + 4096 + (ai * 128 + wr * 64 + m * 16 + fr) * 4);
                u32x4 g2[2];
#pragma unroll
                for (int bj = 0; bj < 2; ++bj) g2[bj] = *(const u32x4*)(xb + (size_t)(row0 + ai * 128 + m * 16) * 1024 + u.pn * 256 + bj * 128 + wc * 32 + 8 * fq);
#pragma unroll
                for (int bj = 0; bj < 2; ++bj) { const u32x4 gg = g2[bj]; f32x4 v0 = acc[ai][bj][m][0], v1 = acc[ai][bj][m][1];
                    v0[0] += bflo(gg.x); v0[1] += bfhi(gg.x); v0[2] += bflo(gg.y); v0[3] += bfhi(gg.y); v1[0] += bflo(gg.z); v1[1] += bfhi(gg.z); v1[2] += bflo(gg.w); v1[3] += bfhi(gg.w);
                    float* op = out + (size_t)(row0 + ai * 128 + m * 16) * 1024 + u.pn * 256 + bj * 128 + wc * 32 + 8 * fq;
                    *(f32x4*)op = v0 * rs * wf[bj][0]; *(f32x4*)(op + 4) = v1 * rs * wf[bj][1]; }
                if (m & 1) asm volatile("" ::: "memory"); }
    }
};
struct EpiFfn1 {
    static constexpr bool PERM = true;
    static constexpr bool NEEDS_RS = true; const float* rsv;
    bf16_t* ACT; const float* ssq;
    __device__ __forceinline__ void operator()(const f32x4 (&acc)[2][2][4][2], const Unit& u, int wr, int wc, int fr, int fq, const LAS float* rsl) const {
        const int row0 = u.pm * 256 + wr * 64 + fr;
#pragma unroll
        for (int ai = 0; ai < 2; ++ai)
#pragma unroll
            for (int m = 0; m < 4; ++m) {
                const int row = row0 + ai * 128 + m * 16; const float rs = rsl[ai * 128 + wr * 64 + m * 16 + fr];
                f32x4 o[2];
#pragma unroll
                for (int n = 0; n < 2; ++n)
#pragma unroll
                    for (int j = 0; j < 4; ++j) { const float gt = acc[ai][0][m][n][j] * rs, up = acc[ai][1][m][n][j] * rs; o[n][j] = gt * sigmoidf_(gt) * up; }
                *(u32x4*)(ACT + (size_t)row * DFF + u.pn * 128 + wc * 32 + 8 * fq) = pack8(o[0], o[1]);
                asm volatile("" ::: "memory");
            }
    }
};

struct WJob { const float* src; const float* g; bf16_t* dst; int ld, ldd, vlo, vhi, kw; };
__device__ __forceinline__ WJob wjob_decode(const Params& p, int layer, int j) {
    WJob w; w.g = nullptr; w.vlo = 0; w.vhi = 256; w.kw = 256;
    bf16_t* W = (bf16_t*)(p.ws + OFF_W + (size_t)layer * SZ_WLAYER);
    if (j < 480) { const int nb = j >> 2, kb = j & 3, n0 = nb * 32; int c0;
        if (n0 < 3072) c0 = n0; else if (n0 < 3584) c0 = 3104 + (n0 - 3072); else if (n0 == 3584) c0 = 3072; else { c0 = 0; w.vhi = 0; }
        w.src = p.w_in + (size_t)layer * 1024 * INW + (size_t)kb * 256 * INW + c0; w.ld = INW; w.g = p.norm_mix + layer * 1024 + kb * 256;
        w.dst = (bf16_t*)((char*)W + WO_A) + (size_t)n0 * 1024 + kb * 256; w.ldd = 1024; return w; }
    j -= 480;
    if (j < 256) { const int nb = j >> 2, kb = j & 3, n0 = nb * 32;
        w.src = p.w_in + (size_t)layer * 1024 * INW + (size_t)kb * 256 * INW + 3616 + n0; w.ld = INW; w.g = p.norm_mix + layer * 1024 + kb * 256;
        w.dst = (bf16_t*)((char*)W + WO_B) + (size_t)n0 * 1024 + kb * 256; w.ldd = 1024; return w; }
    j -= 256;
    if (j < 128) { const int nb = j >> 2, kb = j & 3, n0 = nb * 32;
        w.src = p.w_ga + (size_t)layer * 1024 * 1024 + (size_t)kb * 256 * 1024 + n0; w.ld = 1024;
        w.dst = (bf16_t*)((char*)W + WO_GA) + (size_t)n0 * 1024 + kb * 256; w.ldd = 1024; return w; }
    j -= 128;
    if (j < 64) { const int nb = j >> 1, kb = j & 1, n0 = nb * 32, grp = n0 >> 8;
        w.src = p.w_pool + (size_t)layer * 4 * 128 * 256 + (size_t)grp * 128 * 256 + (n0 & 255); w.ld = 256;
        w.vlo = 0; w.vhi = kb == 0 ? 128 : 0; w.kw = kb == 0 ? 128 : 0;
        w.dst = (bf16_t*)((char*)W + WO_POOL) + (size_t)n0 * 128; w.ldd = 128; return w; }
    j -= 64;
    if (j < 128) { const int nb = j >> 2, kb = j & 3, n0 = nb * 32;
        w.src = p.w_out + (size_t)layer * 1024 * 1024 + (size_t)kb * 256 * 1024 + n0; w.ld = 1024;
        w.dst = (bf16_t*)((char*)W + WO_OUT) + (size_t)n0 * 1024 + kb * 256; w.ldd = 1024; return w; }
    j -= 128;
    if (j < 704) { const int nb = j >> 2, kb = j & 3, n0 = nb * 32, pn = n0 >> 8, within = n0 & 255;
        const int c0 = within < 128 ? 128 * pn + within : DFF + 128 * pn + (within - 128);
        w.src = p.w_f1 + (size_t)layer * 1024 * 2 * DFF + (size_t)kb * 256 * 2 * DFF + c0; w.ld = 2 * DFF; w.g = p.norm_ffn + layer * 1024 + kb * 256;
        w.dst = (bf16_t*)((char*)W + WO_F1) + (size_t)n0 * 1024 + kb * 256; w.ldd = 1024; return w; }
    j -= 704;
    { const int nb = j / 11, kb = j % 11, n0 = nb * 32;
        w.src = p.w_f2 + (size_t)layer * DFF * 1024 + (size_t)kb * 256 * 1024 + n0; w.ld = 1024;
        w.dst = (bf16_t*)((char*)W + WO_F2) + (size_t)n0 * DFF + kb * 256; w.ldd = DFF; return w; }
}

__device__ __forceinline__ void phase_prep(LAS unsigned char* lds, const Params& p) {
    int tid = threadIdx.x; asm volatile("" : "+v"(tid));
    const int wid = tid >> 6, lane = tid & 63;
    {
        f32x4 v[4]; WJob w, wn; int buf = 0;
#define PREP_LOAD(W_) do { _Pragma("unroll") for (int ps = 0; ps < 4; ++ps) { const int kk = (tid >> 3) + 64 * ps, c4 = (tid & 7) * 4; \
            v[ps] = (f32x4){0.f, 0.f, 0.f, 0.f}; \
            if (kk >= (W_).vlo && kk < (W_).vhi) { v[ps] = *(const f32x4*)((W_).src + (size_t)kk * (W_).ld + c4); if ((W_).g) v[ps] = v[ps] * (W_).g[kk]; } } } while (0)
        int job = bid_();
        if (job < 2 * 2112) { w = wjob_decode(p, job / 2112, job % 2112); PREP_LOAD(w); }
        for (; job < 2 * 2112; job += nblk_()) {
            const int tb = buf * 33792;
#pragma unroll
            for (int ps = 0; ps < 4; ++ps) { const int kk = (tid >> 3) + 64 * ps, c4 = (tid & 7) * 4;
#pragma unroll
                for (int e = 0; e < 4; ++e) *(LAS float*)(lds + tb + (kk * 33 + c4 + e) * 4) = v[ps][e]; }
            __syncthreads();
            const int nj = job + nblk_();
            if (nj < 2 * 2112) { wn = wjob_decode(p, nj / 2112, nj % 2112); PREP_LOAD(wn); }
            { const int n = tid & 31, s = tid >> 5; unsigned pk[8];
#pragma unroll
                for (int e = 0; e < 8; ++e) { const float a = *(LAS float*)(lds + tb + ((s * 16 + 2 * e) * 33 + n) * 4), b = *(LAS float*)(lds + tb + ((s * 16 + 2 * e + 1) * 33 + n) * 4); pk[e] = cvt_pk_bf16(a, b); }
                bf16_t* d = w.dst + (size_t)n * w.ldd + s * 16;
                if (s * 16 < w.kw) { *(u32x4*)d = (u32x4){pk[0], pk[1], pk[2], pk[3]}; *(u32x4*)(d + 8) = (u32x4){pk[4], pk[5], pk[6], pk[7]}; } }
            w = wn; buf ^= 1;
        }
#undef PREP_LOAD
        __syncthreads();
    }
    bf16_t* xb = (bf16_t*)(p.ws + OFF_XB); float* ssq = (float*)(p.ws + OFF_SSQ);
    for (int row0 = bid_() * 8 + wid; row0 < T_TOK; row0 += nblk_() * 16) {
        f32x4 v[2][4]; bool ok[2];
#pragma unroll
        for (int u = 0; u < 2; ++u) { const int row = row0 + u * nblk_() * 8; ok[u] = row < T_TOK;
            if (ok[u]) { const float* src = p.x_in + (size_t)row * 1024 + lane * 16;
#pragma unroll
                for (int i = 0; i < 4; ++i) v[u][i] = *(const f32x4*)(src + 4 * i); } }
#pragma unroll
        for (int u = 0; u < 2; ++u) if (ok[u]) { const int row = row0 + u * nblk_() * 8;
            float s = 0.f;
#pragma unroll
            for (int i = 0; i < 4; ++i) s += (v[u][i][0] * v[u][i][0] + v[u][i][1] * v[u][i][1]) + (v[u][i][2] * v[u][i][2] + v[u][i][3] * v[u][i][3]);
#pragma unroll
            for (int o = 32; o >= 1; o >>= 1) s += __shfl_xor(s, o);
            bf16_t* dst = xb + (size_t)row * 1024 + lane * 16;
            *(u32x4*)dst = pack8(v[u][0], v[u][1]); *(u32x4*)(dst + 8) = pack8(v[u][2], v[u][3]);
            if (lane < 16) ssq[(size_t)row * 16 + lane] = lane == 0 ? s : 0.f;
            if (lane == 0) ((float*)(p.ws + OFF_RS))[row] = rsqrtf(s * (1.f / 1024.f) + 1e-6f); }
    }
}

#define MFMA16(a, b, c) __builtin_amdgcn_mfma_f32_16x16x32_bf16((a), (b), (c), 0, 0, 0)
template <bool PASS2>
__device__ __forceinline__ void gla_pass(LAS unsigned char* lds, const Params& p, int layer) {
    constexpr int SQ = 0, SKD = 17408, SV = 35840, SP = 69632, SLR = 78848, SDEC = 84992, SST = 85504, SK = SST, SX = SST + 17408, SCOL = SST + 51200;
    int tid = threadIdx.x; asm volatile("" : "+v"(tid));
    const int wid = __builtin_amdgcn_readfirstlane(tid >> 6), lane = tid & 63, fr = lane & 15, fq = lane >> 4;
    const int dk0 = (tid & 63) * 2;
    bf16_t* P = (bf16_t*)(p.ws + OFF_PROJ);
    const bf16_t* LR = (const bf16_t*)(p.ws + OFF_LR);
    bf16_t* QT = (bf16_t*)(p.ws + OFF_E + (size_t)32 * 1024 * 1024);
    bf16_t* O = (bf16_t*)(p.ws + OFF_O);
    for (int item = bid_(); item < 256; item += nblk_()) {
        const int b = item >> 7, h = (item >> 5) & 3, grp = item & 31;
#pragma unroll 1
        for (int dir = 0; dir < 2; ++dir) {
            const int scan = (b * 4 + h) * 2 + dir;
            bf16x8 wB1, wB2; float biasx;
            { const float* Wc = (dir ? p.wdu_b : p.wdu_f) + (size_t)layer * 16 * 512 + h * 128 + wid * 16 + fr;
              float wv[8]; unsigned h1[4], h2[4];
#pragma unroll
              for (int j = 0; j < 8; ++j) wv[j] = Wc[((fq & 1) * 8 + j) * 512];
#pragma unroll
              for (int jp = 0; jp < 4; ++jp) { const float a = wv[2 * jp], bq = wv[2 * jp + 1]; const unsigned hi = cvt_pk_bf16(a, bq);
                  const unsigned lo = cvt_pk_bf16(a - bflo(hi), bq - bfhi(hi)); h1[jp] = hi; h2[jp] = fq < 2 ? lo : 0u; }
              wB1 = __builtin_bit_cast(bf16x8, (u32x4){h1[0], h1[1], h1[2], h1[3]}); wB2 = __builtin_bit_cast(bf16x8, (u32x4){h2[0], h2[1], h2[2], h2[3]});
              biasx = (dir ? p.bd_b : p.bd_f)[layer * 512 + h * 128 + wid * 16 + fr]; }
            f32x4 accS[8][2];
#pragma unroll
            for (int m8 = 0; m8 < 8; ++m8)
#pragma unroll
                for (int n = 0; n < 2; ++n) accS[m8][n] = (f32x4){0.f, 0.f, 0.f, 0.f};
            float gtot0 = 0.f, gtot1 = 0.f;
            u32x4 rk[2], rq[2], rv[4]; u32x4 rl = (u32x4){0u, 0u, 0u, 0u};
#define GLA_ISSUE(CC) do { const int chunk_ = dir ? 7 - (CC) : (CC); const int t0_ = b * SEQL + grp * 512 + chunk_ * 64; \
                _Pragma("unroll") for (int it = 0; it < 2; ++it) { const int pi = tid + 512 * it, row = pi >> 4, seg = pi & 15; \
                    const bf16_t* src = P + (size_t)(t0_ + row) * PW + h * 128 + seg * 8; rk[it] = *(const u32x4*)(src + 512); } \
                if (tid < 256) { const int row = tid >> 2, seg = tid & 3; rl = *(const u32x4*)(LR + (size_t)(t0_ + row) * 64 + dir * 32 + seg * 8); } } while (0)
            GLA_ISSUE(0);
#pragma unroll 1
            for (int cc = 0; cc < 8; ++cc) {
                const int chunk = dir ? 7 - cc : cc;
                const int t0 = b * SEQL + grp * 512 + chunk * 64;
#pragma unroll
                for (int it = 0; it < 2; ++it) { const int pi = tid + 512 * it, row = pi >> 4, seg = pi & 15;
                    *(LAS u32x4*)(lds + SK + row * 272 + seg * 16) = rk[it];
                    if (PASS2) rq[it] = *(const u32x4*)(P + (size_t)(t0 + row) * PW + h * 128 + seg * 8); }
#pragma unroll
                for (int it = 0; it < 4; ++it) { const int pi = tid + 512 * it, row = pi >> 5, seg = pi & 31;
                    rv[it] = *(const u32x4*)(P + (size_t)(t0 + row) * PW + 1024 + h * 256 + seg * 8); }
                if (tid < 256) { const int row = tid >> 2, seg = tid & 3; *(LAS u32x4*)(lds + SLR + row * 64 + seg * 16) = rl; }
                __syncthreads();
#pragma unroll 1
                for (int m = 0; m < 4; ++m) {
                    const bf16x8 A = *(LAS bf16x8*)(lds + SLR + (m * 16 + fr) * 64 + fq * 16);
                    f32x4 xx = (f32x4){0.f, 0.f, 0.f, 0.f};
                    xx = MFMA16(A, wB1, xx); xx = MFMA16(A, wB2, xx);
#pragma unroll
                    for (int jj = 0; jj < 4; ++jj) { const float x = xx[jj] + biasx; const float ls = fminf(x, 0.f) - __logf(1.f + __expf(-fabsf(x)));
                        *(LAS float*)(lds + SX + ((m * 16 + 4 * fq + jj) * 132 + wid * 16 + fr) * 4) = ls * 0.0625f; }
                }
                if (PASS2) {
#pragma unroll
                    for (int it = 0; it < 2; ++it) { const int pi = tid + 512 * it, row = pi >> 4, seg = pi & 15; *(LAS u32x4*)(lds + SQ + row * 272 + seg * 16) = rq[it]; } }
                __syncthreads();
                float c0[8], c1[8];
#pragma unroll
                for (int e = 0; e < 8; ++e) { const f32x2 t2 = *(LAS f32x2*)(lds + SX + ((wid * 8 + e) * 132 + dk0) * 4); c0[e] = t2.x; c1[e] = t2.y; }
                if (dir == 0) {
#pragma unroll
                    for (int e = 1; e < 8; ++e) { c0[e] += c0[e - 1]; c1[e] += c1[e - 1]; }
                } else {
#pragma unroll
                    for (int e = 6; e >= 0; --e) { c0[e] += c0[e + 1]; c1[e] += c1[e + 1]; }
                }
                { f32x2 t2; t2.x = dir == 0 ? c0[7] : c0[0]; t2.y = dir == 0 ? c1[7] : c1[0]; *(LAS f32x2*)(lds + SCOL + (wid * 128 + dk0) * 4) = t2; }
                __syncthreads();
                float tot0 = 0.f, tot1 = 0.f, offs0 = 0.f, offs1 = 0.f;
#pragma unroll
                for (int s = 0; s < 8; ++s) { const f32x2 t2 = *(LAS f32x2*)(lds + SCOL + (s * 128 + dk0) * 4); tot0 += t2.x; tot1 += t2.y;
                    const bool inc = dir == 0 ? (s < wid) : (s > wid); offs0 += inc ? t2.x : 0.f; offs1 += inc ? t2.y : 0.f; }
                const float etot0 = __expf(tot0), etot1 = __expf(tot1), eg0 = __expf(gtot0), eg1 = __expf(gtot1);
                unsigned kd0p[4], kd1p[4]; float kd0prev = 0.f, kd1prev = 0.f;
#pragma unroll
                for (int e = 0; e < 8; ++e) { const int i = wid * 8 + e;
                    const float ec0 = __expf(c0[e] + offs0), ec1 = __expf(c1[e] + offs1), inv0 = __builtin_amdgcn_rcpf(ec0), inv1 = __builtin_amdgcn_rcpf(ec1);
                    const unsigned kw = *(LAS unsigned*)(lds + SK + i * 272 + dk0 * 2);
                    const float k0 = bflo(kw), k1 = bfhi(kw);
                    const float kd0 = k0 * (etot0 * inv0), kd1 = k1 * (etot1 * inv1);
                    if (PASS2) { const unsigned qw = *(LAS unsigned*)(lds + SQ + i * 272 + dk0 * 2);
                        const float qe0 = bflo(qw) * 0.08838834764831845f * ec0, qe1 = bfhi(qw) * 0.08838834764831845f * ec1;
                        *(LAS unsigned*)(lds + SQ + i * 272 + dk0 * 2) = cvt_pk_bf16(qe0, qe1);
                        const unsigned qt = cvt_pk_bf16(qe0 * eg0, qe1 * eg1);
                        if (dir == 0) *(unsigned*)(QT + (size_t)(t0 + i) * 512 + h * 128 + dk0) = qt; else *(unsigned*)(P + (size_t)(t0 + i) * PW + h * 128 + dk0) = qt;
                        *(LAS unsigned*)(lds + SK + i * 272 + dk0 * 2) = cvt_pk_bf16(k0 * inv0, k1 * inv1); }
                    if (e & 1) { kd0p[e >> 1] = cvt_pk_bf16(kd0prev, kd0); kd1p[e >> 1] = cvt_pk_bf16(kd1prev, kd1); } else { kd0prev = kd0; kd1prev = kd1; } }
                *(LAS u32x4*)(lds + SKD + dk0 * 144 + wid * 16) = (u32x4){kd0p[0], kd0p[1], kd0p[2], kd0p[3]};
                *(LAS u32x4*)(lds + SKD + (dk0 + 1) * 144 + wid * 16) = (u32x4){kd1p[0], kd1p[1], kd1p[2], kd1p[3]};
                if (wid == 0) { f32x2 t2; t2.x = etot0; t2.y = etot1; *(LAS f32x2*)(lds + SDEC + dk0 * 4) = t2; }
                gtot0 += tot0; gtot1 += tot1;
#pragma unroll
                for (int it = 0; it < 4; ++it) { const int pi = tid + 512 * it, row = pi >> 5, seg = pi & 31;
                    *(LAS u32x4*)(lds + SV + row * 528 + seg * 16) = rv[it]; }
                __syncthreads();
                if (PASS2) {
                    f32x4 accP[2];
#pragma unroll
                    for (int s = 0; s < 2; ++s) { const int tt = wid * 2 + s, ib = tt >> 2, jb = tt & 3; f32x4 a = (f32x4){0.f, 0.f, 0.f, 0.f};
#pragma unroll
                        for (int kb = 0; kb < 4; ++kb) { const bf16x8 A = *(LAS bf16x8*)(lds + SK + (jb * 16 + fr) * 272 + (kb * 32 + fq * 8) * 2);
                            const bf16x8 B = *(LAS bf16x8*)(lds + SQ + (ib * 16 + fr) * 272 + (kb * 32 + fq * 8) * 2); a = MFMA16(A, B, a); }
                        accP[s] = a; }
                    __syncthreads();
#pragma unroll
                    for (int s = 0; s < 2; ++s) { const int tt = wid * 2 + s, ib = tt >> 2, jb = tt & 3; const int i = ib * 16 + fr, jbase = jb * 16 + 4 * fq; float v[4];
#pragma unroll
                        for (int jj = 0; jj < 4; ++jj) { const int j = jbase + jj; const bool keep = dir == 0 ? (j <= i) : (j > i); v[jj] = keep ? accP[s][jj] : 0.f; }
                        *(LAS u32x2*)(lds + SP + i * 144 + jbase * 2) = (u32x2){cvt_pk_bf16(v[0], v[1]), cvt_pk_bf16(v[2], v[3])}; }
#pragma unroll
                    for (int m8 = 0; m8 < 8; ++m8)
#pragma unroll
                        for (int n = 0; n < 2; ++n) { const f32x4 sv = accS[m8][n];
                            *(LAS u32x2*)(lds + SST + (wid * 32 + n * 16 + fr) * 272 + (m8 * 16 + 4 * fq) * 2) = (u32x2){cvt_pk_bf16(sv[0], sv[1]), cvt_pk_bf16(sv[2], sv[3])}; }
                    __syncthreads();
                }
                bf16x8 vf[2][2];
#pragma unroll
                for (int n = 0; n < 2; ++n)
#pragma unroll
                    for (int kb2 = 0; kb2 < 2; ++kb2) {
                        const int a0 = SV + (kb2 * 32 + fq * 8 + (fr >> 2)) * 528 + (wid * 32 + n * 16 + 4 * (fr & 3)) * 2;
                        const s16x4 lo = __builtin_amdgcn_ds_read_tr16_b64_v4i16((LAS s16x4*)(lds + a0));
                        const s16x4 hi = __builtin_amdgcn_ds_read_tr16_b64_v4i16((LAS s16x4*)(lds + a0 + 4 * 528));
                        vf[n][kb2] = __builtin_shufflevector(lo, hi, 0, 1, 2, 3, 4, 5, 6, 7); }
                if (PASS2) {
#pragma unroll
                    for (int n = 0; n < 2; ++n) {
                        f32x4 accO[4];
#pragma unroll
                        for (int m = 0; m < 4; ++m) accO[m] = (f32x4){0.f, 0.f, 0.f, 0.f};
#pragma unroll
                        for (int kb = 0; kb < 4; ++kb) { const bf16x8 A = *(LAS bf16x8*)(lds + SST + (wid * 32 + n * 16 + fr) * 272 + (kb * 32 + fq * 8) * 2);
#pragma unroll
                            for (int m = 0; m < 4; ++m) { const bf16x8 B = *(LAS bf16x8*)(lds + SQ + (m * 16 + fr) * 272 + (kb * 32 + fq * 8) * 2); accO[m] = MFMA16(A, B, accO[m]); } }
#pragma unroll
                        for (int kb2 = 0; kb2 < 2; ++kb2)
#pragma unroll
                            for (int m = 0; m < 4; ++m) { const bf16x8 B = *(LAS bf16x8*)(lds + SP + (m * 16 + fr) * 144 + (kb2 * 32 + fq * 8) * 2); accO[m] = MFMA16(vf[n][kb2], B, accO[m]); }
#pragma unroll
                        for (int m = 0; m < 4; ++m) { bf16_t* dst = O + (size_t)(t0 + m * 16 + fr) * 1024 + h * 256 + wid * 32 + n * 16 + 4 * fq; f32x4 v = accO[m];
                            if (dir) { const u32x2 old = *(const u32x2*)dst; v[0] += bflo(old.x); v[1] += bfhi(old.x); v[2] += bflo(old.y); v[3] += bfhi(old.y); }
                            *(u32x2*)dst = (u32x2){cvt_pk_bf16(v[0], v[1]), cvt_pk_bf16(v[2], v[3])}; }
                        asm volatile("" ::: "memory");
                    }
                }
                if (cc < 7) GLA_ISSUE(cc + 1);
#pragma unroll
                for (int m8 = 0; m8 < 8; ++m8) { const f32x4 d = *(LAS f32x4*)(lds + SDEC + (m8 * 16 + 4 * fq) * 4);
#pragma unroll
                    for (int n = 0; n < 2; ++n) accS[m8][n] = accS[m8][n] * d;
#pragma unroll
                    for (int kb2 = 0; kb2 < 2; ++kb2) { const bf16x8 A = *(LAS bf16x8*)(lds + SKD + (m8 * 16 + fr) * 144 + (kb2 * 32 + fq * 8) * 2);
#pragma unroll
                        for (int n = 0; n < 2; ++n) accS[m8][n] = MFMA16(A, vf[n][kb2], accS[m8][n]); } }
                __syncthreads();
            }
            {
                char* wsl = p.ws; asm volatile("" : "+s"(wsl));
                bf16_t* Eit = (bf16_t*)(wsl + OFF_E) + (size_t)(scan * 32 + grp) * 32768 + (size_t)(wid * 32 + fr) * 128 + 4 * fq;
                float* DL = (float*)(wsl + OFF_DLOG);
#pragma unroll
                for (int m8 = 0; m8 < 8; ++m8)
#pragma unroll
                    for (int n = 0; n < 2; ++n)
                        *(u32x2*)(Eit + n * 16 * 128 + m8 * 16) = (u32x2){cvt_pk_bf16(accS[m8][n][0], accS[m8][n][1]), cvt_pk_bf16(accS[m8][n][2], accS[m8][n][3])};
                if (wid == 0) { DL[(scan * 32 + grp) * 128 + dk0] = gtot0; DL[(scan * 32 + grp) * 128 + dk0 + 1] = gtot1; }
            }
        }
    }
}

#undef GLA_ISSUE
__device__ __forceinline__ void phase_combine(const Params& p) {
    bf16_t* E = (bf16_t*)(p.ws + OFF_E); const float* DL = (const float*)(p.ws + OFF_DLOG);
    int tid = threadIdx.x; asm volatile("" : "+v"(tid));
    for (int idx = bid_() * 512 + tid; idx < 16 * 4096; idx += nblk_() * 512) {
        const int scan = idx >> 12, e8 = idx & 4095, dk0 = (e8 & 15) * 8, dir = scan & 1;
        float R[8];
#pragma unroll
        for (int i = 0; i < 8; ++i) R[i] = 0.f;
#pragma unroll 1
        for (int q4 = 0; q4 < 4; ++q4) {
            u32x4 ev[8]; f32x4 d0[8], d1[8];
#pragma unroll
            for (int gg = 0; gg < 8; ++gg) { const int go = q4 * 8 + gg, g = dir ? 31 - go : go;
                ev[gg] = *(const u32x4*)(E + (size_t)(scan * 32 + g) * 32768 + e8 * 8);
                d0[gg] = *(const f32x4*)(DL + (scan * 32 + g) * 128 + dk0); d1[gg] = *(const f32x4*)(DL + (scan * 32 + g) * 128 + dk0 + 4); }
#pragma unroll
            for (int gg = 0; gg < 8; ++gg) { const int go = q4 * 8 + gg, g = dir ? 31 - go : go;
                *(u32x4*)(E + (size_t)(scan * 32 + g) * 32768 + e8 * 8) = (u32x4){cvt_pk_bf16(R[0], R[1]), cvt_pk_bf16(R[2], R[3]), cvt_pk_bf16(R[4], R[5]), cvt_pk_bf16(R[6], R[7])};
                const u32x4 w = ev[gg];
                R[0] = R[0] * __expf(d0[gg][0]) + bflo(w.x); R[1] = R[1] * __expf(d0[gg][1]) + bfhi(w.x); R[2] = R[2] * __expf(d0[gg][2]) + bflo(w.y); R[3] = R[3] * __expf(d0[gg][3]) + bfhi(w.y);
                R[4] = R[4] * __expf(d1[gg][0]) + bflo(w.z); R[5] = R[5] * __expf(d1[gg][1]) + bfhi(w.z); R[6] = R[6] * __expf(d1[gg][2]) + bflo(w.w); R[7] = R[7] * __expf(d1[gg][3]) + bfhi(w.w); }
        }
    }
}

__device__ __forceinline__ void gla_light(LAS unsigned char* lds, const Params& p, int layer) {
    constexpr int SSTF = 0, SSTB = 69632, SSS = 139264;
    int tid = threadIdx.x; asm volatile("" : "+v"(tid));
    const int wid = __builtin_amdgcn_readfirstlane(tid >> 6), lane = tid & 63, fr = lane & 15, fq = lane >> 4, mt = wid & 3, hv = wid >> 2;
    bf16_t* P = (bf16_t*)(p.ws + OFF_PROJ);
    const bf16_t* E = (const bf16_t*)(p.ws + OFF_E);
    const bf16_t* QT = (const bf16_t*)(p.ws + OFF_E + (size_t)32 * 1024 * 1024);
    const bf16_t* O = (const bf16_t*)(p.ws + OFF_O);
    for (int item = bid_(); item < 256; item += nblk_()) {
        const int b = item >> 7, h = (item >> 5) & 3, grp = item & 31;
        const int scanf = (b * 4 + h) * 2;
        __syncthreads();
#pragma unroll
        for (int it = 0; it < 8; ++it) { const int pi = tid + 512 * it, row = pi >> 4, seg = pi & 15;
            const u32x4 vf_ = *(const u32x4*)(E + (size_t)(scanf * 32 + grp) * 32768 + row * 128 + seg * 8);
            const u32x4 vb_ = *(const u32x4*)(E + (size_t)((scanf + 1) * 32 + grp) * 32768 + row * 128 + seg * 8);
            *(LAS u32x4*)(lds + SSTF + row * 272 + seg * 16) = vf_; *(LAS u32x4*)(lds + SSTB + row * 272 + seg * 16) = vb_; }
        __syncthreads();
        f32x4 gn[8];
#pragma unroll
        for (int n = 0; n < 8; ++n) gn[n] = *(const f32x4*)(p.gla_norm + layer * 1024 + h * 256 + hv * 128 + n * 16 + 4 * fq);
#pragma unroll 1
        for (int cc = 0; cc < 8; ++cc) {
            const size_t tok = (size_t)(b * SEQL + grp * 512 + cc * 64 + mt * 16 + fr);
            bf16x8 bq[2][4];
#pragma unroll
            for (int kb = 0; kb < 4; ++kb) { bq[0][kb] = *(const bf16x8*)(QT + tok * 512 + h * 128 + kb * 32 + fq * 8); bq[1][kb] = *(const bf16x8*)(P + tok * PW + h * 128 + kb * 32 + fq * 8); }
            u32x2 oo[8], rr[8];
#pragma unroll
            for (int n = 0; n < 8; ++n) { oo[n] = *(const u32x2*)(O + tok * 1024 + h * 256 + hv * 128 + n * 16 + 4 * fq);
                rr[n] = *(const u32x2*)(P + tok * PW + 2048 + h * 256 + hv * 128 + n * 16 + 4 * fq); }
            f32x4 accO[8];
#pragma unroll
            for (int n = 0; n < 8; ++n) accO[n] = (f32x4){0.f, 0.f, 0.f, 0.f};
#pragma unroll
            for (int dir = 0; dir < 2; ++dir)
#pragma unroll
                for (int kb = 0; kb < 4; ++kb)
#pragma unroll
                    for (int n = 0; n < 8; ++n) { const bf16x8 A = *(LAS bf16x8*)(lds + (dir ? SSTB : SSTF) + (hv * 128 + n * 16 + fr) * 272 + (kb * 32 + fq * 8) * 2);
                        accO[n] = MFMA16(A, bq[dir][kb], accO[n]); }
            float s = 0.f;
#pragma unroll
            for (int n = 0; n < 8; ++n) { f32x4 v = accO[n]; v[0] += bflo(oo[n].x); v[1] += bfhi(oo[n].x); v[2] += bflo(oo[n].y); v[3] += bfhi(oo[n].y); accO[n] = v;
                s += (v[0] * v[0] + v[1] * v[1]) + (v[2] * v[2] + v[3] * v[3]); }
            s += __shfl_xor(s, 16); s += __shfl_xor(s, 32);
            const int sb = SSS + (cc & 1) * 512;
            if (fq == 0) *(LAS float*)(lds + sb + (hv * 64 + mt * 16 + fr) * 4) = s;
            __syncthreads();
            const float tot = *(LAS float*)(lds + sb + (mt * 16 + fr) * 4) + *(LAS float*)(lds + sb + (64 + mt * 16 + fr) * 4);
            const float rn = rsqrtf(tot * (1.f / 256.f) + 1e-6f);
#pragma unroll
            for (int n = 0; n < 8; ++n) { const float r0 = bflo(rr[n].x), r1 = bfhi(rr[n].x), r2 = bflo(rr[n].y), r3 = bfhi(rr[n].y);
                const f32x4 v = accO[n] * rn * gn[n];
                *(u32x2*)(P + tok * PW + 2048 + h * 256 + hv * 128 + n * 16 + 4 * fq) =
                    (u32x2){cvt_pk_bf16(v[0] * (r0 * sigmoidf_(r0)), v[1] * (r1 * sigmoidf_(r1))), cvt_pk_bf16(v[2] * (r2 * sigmoidf_(r2)), v[3] * (r3 * sigmoidf_(r3)))}; }
        }
    }
}

__device__ __forceinline__ void phase_gating(const Params& p, int layer) {
    int tid = threadIdx.x; asm volatile("" : "+v"(tid));
    const int wid = tid >> 6, lane = tid & 63;
    bf16_t* P = (bf16_t*)(p.ws + OFF_PROJ); const bf16_t* O = (const bf16_t*)(p.ws + OFF_O);
    const float* gn = p.gla_norm + layer * 1024 + lane * 16;
    f32x4 g4[4];
#pragma unroll
    for (int i = 0; i < 4; ++i) g4[i] = *(const f32x4*)(gn + 4 * i);
    for (int t0 = bid_() * 8 + wid; t0 < T_TOK; t0 += nblk_() * 16) {
        u32x4 oo[2][2], rr[2][2]; bool ok[2];
#pragma unroll
        for (int u = 0; u < 2; ++u) { const int t = t0 + u * nblk_() * 8; ok[u] = t < T_TOK;
            if (ok[u]) { oo[u][0] = *(const u32x4*)(O + (size_t)t * 1024 + lane * 16); oo[u][1] = *(const u32x4*)(O + (size_t)t * 1024 + lane * 16 + 8);
                const bf16_t* rp = P + (size_t)t * PW + 2048 + lane * 16; rr[u][0] = *(const u32x4*)rp; rr[u][1] = *(const u32x4*)(rp + 8); } }
#pragma unroll
        for (int u = 0; u < 2; ++u) if (ok[u]) { const int t = t0 + u * nblk_() * 8;
            bf16_t* rp = P + (size_t)t * PW + 2048 + lane * 16;
            const u32x4 o0 = oo[u][0], o1 = oo[u][1], r0 = rr[u][0], r1 = rr[u][1];
            float ov[16], rv[16];
            ov[0] = bflo(o0.x); ov[1] = bfhi(o0.x); ov[2] = bflo(o0.y); ov[3] = bfhi(o0.y); ov[4] = bflo(o0.z); ov[5] = bfhi(o0.z); ov[6] = bflo(o0.w); ov[7] = bfhi(o0.w);
            ov[8] = bflo(o1.x); ov[9] = bfhi(o1.x); ov[10] = bflo(o1.y); ov[11] = bfhi(o1.y); ov[12] = bflo(o1.z); ov[13] = bfhi(o1.z); ov[14] = bflo(o1.w); ov[15] = bfhi(o1.w);
            rv[0] = bflo(r0.x); rv[1] = bfhi(r0.x); rv[2] = bflo(r0.y); rv[3] = bfhi(r0.y); rv[4] = bflo(r0.z); rv[5] = bfhi(r0.z); rv[6] = bflo(r0.w); rv[7] = bfhi(r0.w);
            rv[8] = bflo(r1.x); rv[9] = bfhi(r1.x); rv[10] = bflo(r1.y); rv[11] = bfhi(r1.y); rv[12] = bflo(r1.z); rv[13] = bfhi(r1.z); rv[14] = bflo(r1.w); rv[15] = bfhi(r1.w);
            float s = 0.f;
#pragma unroll
            for (int i = 0; i < 16; ++i) s += ov[i] * ov[i];
            s += __shfl_xor(s, 8); s += __shfl_xor(s, 4); s += __shfl_xor(s, 2); s += __shfl_xor(s, 1);
            const float rn = rsqrtf(s * (1.f / 256.f) + 1e-6f);
            float out[16];
#pragma unroll
            for (int i = 0; i < 16; ++i) { const float r = rv[i]; out[i] = ov[i] * rn * g4[i >> 2][i & 3] * (r * sigmoidf_(r)); }
            *(u32x4*)rp = (u32x4){cvt_pk_bf16(out[0], out[1]), cvt_pk_bf16(out[2], out[3]), cvt_pk_bf16(out[4], out[5]), cvt_pk_bf16(out[6], out[7])};
            *(u32x4*)(rp + 8) = (u32x4){cvt_pk_bf16(out[8], out[9]), cvt_pk_bf16(out[10], out[11]), cvt_pk_bf16(out[12], out[13]), cvt_pk_bf16(out[14], out[15])}; }
    }
}

template <int HW, int RL>
__device__ __forceinline__ void pool_run(const bf16_t* P, bf16_t* PO, int t0, int c8) {
    constexpr int NR = RL + 2 * HW - 1;
    const int pos0 = t0 & (SEQL - 1);
    const bf16_t* base = P + (size_t)t0 * PW + 3072 + c8 * 8;
    u32x4 v[NR];
#pragma unroll
    for (int k = 0; k < NR; ++k) { const int off = k - HW, tt = pos0 + off;
        v[k] = (tt >= 0 && tt < SEQL) ? *(const u32x4*)(base + (long)off * PW) : (u32x4){0u, 0u, 0u, 0u}; }
    float w[8];
#pragma unroll
    for (int i = 0; i < 8; ++i) w[i] = 0.f;
#pragma unroll
    for (int k = 0; k < 2 * HW; ++k) { w[0] += bflo(v[k].x); w[1] += bfhi(v[k].x); w[2] += bflo(v[k].y); w[3] += bfhi(v[k].y); w[4] += bflo(v[k].z); w[5] += bfhi(v[k].z); w[6] += bflo(v[k].w); w[7] += bfhi(v[k].w); }
#pragma unroll
    for (int i = 0; i < RL; ++i) {
        if (i > 0) { const u32x4 a = v[i + 2 * HW - 1], s = v[i - 1];
            w[0] += bflo(a.x) - bflo(s.x); w[1] += bfhi(a.x) - bfhi(s.x); w[2] += bflo(a.y) - bflo(s.y); w[3] += bfhi(a.y) - bfhi(s.y);
            w[4] += bflo(a.z) - bflo(s.z); w[5] += bfhi(a.z) - bfhi(s.z); w[6] += bflo(a.w) - bflo(s.w); w[7] += bfhi(a.w) - bfhi(s.w); }
        const int pos = pos0 + i, lo = pos - HW < 0 ? 0 : pos - HW, hi = pos + HW > SEQL ? SEQL : pos + HW;
        const float ic = 1.f / (float)(hi - lo);
        const u32x4 c = v[HW + i];
        *(u32x4*)(PO + (size_t)(t0 + i) * 512 + c8 * 8) = (u32x4){cvt_pk_bf16(w[0] * ic - bflo(c.x), w[1] * ic - bfhi(c.x)), cvt_pk_bf16(w[2] * ic - bflo(c.y), w[3] * ic - bfhi(c.y)),
                                                                 cvt_pk_bf16(w[4] * ic - bflo(c.z), w[5] * ic - bfhi(c.z)), cvt_pk_bf16(w[6] * ic - bflo(c.w), w[7] * ic - bfhi(c.w))};
    }
}
__device__ __forceinline__ void phase_pool(const Params& p) {
    const bf16_t* P = (const bf16_t*)(p.ws + OFF_PROJ); bf16_t* PO = (bf16_t*)(p.ws + OFF_E);
    int tid = threadIdx.x; asm volatile("" : "+v"(tid));
    const int wid = __builtin_amdgcn_readfirstlane(tid >> 6), lane = tid & 63;
    for (int wi = blockIdx.x * 8 + wid; wi < T_TOK / 16; wi += gridDim.x * 8) {
        const int grp = wi & 3, t0 = (wi >> 2) * 64 + (lane >> 4) * 16, c8 = grp * 16 + (lane & 15);
        if (grp == 0) pool_run<1, 16>(P, PO, t0, c8); else if (grp == 1) pool_run<2, 16>(P, PO, t0, c8); else if (grp == 2) pool_run<4, 16>(P, PO, t0, c8); else { pool_run<8, 8>(P, PO, t0, c8); pool_run<8, 8>(P, PO, t0 + 8, c8); }
    }
}

__device__ __forceinline__ void phase_final(const Params& p) {
    int tid = threadIdx.x; asm volatile("" : "+v"(tid));
    const int wid = tid >> 6, lane = tid & 63;
    const float* ssq = (const float*)(p.ws + OFF_SSQ); const bf16_t* xb = (const bf16_t*)(p.ws + OFF_XB);
    f32x4 g4[4];
#pragma unroll
    for (int i = 0; i < 4; ++i) g4[i] = *(const f32x4*)(p.norm_final + lane * 16 + 4 * i);
    for (int row0 = bid_() * 8 + wid; row0 < T_TOK; row0 += nblk_() * 32) {
        u32x4 v[4][2]; float rs[4]; bool ok[4];
#pragma unroll
        for (int u = 0; u < 4; ++u) { const int row = row0 + u * nblk_() * 8; ok[u] = row < T_TOK;
            if (ok[u]) { rs[u] = rowscale(ssq, row); const bf16_t* xp = xb + (size_t)row * 1024 + lane * 16; v[u][0] = *(const u32x4*)xp; v[u][1] = *(const u32x4*)(xp + 8); } }
#pragma unroll
        for (int u = 0; u < 4; ++u) if (ok[u]) { const int row = row0 + u * nblk_() * 8; float* op = p.xf + (size_t)row * 1024 + lane * 16; const float r = rs[u];
            *(f32x4*)(op) = (f32x4){bflo(v[u][0].x), bfhi(v[u][0].x), bflo(v[u][0].y), bfhi(v[u][0].y)} * r * g4[0];
            *(f32x4*)(op + 4) = (f32x4){bflo(v[u][0].z), bfhi(v[u][0].z), bflo(v[u][0].w), bfhi(v[u][0].w)} * r * g4[1];
            *(f32x4*)(op + 8) = (f32x4){bflo(v[u][1].x), bfhi(v[u][1].x), bflo(v[u][1].y), bfhi(v[u][1].y)} * r * g4[2];
            *(f32x4*)(op + 12) = (f32x4){bflo(v[u][1].z), bfhi(v[u][1].z), bflo(v[u][1].w), bfhi(v[u][1].w)} * r * g4[3]; }
    }
}

__device__ __forceinline__ void phase_rs(const Params& p) {
    int tid = threadIdx.x; asm volatile("" : "+v"(tid));
    const float* ssq = (const float*)(p.ws + OFF_SSQ); float* rs = (float*)(p.ws + OFF_RS);
    for (int row = bid_() * 512 + tid; row < T_TOK; row += nblk_() * 512) rs[row] = rowscale(ssq, row);
}
__device__ __forceinline__ void grid_barrier(unsigned* bar, unsigned k) {
    asm volatile("s_waitcnt vmcnt(0)" ::: "memory");
    __syncthreads();
    if (threadIdx.x == 0) {
        const unsigned nb = nblk_(), g = bid_() >> 4, ng = (nb + 15u) >> 4, gsz = (nb - 16u * g) < 16u ? (nb - 16u * g) : 16u;
        __builtin_amdgcn_fence(__ATOMIC_RELEASE, "agent");
        asm volatile("s_waitcnt vmcnt(0)" ::: "memory");
        const unsigned old = __hip_atomic_fetch_add(bar + 64 * g, 1u, __ATOMIC_RELAXED, __HIP_MEMORY_SCOPE_AGENT);
        if (old == k * gsz - 1u) {
            const unsigned old2 = __hip_atomic_fetch_add(bar + 64 * 32, 1u, __ATOMIC_RELAXED, __HIP_MEMORY_SCOPE_AGENT);
            if (old2 == k * ng - 1u) for (unsigned j = 0; j < ng; ++j) __hip_atomic_store(bar + 64 * (64 + j), k, __ATOMIC_RELAXED, __HIP_MEMORY_SCOPE_AGENT);
        }
        while (__hip_atomic_load(bar + 64 * (64 + g), __ATOMIC_RELAXED, __HIP_MEMORY_SCOPE_AGENT) < k) __builtin_amdgcn_s_sleep(2);
        __builtin_amdgcn_fence(__ATOMIC_ACQUIRE, "agent");
        asm volatile("s_waitcnt vmcnt(0)" ::: "memory");
    }
    __syncthreads();
}
__global__ void __launch_bounds__(512, 2) mega(const Params p_arg) {
    extern __shared__ __attribute__((aligned(16))) unsigned char shm[];
    LAS unsigned char* lds = (LAS unsigned char*)shm;
    typedef const Params __attribute__((address_space(4))) * KArgPtr;
    const int phase_lo = p_arg.phase_lo, phase_hi = p_arg.phase_hi;
    pg8::StaticOrder S;
    unsigned bar_k = 0;
    for (int ph = phase_lo; ph < phase_hi; ++ph) {
        KArgPtr kp = (KArgPtr)__builtin_amdgcn_kernarg_segment_ptr(); asm volatile("" : "+s"(kp));
        const Params& p = *(const Params*)kp;
        bf16_t* xb = (bf16_t*)(p.ws + OFF_XB); bf16_t* proj = (bf16_t*)(p.ws + OFF_PROJ); float* ssq = (float*)(p.ws + OFF_SSQ);
        if (ph > phase_lo) {
            if (phase_hi > 1000) cg::this_grid().sync();
            grid_barrier((unsigned*)(p.ws + OFF_BAR), ++bar_k);
        }
        if (ph == 0) { phase_prep(lds, p); continue; }
        if (ph == 19) { phase_final(p); continue; }
        const int layer = (ph - 1) / 9, sub = (ph - 1) % 9;
        const char* W = p.ws + OFF_W + (size_t)layer * SZ_WLAYER;
        switch (sub) {
        case 0: { if (layer > 0) { phase_rs(p); grid_barrier((unsigned*)(p.ws + OFF_BAR), ++bar_k); }
                  pg8::Gemm g{xb, (const bf16_t*)(W + WO_A), T_TOK, NA, 1024, 1024}; S.init(g.M, g.N, nblk_(), bid_());
                  EpiA e{(const float*)(p.ws + OFF_RS), proj, (bf16_t*)(p.ws + OFF_LR), ssq}; pg8::gemm_phase(lds, g, S, e); } break;
        case 1: gla_pass<true>(lds, p, layer); break;
        case 2: phase_combine(p); break;
        case 3: gla_light(lds, p, layer); break;
        case 4: { pg8::Gemm g{xb, (const bf16_t*)(W + WO_B), T_TOK, NB, 1024, 1024}; S.init(g.M, g.N, nblk_(), bid_());
                  EpiGate e{(const float*)(p.ws + OFF_RS), proj, ssq}; pg8::gemm_phase(lds, g, S, e);
                  phase_pool(p); } break;
        case 5: { { pg8::Gemm g{(const bf16_t*)(p.ws + OFF_E), (const bf16_t*)(W + WO_POOL), T_TOK, 1024, 128, 512}; S.init(g.M, g.N, nblk_(), bid_());
                    EpiPool e{proj, p.pool_scale + layer * 1024}; pg8::gemm_phase<EpiPool, 256>(lds, g, S, e); }
                  { pg8::Gemm g{proj + 2048, (const bf16_t*)(W + WO_GA), T_TOK, 1024, 1024, PW}; S.init(g.M, g.N, nblk_(), bid_());
                    EpiMerge e{proj}; pg8::gemm_phase(lds, g, S, e); } } break;
        case 6: { pg8::Gemm g{proj, (const bf16_t*)(W + WO_OUT), T_TOK, 1024, 1024, PW}; S.init(g.M, g.N, nblk_(), bid_());
                  EpiRes e{xb, ssq}; pg8::gemm_phase(lds, g, S, e); } break;
        case 7: { phase_rs(p); grid_barrier((unsigned*)(p.ws + OFF_BAR), ++bar_k);
                  pg8::Gemm g{xb, (const bf16_t*)(W + WO_F1), T_TOK, 2 * DFF, 1024, 1024}; S.init(g.M, g.N, nblk_(), bid_());
                  EpiFfn1 e{(const float*)(p.ws + OFF_RS), proj, ssq}; pg8::gemm_phase(lds, g, S, e); } break;
        case 8: { pg8::Gemm g{proj, (const bf16_t*)(W + WO_F2), T_TOK, 1024, DFF, DFF}; S.init(g.M, g.N, nblk_(), bid_());
                  if (layer == 1) { EpiResFinal e{p.ws, lds + pg8::STAGE_BYTES + 2048}; pg8::gemm_phase(lds, g, S, e); }
                  else { EpiRes e{xb, ssq}; pg8::gemm_phase(lds, g, S, e); } } break;
        }
    }
}

extern "C" void kernel_launch(void* const* d_in, const int* in_sizes, int n_in, void* d_out, int out_size, void* d_ws, size_t ws_size, hipStream_t stream) {
    (void)in_sizes; (void)n_in; (void)out_size;
    if (ws_size < WS_NEEDED) return;
    Params p{};
    p.x_in = (const float*)d_in[0]; p.norm_mix = (const float*)d_in[1]; p.w_in = (const float*)d_in[2]; p.wdu_f = (const float*)d_in[3]; p.bd_f = (const float*)d_in[4];
    p.wdu_b = (const float*)d_in[5]; p.bd_b = (const float*)d_in[6]; p.gla_norm = (const float*)d_in[7]; p.w_ga = (const float*)d_in[8]; p.w_pool = (const float*)d_in[9];
    p.pool_scale = (const float*)d_in[10]; p.w_out = (const float*)d_in[11]; p.norm_ffn = (const float*)d_in[12]; p.w_f1 = (const float*)d_in[13]; p.w_f2 = (const float*)d_in[14];
    p.norm_final = (const float*)d_in[15];
    p.xf = (float*)d_out; p.ws = (char*)d_ws;
    hipFuncSetAttribute((const void*)mega, hipFuncAttributeMaxDynamicSharedMemorySize, LDS_BYTES);
    int dev = 0, cus = 0, per = 0;
    hipGetDevice(&dev); hipDeviceGetAttribute(&cus, hipDeviceAttributeMultiprocessorCount, dev);
    hipOccupancyMaxActiveBlocksPerMultiprocessor(&per, mega, 512, LDS_BYTES);
    int grid = cus * (per > 0 ? per : 1); if (grid > 256) grid = 256; if (grid < 1) grid = 1;
#if MK_SINGLE_LAUNCH
    p.phase_lo = 0; p.phase_hi = 19;
    hipMemsetAsync((char*)d_ws + OFF_BAR, 0, 128 * 256, stream);
    void* args[] = {(void*)&p};
    hipLaunchCooperativeKernel((const void*)mega, dim3(grid), dim3(512), args, LDS_BYTES, stream);
#else
    for (int ph = 0; ph < 20; ++ph) { p.phase_lo = ph; p.phase_hi = ph + 1; hipLaunchKernelGGL(mega, dim3(grid), dim3(512), LDS_BYTES, stream, p); }
#endif
}
```

```cpp
#include <hip/hip_runtime.h>
#include <hip/hip_cooperative_groups.h>
namespace cg = cooperative_groups;

#ifndef MK_SINGLE_LAUNCH
#define MK_SINGLE_LAUNCH 1
#endif

#define LAS __attribute__((address_space(3)))
typedef unsigned short bf16_t;
typedef short bf16x8 __attribute__((ext_vector_type(8)));
typedef short s16x4 __attribute__((ext_vector_type(4)));
typedef float f32x4 __attribute__((ext_vector_type(4)));
typedef unsigned u32x4 __attribute__((ext_vector_type(4)));
typedef unsigned u32x2 __attribute__((ext_vector_type(2)));

constexpr int T_TOK = 32768, SEQL = 16384, DM = 1024, PW = 3584, NA = 3840, NB = 2048, DFF = 2816, INW = 5664;
constexpr int LDS_BYTES = 155136;

constexpr size_t SZ_WA = (size_t)NA * 1024 * 2, SZ_WB = (size_t)NB * 1024 * 2, SZ_WGA = (size_t)1024 * 1024 * 2, SZ_WPOOL = (size_t)1024 * 512 * 2,
                 SZ_WOUT = (size_t)1024 * 1024 * 2, SZ_WF1 = (size_t)2 * DFF * 1024 * 2, SZ_WF2 = (size_t)1024 * DFF * 2;
constexpr size_t WO_A = 0, WO_B = WO_A + SZ_WA, WO_GA = WO_B + SZ_WB, WO_POOL = WO_GA + SZ_WGA, WO_OUT = WO_POOL + SZ_WPOOL, WO_F1 = WO_OUT + SZ_WOUT,
                 WO_F2 = WO_F1 + SZ_WF1, SZ_WLAYER = WO_F2 + SZ_WF2;
constexpr size_t OFF_W = 0;
constexpr size_t OFF_XB = OFF_W + 2 * SZ_WLAYER;
constexpr size_t OFF_PROJ = OFF_XB + (size_t)T_TOK * 1024 * 2;
constexpr size_t OFF_LR = OFF_PROJ + (size_t)T_TOK * PW * 2;
constexpr size_t OFF_E = OFF_LR + (size_t)T_TOK * 32 * 4;
constexpr size_t OFF_DLOG = OFF_E + (size_t)16 * 32 * 32768 * 4;
constexpr size_t OFF_O = OFF_DLOG + (size_t)16 * 32 * 128 * 4;
constexpr size_t OFF_SSQ = OFF_O + (size_t)T_TOK * 1024 * 2;
constexpr size_t OFF_BAR = OFF_SSQ + (size_t)T_TOK * 16 * 4;
constexpr size_t OFF_RS = OFF_BAR + 128 * 256;
constexpr size_t OFF_XCH = OFF_RS + (size_t)T_TOK * 4;
constexpr size_t WS_NEEDED = OFF_XCH + (size_t)128 * 4 * 256 * 4;

struct Params {
    const float* x_in; const float* norm_mix; const float* w_in; const float* wdu_f; const float* bd_f; const float* wdu_b; const float* bd_b;
    const float* gla_norm; const float* w_ga; const float* w_pool; const float* pool_scale; const float* w_out; const float* norm_ffn;
    const float* w_f1; const float* w_f2; const float* norm_final;
    float* xf; char* ws;
    int phase_lo, phase_hi;
};

typedef float f32x2 __attribute__((ext_vector_type(2)));
typedef __bf16 bf16x2_t __attribute__((ext_vector_type(2)));
__device__ __forceinline__ int bid_() { int v = __builtin_amdgcn_readfirstlane((int)blockIdx.x); asm volatile("" : "+s"(v)); return v; }
__device__ __forceinline__ int nblk_() { int v = __builtin_amdgcn_readfirstlane((int)gridDim.x); asm volatile("" : "+s"(v)); return v; }
__device__ __forceinline__ unsigned cvt_pk_bf16(float lo, float hi) { const f32x2 v = {lo, hi}; const bf16x2_t b = __builtin_convertvector(v, bf16x2_t); return __builtin_bit_cast(unsigned, b); }
__device__ __forceinline__ float bf2f(unsigned short b) { return __uint_as_float(((unsigned)b) << 16); }
__device__ __forceinline__ float bflo(unsigned w) { return __uint_as_float(w << 16); }
__device__ __forceinline__ float bfhi(unsigned w) { return __uint_as_float(w & 0xffff0000u); }
__device__ __forceinline__ unsigned short f2bf(float f) { return (unsigned short)(cvt_pk_bf16(f, 0.f) & 0xffffu); }
__device__ __forceinline__ float sigmoidf_(float x) { return __builtin_amdgcn_rcpf(1.f + __expf(-x)); }

namespace pg8 {
constexpr int BM = 256, BK = 64, HALF = 128, HTB = HALF * BK * 2, STAGE_BYTES = 8 * HTB, NXCD = 8, WGM = 8;
__device__ __forceinline__ int lds_byte(int r, int c) { const int st = (r >> 4) * 2 + (c >> 5), rr = r & 15, cc = c & 31, ob = rr * 64 + cc * 2; return st * 1024 + (ob ^ (((ob >> 9) & 1) << 5)); }
__device__ __forceinline__ void stage_rc(int b, int& R, int& C) { const int st = b / 1024, sb = b % 1024, swz = sb ^ (((sb >> 9) & 1) << 5); R = (st >> 1) * 16 + swz / 64; C = (st & 1) * 32 + (swz % 64) / 2; }
__device__ __forceinline__ int perm32(int rho) { const int n = rho >> 4, i = rho & 15; return 8 * (i >> 2) + 4 * n + (i & 3); }
struct Unit { int pm, pn; };
struct Gemm { const bf16_t* A; const bf16_t* Bt; int M, N, K, lda; };
struct StaticOrder {
    int nM, nN, nwg, G, c;
    __device__ void init(int M, int N, int G_, int c_) { nM = M / BM; nN = N / BM; nwg = nM * nN; G = G_; c = c_; }
    __device__ bool next(int i, Unit& u) const {
        const long L = (long)i * G + c; if (L >= nwg) return false;
        int wgid = (int)L; { const int q = nwg / NXCD, r = nwg % NXCD, xcd = wgid % NXCD, off = wgid / NXCD; wgid = (xcd < r ? xcd * (q + 1) : r * (q + 1) + (xcd - r) * q) + off; }
        const int nig = WGM * nN, gid = wgid / nig, fm = gid * WGM, gsz = (nM - fm) < WGM ? (nM - fm) : WGM;
        u.pm = fm + ((wgid % nig) % gsz); u.pn = (wgid % nig) / gsz; return true;
    }
};

template <class Epi, int APN = 0, bool ALIGN_EPI = true, bool SP2 = true>
__device__ __forceinline__ void gemm_phase(LAS unsigned char* lds, const Gemm g, const StaticOrder& S, const Epi& E) {
    int tid = threadIdx.x; asm volatile("" : "+v"(tid));
    const int wid = __builtin_amdgcn_readfirstlane(tid >> 6), lane = tid & 63, wr = wid >> 2, wc = wid & 3, fr = lane & 15, fq = lane >> 4;
    int K = g.K; asm volatile("" : "+s"(K));
    const int nt = K / BK;
    unsigned voffA[2], voffB[2];
#pragma unroll
    for (int i = 0; i < 2; ++i) { int R, C; stage_rc(tid * 16 + i * 8192, R, C); const int Rb = Epi::PERM ? ((R & ~31) + perm32(R & 31)) : R;
        voffA[i] = (unsigned)(R * g.lda + C) * 2u; voffB[i] = (unsigned)(Rb * K + C) * 2u; }
    const size_t kstep = (size_t)(BK * 2);
    const size_t hstepA = (size_t)HALF * g.lda * 2, hstepB = (size_t)HALF * K * 2;
    const size_t tstepA = 2 * hstepA, tstepB = 2 * hstepB;
    const unsigned ldsw = (unsigned)wid * 1024u;
    const int aoff = lds_byte(wr * 64 + fr, fq * 8), boff = lds_byte(wc * 32 + fr, fq * 8);
#define PG8_SA(b, h) (((b) * 2 + (h)) * HTB)
#define PG8_SB(b, h) ((4 + (b) * 2 + (h)) * HTB)
#define PG8_STAGE(bufoff, gbase, voff) do { _Pragma("unroll") for (int _i = 0; _i < 2; ++_i) \
        __builtin_amdgcn_global_load_lds((const unsigned*)((const char*)(gbase) + (voff)[_i]), (LAS unsigned*)(lds + (bufoff) + ldsw + _i * 8192), 16, 0, 0); } while (0)
#define PG8_LDA(dst, b, h) do { _Pragma("unroll") for (int m = 0; m < 4; ++m) _Pragma("unroll") for (int k = 0; k < 2; ++k) dst[m][k] = *(const LAS bf16x8*)(lds + PG8_SA(b, h) + aoff + m * 2048 + k * 1024); } while (0)
#define PG8_LDB(dst, b, h) do { _Pragma("unroll") for (int n = 0; n < 2; ++n) _Pragma("unroll") for (int k = 0; k < 2; ++k) dst[n][k] = *(const LAS bf16x8*)(lds + PG8_SB(b, h) + boff + n * 2048 + k * 1024); } while (0)
#define PG8_MMA(ai, bj, At, Bt) do { __builtin_amdgcn_s_setprio(1); _Pragma("unroll") for (int m = 0; m < 4; ++m) _Pragma("unroll") for (int n = 0; n < 2; ++n) _Pragma("unroll") for (int k = 0; k < 2; ++k) \
        acc[ai][bj][m][n] = __builtin_amdgcn_mfma_f32_16x16x32_bf16(Bt[n][k], At[m][k], acc[ai][bj][m][n], 0, 0, 0); __builtin_amdgcn_s_setprio(0); } while (0)
#define PG8_WAIT_V(n) asm volatile("s_waitcnt vmcnt(" #n ")" ::: "memory")
#define PG8_WAIT_L(n) asm volatile("s_waitcnt lgkmcnt(" #n ")" ::: "memory")
#define PG8_BAR __builtin_amdgcn_s_barrier()
#define PG8_SCHED __builtin_amdgcn_sched_barrier(0)
    Unit cur, nxt; int ui = 0;
    if (!S.next(0, cur)) return;
    f32x4 acc[2][2][4][2];
#pragma unroll
    for (int a = 0; a < 2; ++a)
#pragma unroll
        for (int b = 0; b < 2; ++b)
#pragma unroll
            for (int m = 0; m < 4; ++m)
#pragma unroll
                for (int n = 0; n < 2; ++n) acc[a][b][m][n] = (f32x4){0.f, 0.f, 0.f, 0.f};
    bf16x8 At[4][2], B0[2][2], B1[2][2];
    const char* cA = (const char*)g.A + (size_t)cur.pm * tstepA + (size_t)cur.pn * APN; const char* cB = (const char*)g.Bt + (size_t)cur.pn * tstepB;
    if constexpr (SP2) {
        PG8_STAGE(PG8_SB(0, 0), cB, voffB); PG8_STAGE(PG8_SB(0, 1), cB + hstepB, voffB); PG8_STAGE(PG8_SA(0, 0), cA, voffA); PG8_STAGE(PG8_SA(0, 1), cA + hstepA, voffA);
        if (wr == 1) PG8_BAR;
        PG8_WAIT_V(2); PG8_BAR;
        PG8_STAGE(PG8_SB(1, 0), cB + kstep, voffB); PG8_STAGE(PG8_SA(1, 0), cA + kstep, voffA); PG8_STAGE(PG8_SB(1, 1), cB + hstepB + kstep, voffB);
        PG8_WAIT_V(6); PG8_BAR;
    } else {
        PG8_STAGE(PG8_SB(0, 0), cB, voffB); PG8_STAGE(PG8_SA(0, 0), cA, voffA); PG8_STAGE(PG8_SB(0, 1), cB + hstepB, voffB); PG8_STAGE(PG8_SA(0, 1), cA + hstepA, voffA);
        if (wr == 1) PG8_BAR;
        PG8_WAIT_V(4); PG8_BAR;
        PG8_STAGE(PG8_SB(1, 0), cB + kstep, voffB); PG8_STAGE(PG8_SA(1, 0), cA + kstep, voffA); PG8_STAGE(PG8_SB(1, 1), cB + hstepB + kstep, voffB);
        PG8_WAIT_V(6); PG8_BAR;
    }
    for (;;) {
        const bool has_next = S.next(ui + 1, nxt);
        const unsigned rsoff = (unsigned)STAGE_BYTES + (unsigned)(ui & 1) * 1024u;
        if constexpr (Epi::NEEDS_RS) { if (wid < 4) __builtin_amdgcn_global_load_lds((const unsigned*)(E.rsv + cur.pm * 256 + wid * 64 + lane), (LAS unsigned*)(lds + rsoff + wid * 256), 4, 0, 0); }
        const char* nA = has_next ? (const char*)g.A + (size_t)nxt.pm * tstepA + (size_t)nxt.pn * APN : cA; const char* nB = has_next ? (const char*)g.Bt + (size_t)nxt.pn * tstepB : cB;
        for (int t = 0; t < nt; t += 2) {
            const bool last = (t == nt - 2);
            const char* a1 = cA + (size_t)(t + 1) * kstep;
            const char* a2 = last ? nA : cA + (size_t)(t + 2) * kstep; const char* b2 = last ? nB : cB + (size_t)(t + 2) * kstep;
            const char* a3 = a2 + kstep; const char* b3 = b2 + kstep;
            if constexpr (SP2) {
            PG8_LDB(B0, 0, 0); PG8_LDB(B1, 0, 1); PG8_SCHED; PG8_LDA(At, 0, 0); PG8_STAGE(PG8_SA(1, 1), a1 + hstepA, voffA);
            PG8_WAIT_V(8); PG8_WAIT_L(0); PG8_BAR; PG8_MMA(0, 0, At, B0); PG8_MMA(0, 1, At, B1); PG8_BAR; PG8_SCHED;
            PG8_LDA(At, 0, 1); PG8_STAGE(PG8_SB(0, 0), b2, voffB); PG8_STAGE(PG8_SB(0, 1), b2 + hstepB, voffB); PG8_STAGE(PG8_SA(0, 0), a2, voffA);
            PG8_WAIT_V(8); PG8_WAIT_L(0); PG8_BAR; PG8_MMA(1, 0, At, B0); PG8_MMA(1, 1, At, B1); PG8_BAR; PG8_SCHED;
            PG8_LDB(B0, 1, 0); PG8_LDB(B1, 1, 1); PG8_SCHED; PG8_LDA(At, 1, 0); PG8_STAGE(PG8_SA(0, 1), a2 + hstepA, voffA);
            PG8_WAIT_V(8); PG8_WAIT_L(0); PG8_BAR; PG8_MMA(0, 0, At, B0); PG8_MMA(0, 1, At, B1); PG8_BAR; PG8_SCHED;
            PG8_LDA(At, 1, 1); PG8_STAGE(PG8_SB(1, 0), b3, voffB); PG8_STAGE(PG8_SB(1, 1), b3 + hstepB, voffB); PG8_STAGE(PG8_SA(1, 0), a3, voffA);
            PG8_WAIT_V(8); PG8_WAIT_L(0); PG8_BAR; PG8_MMA(1, 0, At, B0); PG8_MMA(1, 1, At, B1); PG8_BAR; PG8_SCHED;
            } else {
            PG8_LDB(B0, 0, 0); PG8_SCHED; PG8_LDA(At, 0, 0); PG8_STAGE(PG8_SA(1, 1), a1 + hstepA, voffA);
            PG8_WAIT_L(8); PG8_BAR; PG8_WAIT_L(0); PG8_MMA(0, 0, At, B0); PG8_BAR; PG8_SCHED;
            PG8_LDB(B1, 0, 1); PG8_STAGE(PG8_SB(0, 0), b2, voffB);
            PG8_BAR; PG8_WAIT_L(0); PG8_MMA(0, 1, At, B1); PG8_BAR;
            PG8_LDA(At, 0, 1); PG8_STAGE(PG8_SA(0, 0), a2, voffA);
            PG8_BAR; PG8_WAIT_L(0); PG8_MMA(1, 0, At, B0); PG8_BAR; PG8_SCHED;
            PG8_STAGE(PG8_SB(0, 1), b2 + hstepB, voffB);
            PG8_WAIT_V(6); PG8_BAR; PG8_MMA(1, 1, At, B1); PG8_BAR;
            PG8_LDB(B0, 1, 0); PG8_SCHED; PG8_LDA(At, 1, 0); PG8_STAGE(PG8_SA(0, 1), a2 + hstepA, voffA);
            PG8_WAIT_L(8); PG8_BAR; PG8_WAIT_L(0); PG8_MMA(0, 0, At, B0); PG8_BAR; PG8_SCHED;
            PG8_LDB(B1, 1, 1); PG8_STAGE(PG8_SB(1, 0), b3, voffB);
            PG8_BAR; PG8_WAIT_L(0); PG8_MMA(0, 1, At, B1); PG8_BAR;
            PG8_LDA(At, 1, 1); PG8_STAGE(PG8_SA(1, 0), a3, voffA);
            PG8_BAR; PG8_WAIT_L(0); PG8_MMA(1, 0, At, B0); PG8_BAR; PG8_SCHED;
            PG8_STAGE(PG8_SB(1, 1), b3 + hstepB, voffB);
            PG8_WAIT_V(6); PG8_BAR; PG8_MMA(1, 1, At, B1); PG8_BAR;
            }
        }
        if constexpr (ALIGN_EPI) { if (wr == 0) PG8_BAR; }
        E(acc, cur, wr, wc, fr, fq, (const LAS float*)(lds + rsoff));
        if (!has_next) break;
#pragma unroll
        for (int a = 0; a < 2; ++a)
#pragma unroll
            for (int b = 0; b < 2; ++b)
#pragma unroll
                for (int m = 0; m < 4; ++m)
#pragma unroll
                    for (int n = 0; n < 2; ++n) acc[a][b][m][n] = (f32x4){0.f, 0.f, 0.f, 0.f};
        cur = nxt; cA = nA; cB = nB; ++ui;
        if constexpr (ALIGN_EPI) { if (wr == 1) PG8_BAR; }
    }
    PG8_WAIT_V(0);
    if constexpr (!ALIGN_EPI) { if (wr == 0) PG8_BAR; }
    PG8_BAR;
#undef PG8_SA
#undef PG8_SB
#undef PG8_STAGE
#undef PG8_LDA
#undef PG8_LDB
#undef PG8_MMA
#undef PG8_WAIT_V
#undef PG8_WAIT_L
#undef PG8_BAR
#undef PG8_SCHED
}
}
using pg8::Unit;

__device__ __forceinline__ float rowscale(const float* ssq, int row) {
    const f32x4* s = (const f32x4*)(ssq + (size_t)row * 16);
    const f32x4 a = s[0], b = s[1], c = s[2], d = s[3];
    const float t = ((a[0] + a[1]) + (a[2] + a[3])) + ((b[0] + b[1]) + (b[2] + b[3])) + ((c[0] + c[1]) + (c[2] + c[3])) + ((d[0] + d[1]) + (d[2] + d[3]));
    return rsqrtf(t * (1.f / 1024.f) + 1e-6f);
}
__device__ __forceinline__ u32x4 pack8(const f32x4 v0, const f32x4 v1) {
    u32x4 w; w.x = cvt_pk_bf16(v0[0], v0[1]); w.y = cvt_pk_bf16(v0[2], v0[3]); w.z = cvt_pk_bf16(v1[0], v1[1]); w.w = cvt_pk_bf16(v1[2], v1[3]); return w;
}

struct EpiA {
    static constexpr bool PERM = true;
    static constexpr bool NEEDS_RS = true; const float* rsv;
    bf16_t* P; bf16_t* lr; const float* ssq;
    __device__ __forceinline__ void operator()(const f32x4 (&acc)[2][2][4][2], const Unit& u, int wr, int wc, int fr, int fq, const LAS float* rsl) const {
        const int row0 = u.pm * 256 + wr * 64 + fr;
#pragma unroll
        for (int ai = 0; ai < 2; ++ai)
#pragma unroll
            for (int m = 0; m < 4; ++m) {
                const int row = row0 + ai * 128 + m * 16; const float rs = rsl[ai * 128 + wr * 64 + m * 16 + fr];
                if (u.pn < 14) {
#pragma unroll
                    for (int bj = 0; bj < 2; ++bj) {
                        const f32x4 v0 = acc[ai][bj][m][0] * rs, v1 = acc[ai][bj][m][1] * rs;
                        *(u32x4*)(P + (size_t)row * PW + u.pn * 256 + bj * 128 + wc * 32 + 8 * fq) = pack8(v0, v1);
                    }
                } else if (wc == 0) {
                    const f32x4 v0 = acc[ai][0][m][0] * rs, v1 = acc[ai][0][m][1] * rs;
                    const u32x4 hi = pack8(v0, v1);
                    const f32x4 d0 = (f32x4){v0[0] - bflo(hi.x), v0[1] - bfhi(hi.x), v0[2] - bflo(hi.y), v0[3] - bfhi(hi.y)};
                    const f32x4 d1 = (f32x4){v1[0] - bflo(hi.z), v1[1] - bfhi(hi.z), v1[2] - bflo(hi.w), v1[3] - bfhi(hi.w)};
                    bf16_t* lp = lr + (size_t)row * 64 + (fq >> 1) * 32 + (fq & 1) * 8;
                    *(u32x4*)lp = hi; *(u32x4*)(lp + 16) = pack8(d0, d1);
                }
            }
    }
};
struct EpiGate {
    static constexpr bool PERM = true;
    static constexpr bool NEEDS_RS = true; const float* rsv;
    bf16_t* P; const float* ssq;
    __device__ __forceinline__ void operator()(const f32x4 (&acc)[2][2][4][2], const Unit& u, int wr, int wc, int fr, int fq, const LAS float* rsl) const {
        const int row0 = u.pm * 256 + wr * 64 + fr;
#pragma unroll
        for (int ai = 0; ai < 2; ++ai)
#pragma unroll
            for (int m = 0; m < 4; ++m) {
                const int row = row0 + ai * 128 + m * 16; const float rs = rsl[ai * 128 + wr * 64 + m * 16 + fr];
#pragma unroll
                for (int bj = 0; bj < 2; ++bj) {
                    f32x4 v0 = acc[ai][bj][m][0] * rs, v1 = acc[ai][bj][m][1] * rs;
#pragma unroll
                    for (int j = 0; j < 4; ++j) { v0[j] = sigmoidf_(v0[j]); v1[j] = sigmoidf_(v1[j]); }
                    *(u32x4*)(P + (size_t)row * PW + u.pn * 256 + bj * 128 + wc * 32 + 8 * fq) = pack8(v0, v1);
                }
                asm volatile("" ::: "memory");
            }
    }
};
struct EpiPool {
    static constexpr bool PERM = true;
    static constexpr bool NEEDS_RS = false;
    bf16_t* P; const float* pscale;
    __device__ __forceinline__ void operator()(const f32x4 (&acc)[2][2][4][2], const Unit& u, int wr, int wc, int fr, int fq, const LAS float* rsl) const {
        const int row0 = u.pm * 256 + wr * 64 + fr;
#pragma unroll
        for (int bj = 0; bj < 2; ++bj) {
            const int col = u.pn * 256 + bj * 128 + wc * 32 + 8 * fq;
            const f32x4 p0 = *(const f32x4*)(pscale + col), p1 = *(const f32x4*)(pscale + col + 4);
#pragma unroll
            for (int ai = 0; ai < 2; ++ai)
#pragma unroll
                for (int m = 0; m < 4; ++m) {
                    const int row = row0 + ai * 128 + m * 16;
                    bf16_t* ptr = P + (size_t)row * PW + 1024 + col;
                    const u32x4 g = *(const u32x4*)ptr;
                    f32x4 v0 = acc[ai][bj][m][0] * p0, v1 = acc[ai][bj][m][1] * p1;
                    v0[0] *= bflo(g.x); v0[1] *= bfhi(g.x); v0[2] *= bflo(g.y); v0[3] *= bfhi(g.y);
                    v1[0] *= bflo(g.z); v1[1] *= bfhi(g.z); v1[2] *= bflo(g.w); v1[3] *= bfhi(g.w);
                    *(u32x4*)ptr = pack8(v0, v1);
                    if (m & 1) asm volatile("" ::: "memory");
                }
        }
    }
};
struct EpiMerge {
    static constexpr bool PERM = true;
    static constexpr bool NEEDS_RS = false;
    bf16_t* P;
    __device__ __forceinline__ void operator()(const f32x4 (&acc)[2][2][4][2], const Unit& u, int wr, int wc, int fr, int fq, const LAS float* rsl) const {
        const int row0 = u.pm * 256 + wr * 64 + fr;
#pragma unroll
        for (int ai = 0; ai < 2; ++ai)
#pragma unroll
            for (int m = 0; m < 4; ++m) {
                const int row = row0 + ai * 128 + m * 16;
#pragma unroll
                for (int bj = 0; bj < 2; ++bj) {
                    bf16_t* ptr = P + (size_t)row * PW + u.pn * 256 + bj * 128 + wc * 32 + 8 * fq;
                    const u32x4 g = *(const u32x4*)ptr; const u32x4 t = *(const u32x4*)(ptr + 1024);
                    f32x4 v0 = acc[ai][bj][m][0], v1 = acc[ai][bj][m][1];
                    v0[0] = v0[0] * bflo(g.x) + bflo(t.x); v0[1] = v0[1] * bfhi(g.x) + bfhi(t.x); v0[2] = v0[2] * bflo(g.y) + bflo(t.y); v0[3] = v0[3] * bfhi(g.y) + bfhi(t.y);
                    v1[0] = v1[0] * bflo(g.z) + bflo(t.z); v1[1] = v1[1] * bfhi(g.z) + bfhi(t.z); v1[2] = v1[2] * bflo(g.w) + bflo(t.w); v1[3] = v1[3] * bfhi(g.w) + bfhi(t.w);
                    *(u32x4*)ptr = pack8(v0, v1);
                }
                asm volatile("" ::: "memory");
            }
    }
};
struct EpiRes {
    static constexpr bool PERM = true;
    static constexpr bool NEEDS_RS = false;
    bf16_t* xb; float* ssq;
    __device__ __forceinline__ void operator()(const f32x4 (&acc)[2][2][4][2], const Unit& u, int wr, int wc, int fr, int fq, const LAS float* rsl) const {
        const int row0 = u.pm * 256 + wr * 64 + fr;
#pragma unroll
        for (int ai = 0; ai < 2; ++ai)
#pragma unroll
            for (int m = 0; m < 4; ++m) {
                const int row = row0 + ai * 128 + m * 16; float s = 0.f;
#pragma unroll
                for (int bj = 0; bj < 2; ++bj) {
                    bf16_t* ptr = xb + (size_t)row * 1024 + u.pn * 256 + bj * 128 + wc * 32 + 8 * fq;
                    const u32x4 g = *(const u32x4*)ptr;
                    f32x4 v0 = acc[ai][bj][m][0], v1 = acc[ai][bj][m][1];
                    v0[0] += bflo(g.x); v0[1] += bfhi(g.x); v0[2] += bflo(g.y); v0[3] += bfhi(g.y);
                    v1[0] += bflo(g.z); v1[1] += bfhi(g.z); v1[2] += bflo(g.w); v1[3] += bfhi(g.w);
                    *(u32x4*)ptr = pack8(v0, v1);
                    s += (v0[0] * v0[0] + v0[1] * v0[1]) + (v0[2] * v0[2] + v0[3] * v0[3]) + (v1[0] * v1[0] + v1[1] * v1[1]) + (v1[2] * v1[2] + v1[3] * v1[3]);
                }
                s += __shfl_xor(s, 16); s += __shfl_xor(s, 32);
                if (fq == 0) ssq[(size_t)row * 16 + u.pn * 4 + wc] = s;
            }
    }
};
struct EpiResFinal {
    static constexpr bool PERM = true;
    static constexpr bool NEEDS_RS = false;
    char* ws; LAS unsigned char* lx;
    __device__ __forceinline__ void operator()(const f32x4 (&acc)[2][2][4][2], const Unit& u, int wr, int wc, int fr, int fq, const LAS float* rsl) const {
        const int row0 = u.pm * 256 + wr * 64 + fr, tid = threadIdx.x;
        const Params __attribute__((address_space(4)))* kp = (const Params __attribute__((address_space(4)))*)__builtin_amdgcn_kernarg_segment_ptr();
        const bf16_t* xb = (const bf16_t*)(ws + OFF_XB); float* out = kp->xf; const float* gfin = kp->norm_final;
        float* xch = (float*)(ws + OFF_XCH); unsigned* cnt = (unsigned*)(ws + OFF_BAR) + 6144;
#pragma unroll
        for (int ai = 0; ai < 2; ++ai) {
#pragma unroll
            for (int m = 0; m < 4; ++m) { float s = 0.f;
                u32x4 g2[2];
#pragma unroll
                for (int bj = 0; bj < 2; ++bj) g2[bj] = *(const u32x4*)(xb + (size_t)(row0 + ai * 128 + m * 16) * 1024 + u.pn * 256 + bj * 128 + wc * 32 + 8 * fq);
#pragma unroll
                for (int bj = 0; bj < 2; ++bj) { const u32x4 gg = g2[bj]; f32x4 v0 = acc[ai][bj][m][0], v1 = acc[ai][bj][m][1];
                    v0[0] += bflo(gg.x); v0[1] += bfhi(gg.x); v0[2] += bflo(gg.y); v0[3] += bfhi(gg.y); v1[0] += bflo(gg.z); v1[1] += bfhi(gg.z); v1[2] += bflo(gg.w); v1[3] += bfhi(gg.w);
                    s += (v0[0] * v0[0] + v0[1] * v0[1]) + (v0[2] * v0[2] + v0[3] * v0[3]) + (v1[0] * v1[0] + v1[1] * v1[1]) + (v1[2] * v1[2] + v1[3] * v1[3]); }
                s += __shfl_xor(s, 16); s += __shfl_xor(s, 32);
                if (fq == 0) *(LAS float*)(lx + ((ai * 128 + wr * 64 + m * 16 + fr) * 4 + wc) * 4) = s;
                if (m & 1) asm volatile("" ::: "memory"); }
        }
        __builtin_amdgcn_s_waitcnt(0xc07f);
        __builtin_amdgcn_s_barrier();
        if (tid < 256) { const f32x4 q = *(LAS f32x4*)(lx + tid * 16);
            __hip_atomic_store(xch + (size_t)(u.pm * 4 + u.pn) * 256 + tid, (q[0] + q[1]) + (q[2] + q[3]), __ATOMIC_RELAXED, __HIP_MEMORY_SCOPE_AGENT); }
        asm volatile("s_waitcnt vmcnt(0)" ::: "memory");
        __builtin_amdgcn_s_barrier();
        if (tid == 0) { __hip_atomic_fetch_add(cnt + 16 * u.pm, 1u, __ATOMIC_RELAXED, __HIP_MEMORY_SCOPE_AGENT);
            unsigned polls = 0; while (__hip_atomic_load(cnt + 16 * u.pm, __ATOMIC_RELAXED, __HIP_MEMORY_SCOPE_AGENT) < 4u && ++polls < (1u << 22)) __builtin_amdgcn_s_sleep(1); }
        __builtin_amdgcn_s_barrier();
        if (tid < 256) { float t = 0.f;
#pragma unroll
            for (int j = 0; j < 4; ++j) t += __hip_atomic_load(xch + (size_t)(u.pm * 4 + j) * 256 + tid, __ATOMIC_RELAXED, __HIP_MEMORY_SCOPE_AGENT);
            *(LAS float*)(lx + 4096 + tid * 4) = rsqrtf(t * (1.f / 1024.f) + 1e-6f); }
        __builtin_amdgcn_s_waitcnt(0xc07f);
        __builtin_amdgcn_s_barrier();
        f32x4 wf[2][2];
#pragma unroll
        for (int bj = 0; bj < 2; ++bj) { const int col = u.pn * 256 + bj * 128 + wc * 32 + 8 * fq; wf[bj][0] = *(const f32x4*)(gfin + col); wf[bj][1] = *(const f32x4*)(gfin + col + 4); }
#pragma unroll
        for (int ai = 0; ai < 2; ++ai)
#pragma unroll
            for (int m = 0; m < 4; ++m) { const float rs = *(LAS float*)(lx + 4096 + (ai * 128 + wr * 64 + m * 16 + fr) * 4);
                u32x4 g2[2];
#pragma unroll
                for (int bj = 0; bj < 2; ++bj) g2[bj] = *(const u32x4*)(xb + (size_t)(row0 + ai * 128 + m * 16) * 1024 + u.pn * 256 + bj * 128 + wc * 32 + 8 * fq);
#pragma unroll
                for (int bj = 0; bj < 2; ++bj) { const u32x4 gg = g2[bj]; f32x4 v0 = acc[ai][bj][m][0], v1 = acc[ai][bj][m][1];
                    v0[0] += bflo(gg.x); v0[1] += bfhi(gg.x); v0[2] += bflo(gg.y); v0[3] += bfhi(gg.y); v1[0] += bflo(gg.z); v1[1] += bfhi(gg.z); v1[2] += bflo(gg.w); v1[3] += bfhi(gg.w);
                    float* op = out + (size_t)(row0 + ai * 128 + m * 16) * 1024 + u.pn * 256 + bj * 128 + wc * 32 + 8 * fq;
                    *(f32x4*)op = v0 * rs * wf[bj][0]; *(f32x4*)(op + 4) = v1 * rs * wf[bj][1]; }
                if (m & 1) asm volatile("" ::: "memory"); }
    }
};
struct EpiFfn1 {
    static constexpr bool PERM = true;
    static constexpr bool NEEDS_RS = true; const float* rsv;
    bf16_t* ACT; const float* ssq;
    __device__ __forceinline__ void operator()(const f32x4 (&acc)[2][2][4][2], const Unit& u, int wr, int wc, int fr, int fq, const LAS float* rsl) const {
        const int row0 = u.pm * 256 + wr * 64 + fr;
#pragma unroll
        for (int ai = 0; ai < 2; ++ai)
#pragma unroll
            for (int m = 0; m < 4; ++m) {
                const int row = row0 + ai * 128 + m * 16; const float rs = rsl[ai * 128 + wr * 64 + m * 16 + fr];
                f32x4 o[2];
#pragma unroll
                for (int n = 0; n < 2; ++n)
#pragma unroll
                    for (int j = 0; j < 4; ++j) { const float gt = acc[ai][0][m][n][j] * rs, up = acc[ai][1][m][n][j] * rs; o[n][j] = gt * sigmoidf_(gt) * up; }
                *(u32x4*)(ACT + (size_t)row * DFF + u.pn * 128 + wc * 32 + 8 * fq) = pack8(o[0], o[1]);
                asm volatile("" ::: "memory");
            }
    }
};

struct WJob { const float* src; const float* g; bf16_t* dst; int ld, ldd, vlo, vhi, kw; };
__device__ __forceinline__ WJob wjob_decode(const Params& p, int layer, int j) {
    WJob w; w.g = nullptr; w.vlo = 0; w.vhi = 256; w.kw = 256;
    bf16_t* W = (bf16_t*)(p.ws + OFF_W + (size_t)layer * SZ_WLAYER);
    if (j < 480) { const int nb = j >> 2, kb = j & 3, n0 = nb * 32; int c0;
        if (n0 < 3072) c0 = n0; else if (n0 < 3584) c0 = 3104 + (n0 - 3072); else if (n0 == 3584) c0 = 3072; else { c0 = 0; w.vhi = 0; }
        w.src = p.w_in + (size_t)layer * 1024 * INW + (size_t)kb * 256 * INW + c0; w.ld = INW; w.g = p.norm_mix + layer * 1024 + kb * 256;
        w.dst = (bf16_t*)((char*)W + WO_A) + (size_t)n0 * 1024 + kb * 256; w.ldd = 1024; return w; }
    j -= 480;
    if (j < 256) { const int nb = j >> 2, kb = j & 3, n0 = nb * 32;
        w.src = p.w_in + (size_t)layer * 1024 * INW + (size_t)kb * 256 * INW + 3616 + n0; w.ld = INW; w.g = p.norm_mix + layer * 1024 + kb * 256;
        w.dst = (bf16_t*)((char*)W + WO_B) + (size_t)n0 * 1024 + kb * 256; w.ldd = 1024; return w; }
    j -= 256;
    if (j < 128) { const int nb = j >> 2, kb = j & 3, n0 = nb * 32;
        w.src = p.w_ga + (size_t)layer * 1024 * 1024 + (size_t)kb * 256 * 1024 + n0; w.ld = 1024;
        w.dst = (bf16_t*)((char*)W + WO_GA) + (size_t)n0 * 1024 + kb * 256; w.ldd = 1024; return w; }
    j -= 128;
    if (j < 64) { const int nb = j >> 1, kb = j & 1, n0 = nb * 32, grp = n0 >> 8;
        w.src = p.w_pool + (size_t)layer * 4 * 128 * 256 + (size_t)grp * 128 * 256 + (n0 & 255); w.ld = 256;
        w.vlo = 0; w.vhi = kb == 0 ? 128 : 0; w.kw = kb == 0 ? 128 : 0;
        w.dst = (bf16_t*)((char*)W + WO_POOL) + (size_t)n0 * 128; w.ldd = 128; return w; }
    j -= 64;
    if (j < 128) { const int nb = j >> 2, kb = j & 3, n0 = nb * 32;
        w.src = p.w_out + (size_t)layer * 1024 * 1024 + (size_t)kb * 256 * 1024 + n0; w.ld = 1024;
        w.dst = (bf16_t*)((char*)W + WO_OUT) + (size_t)n0 * 1024 + kb * 256; w.ldd = 1024; return w; }
    j -= 128;
    if (j < 704) { const int nb = j >> 2, kb = j & 3, n0 = nb * 32, pn = n0 >> 8, within = n0 & 255;
        const int c0 = within < 128 ? 128 * pn + within : DFF + 128 * pn + (within - 128);
        w.src = p.w_f1 + (size_t)layer * 1024 * 2 * DFF + (size_t)kb * 256 * 2 * DFF + c0; w.ld = 2 * DFF; w.g = p.norm_ffn + layer * 1024 + kb * 256;
        w.dst = (bf16_t*)((char*)W + WO_F1) + (size_t)n0 * 1024 + kb * 256; w.ldd = 1024; return w; }
    j -= 704;
    { const int nb = j / 11, kb = j % 11, n0 = nb * 32;
        w.src = p.w_f2 + (size_t)layer * DFF * 1024 + (size_t)kb * 256 * 1024 + n0; w.ld = 1024;
        w.dst = (bf16_t*)((char*)W + WO_F2) + (size_t)n0 * DFF + kb * 256; w.ldd = DFF; return w; }
}

__device__ __forceinline__ void phase_prep(LAS unsigned char* lds, const Params& p) {
    int tid = threadIdx.x; asm volatile("" : "+v"(tid));
    const int wid = tid >> 6, lane = tid & 63;
    {
        f32x4 v[4]; WJob w, wn; int buf = 0;
#define PREP_LOAD(W_) do { _Pragma("unroll") for (int ps = 0; ps < 4; ++ps) { const int kk = (tid >> 3) + 64 * ps, c4 = (tid & 7) * 4; \
            v[ps] = (f32x4){0.f, 0.f, 0.f, 0.f}; \
            if (kk >= (W_).vlo && kk < (W_).vhi) { v[ps] = *(const f32x4*)((W_).src + (size_t)kk * (W_).ld + c4); if ((W_).g) v[ps] = v[ps] * (W_).g[kk]; } } } while (0)
        int job = bid_();
        if (job < 2 * 2112) { w = wjob_decode(p, job / 2112, job % 2112); PREP_LOAD(w); }
        for (; job < 2 * 2112; job += nblk_()) {
            const int tb = buf * 33792;
#pragma unroll
            for (int ps = 0; ps < 4; ++ps) { const int kk = (tid >> 3) + 64 * ps, c4 = (tid & 7) * 4;
#pragma unroll
                for (int e = 0; e < 4; ++e) *(LAS float*)(lds + tb + (kk * 33 + c4 + e) * 4) = v[ps][e]; }
            __syncthreads();
            const int nj = job + nblk_();
            if (nj < 2 * 2112) { wn = wjob_decode(p, nj / 2112, nj % 2112); PREP_LOAD(wn); }
            { const int n = tid & 31, s = tid >> 5; unsigned pk[8];
#pragma unroll
                for (int e = 0; e < 8; ++e) { const float a = *(LAS float*)(lds + tb + ((s * 16 + 2 * e) * 33 + n) * 4), b = *(LAS float*)(lds + tb + ((s * 16 + 2 * e + 1) * 33 + n) * 4); pk[e] = cvt_pk_bf16(a, b); }
                bf16_t* d = w.dst + (size_t)n * w.ldd + s * 16;
                if (s * 16 < w.kw) { *(u32x4*)d = (u32x4){pk[0], pk[1], pk[2], pk[3]}; *(u32x4*)(d + 8) = (u32x4){pk[4], pk[5], pk[6], pk[7]}; } }
            w = wn; buf ^= 1;
        }
#undef PREP_LOAD
        __syncthreads();
    }
    bf16_t* xb = (bf16_t*)(p.ws + OFF_XB); float* ssq = (float*)(p.ws + OFF_SSQ);
    for (int row0 = bid_() * 8 + wid; row0 < T_TOK; row0 += nblk_() * 16) {
        f32x4 v[2][4]; bool ok[2];
#pragma unroll
        for (int u = 0; u < 2; ++u) { const int row = row0 + u * nblk_() * 8; ok[u] = row < T_TOK;
            if (ok[u]) { const float* src = p.x_in + (size_t)row * 1024 + lane * 16;
#pragma unroll
                for (int i = 0; i < 4; ++i) v[u][i] = *(const f32x4*)(src + 4 * i); } }
#pragma unroll
        for (int u = 0; u < 2; ++u) if (ok[u]) { const int row = row0 + u * nblk_() * 8;
            float s = 0.f;
#pragma unroll
            for (int i = 0; i < 4; ++i) s += (v[u][i][0] * v[u][i][0] + v[u][i][1] * v[u][i][1]) + (v[u][i][2] * v[u][i][2] + v[u][i][3] * v[u][i][3]);
#pragma unroll
            for (int o = 32; o >= 1; o >>= 1) s += __shfl_xor(s, o);
            bf16_t* dst = xb + (size_t)row * 1024 + lane * 16;
            *(u32x4*)dst = pack8(v[u][0], v[u][1]); *(u32x4*)(dst + 8) = pack8(v[u][2], v[u][3]);
            if (lane < 16) ssq[(size_t)row * 16 + lane] = lane == 0 ? s : 0.f;
            if (lane == 0) ((float*)(p.ws + OFF_RS))[row] = rsqrtf(s * (1.f / 1024.f) + 1e-6f); }
    }
}

#define MFMA16(a, b, c) __builtin_amdgcn_mfma_f32_16x16x32_bf16((a), (b), (c), 0, 0, 0)
template <bool PASS2>
__device__ __forceinline__ void gla_pass(LAS unsigned char* lds, const Params& p, int layer) {
    constexpr int SQ = 0, SK = 17408, SV = 35840, SP = 69632, SLR = 78848, SDEC = 84992, SST = 85504, SX = SST, SCOL = SST + 33792;
    int tid = threadIdx.x; asm volatile("" : "+v"(tid));
    const int wid = __builtin_amdgcn_readfirstlane(tid >> 6), lane = tid & 63, fr = lane & 15, fq = lane >> 4;
    const int dk0 = (tid & 63) * 2;
    bf16_t* P = (bf16_t*)(p.ws + OFF_PROJ);
    const bf16_t* LR = (const bf16_t*)(p.ws + OFF_LR);
    bf16_t* QT = (bf16_t*)(p.ws + OFF_E + (size_t)32 * 1024 * 1024);
    bf16_t* O = (bf16_t*)(p.ws + OFF_O);
    for (int item = bid_(); item < 256; item += nblk_()) {
        const int b = item >> 7, h = (item >> 5) & 3, grp = item & 31;
#pragma unroll 1
        for (int dir = 0; dir < 2; ++dir) {
            const int scan = (b * 4 + h) * 2 + dir;
            bf16x8 wB1, wB2; float biasx;
            { const float* Wc = (dir ? p.wdu_b : p.wdu_f) + (size_t)layer * 16 * 512 + h * 128 + wid * 16 + fr;
              float wv[8]; unsigned h1[4], h2[4];
#pragma unroll
              for (int j = 0; j < 8; ++j) wv[j] = Wc[((fq & 1) * 8 + j) * 512];
#pragma unroll
              for (int jp = 0; jp < 4; ++jp) { const float a = wv[2 * jp], bq = wv[2 * jp + 1]; const unsigned hi = cvt_pk_bf16(a, bq);
                  const unsigned lo = cvt_pk_bf16(a - bflo(hi), bq - bfhi(hi)); h1[jp] = hi; h2[jp] = fq < 2 ? lo : 0u; }
              wB1 = __builtin_bit_cast(bf16x8, (u32x4){h1[0], h1[1], h1[2], h1[3]}); wB2 = __builtin_bit_cast(bf16x8, (u32x4){h2[0], h2[1], h2[2], h2[3]});
              biasx = (dir ? p.bd_b : p.bd_f)[layer * 512 + h * 128 + wid * 16 + fr]; }
            f32x4 accS[8][2];
#pragma unroll
            for (int m8 = 0; m8 < 8; ++m8)
#pragma unroll
                for (int n = 0; n < 2; ++n) accS[m8][n] = (f32x4){0.f, 0.f, 0.f, 0.f};
            float gtot0 = 0.f, gtot1 = 0.f;
            u32x4 rk[2], rq[2], rv[4]; u32x4 rl = (u32x4){0u, 0u, 0u, 0u};
#define GLA_ISSUE(CC) do { const int chunk_ = dir ? 7 - (CC) : (CC); const int t0_ = b * SEQL + grp * 512 + chunk_ * 64; \
                _Pragma("unroll") for (int it = 0; it < 2; ++it) { const int pi = tid + 512 * it, row = pi >> 4, seg = pi & 15; \
                    const bf16_t* src = P + (size_t)(t0_ + row) * PW + h * 128 + seg * 8; rk[it] = *(const u32x4*)(src + 512); } \
                if (tid < 256) { const int row = tid >> 2, seg = tid & 3; rl = *(const u32x4*)(LR + (size_t)(t0_ + row) * 64 + dir * 32 + seg * 8); } } while (0)
            GLA_ISSUE(0);
#pragma unroll 1
            for (int cc = 0; cc < 8; ++cc) {
                const int chunk = dir ? 7 - cc : cc;
                const int t0 = b * SEQL + grp * 512 + chunk * 64;
#pragma unroll
                for (int it = 0; it < 2; ++it) { const int pi = tid + 512 * it, row = pi >> 4, seg = pi & 15;
                    *(LAS u32x4*)(lds + SK + row * 272 + seg * 16) = rk[it];
                    if (PASS2) rq[it] = *(const u32x4*)(P + (size_t)(t0 + row) * PW + h * 128 + seg * 8); }
#pragma unroll
                for (int it = 0; it < 4; ++it) { const int pi = tid + 512 * it, row = pi >> 5, seg = pi & 31;
                    rv[it] = *(const u32x4*)(P + (size_t)(t0 + row) * PW + 1024 + h * 256 + seg * 8); }
                if (tid < 256) { const int row = tid >> 2, seg = tid & 3; *(LAS u32x4*)(lds + SLR + row * 64 + seg * 16) = rl; }
                __syncthreads();
#pragma unroll 1
                for (int m = 0; m < 4; ++m) {
                    const bf16x8 A = *(LAS bf16x8*)(lds + SLR + (m * 16 + fr) * 64 + fq * 16);
                    f32x4 xx = (f32x4){0.f, 0.f, 0.f, 0.f};
                    xx = MFMA16(A, wB1, xx); xx = MFMA16(A, wB2, xx);
#pragma unroll
                    for (int jj = 0; jj < 4; ++jj) { const float x = xx[jj] + biasx; const float ls = fminf(x, 0.f) - __logf(1.f + __expf(-fabsf(x)));
                        *(LAS float*)(lds + SX + ((m * 16 + 4 * fq + jj) * 132 + wid * 16 + fr) * 4) = ls * 0.0625f; }
                }
                if (PASS2) {
#pragma unroll
                    for (int it = 0; it < 2; ++it) { const int pi = tid + 512 * it, row = pi >> 4, seg = pi & 15; *(LAS u32x4*)(lds + SQ + row * 272 + seg * 16) = rq[it]; } }
                __syncthreads();
                float c0[8], c1[8];
#pragma unroll
                for (int e = 0; e < 8; ++e) { const f32x2 t2 = *(LAS f32x2*)(lds + SX + ((wid * 8 + e) * 132 + dk0) * 4); c0[e] = t2.x; c1[e] = t2.y; }
                if (dir == 0) {
#pragma unroll
                    for (int e = 1; e < 8; ++e) { c0[e] += c0[e - 1]; c1[e] += c1[e - 1]; }
                } else {
#pragma unroll
                    for (int e = 6; e >= 0; --e) { c0[e] += c0[e + 1]; c1[e] += c1[e + 1]; }
                }
                { f32x2 t2; t2.x = dir == 0 ? c0[7] : c0[0]; t2.y = dir == 0 ? c1[7] : c1[0]; *(LAS f32x2*)(lds + SCOL + (wid * 128 + dk0) * 4) = t2; }
                __syncthreads();
                float tot0 = 0.f, tot1 = 0.f, offs0 = 0.f, offs1 = 0.f;
#pragma unroll
                for (int s = 0; s < 8; ++s) { const f32x2 t2 = *(LAS f32x2*)(lds + SCOL + (s * 128 + dk0) * 4); tot0 += t2.x; tot1 += t2.y;
                    const bool inc = dir == 0 ? (s < wid) : (s > wid); offs0 += inc ? t2.x : 0.f; offs1 += inc ? t2.y : 0.f; }
                const float etot0 = __expf(tot0), etot1 = __expf(tot1), eg0 = __expf(gtot0), eg1 = __expf(gtot1);
#pragma unroll
                for (int e = 0; e < 8; ++e) { const int i = wid * 8 + e;
                    const float ec0 = __expf(c0[e] + offs0), ec1 = __expf(c1[e] + offs1), inv0 = __builtin_amdgcn_rcpf(ec0), inv1 = __builtin_amdgcn_rcpf(ec1);
                    const unsigned kw = *(LAS unsigned*)(lds + SK + i * 272 + dk0 * 2);
                    const float k0 = bflo(kw), k1 = bfhi(kw);
                    if (PASS2) { const unsigned qw = *(LAS unsigned*)(lds + SQ + i * 272 + dk0 * 2);
                        const float qe0 = bflo(qw) * 0.08838834764831845f * ec0, qe1 = bfhi(qw) * 0.08838834764831845f * ec1;
                        *(LAS unsigned*)(lds + SQ + i * 272 + dk0 * 2) = cvt_pk_bf16(qe0, qe1);
                        const unsigned qt = cvt_pk_bf16(qe0 * eg0, qe1 * eg1);
                        if (dir == 0) *(unsigned*)(QT + (size_t)(t0 + i) * 512 + h * 128 + dk0) = qt; else *(unsigned*)(P + (size_t)(t0 + i) * PW + h * 128 + dk0) = qt;
                        *(LAS unsigned*)(lds + SK + i * 272 + dk0 * 2) = cvt_pk_bf16(k0 * inv0, k1 * inv1); }
                }
                if (wid == 0) { f32x2 t2; t2.x = etot0; t2.y = etot1; *(LAS f32x2*)(lds + SDEC + dk0 * 4) = t2; }
                gtot0 += tot0; gtot1 += tot1;
#pragma unroll
                for (int it = 0; it < 4; ++it) { const int pi = tid + 512 * it, row = pi >> 5, seg = pi & 31;
                    *(LAS u32x4*)(lds + SV + row * 528 + seg * 16) = rv[it]; }
                __syncthreads();
                if (PASS2) {
                    f32x4 accP[2];
#pragma unroll
                    for (int s = 0; s < 2; ++s) { const int tt = wid * 2 + s, ib = tt >> 2, jb = tt & 3; f32x4 a = (f32x4){0.f, 0.f, 0.f, 0.f};
#pragma unroll
                        for (int kb = 0; kb < 4; ++kb) { const bf16x8 A = *(LAS bf16x8*)(lds + SK + (jb * 16 + fr) * 272 + (kb * 32 + fq * 8) * 2);
                            const bf16x8 B = *(LAS bf16x8*)(lds + SQ + (ib * 16 + fr) * 272 + (kb * 32 + fq * 8) * 2); a = MFMA16(A, B, a); }
                        accP[s] = a; }
#pragma unroll
                    for (int s = 0; s < 2; ++s) { const int tt = wid * 2 + s, ib = tt >> 2, jb = tt & 3; const int i = ib * 16 + fr, jbase = jb * 16 + 4 * fq; float v[4];
#pragma unroll
                        for (int jj = 0; jj < 4; ++jj) { const int j = jbase + jj; const bool keep = dir == 0 ? (j <= i) : (j > i); v[jj] = keep ? accP[s][jj] : 0.f; }
                        *(LAS u32x2*)(lds + SP + i * 144 + jbase * 2) = (u32x2){cvt_pk_bf16(v[0], v[1]), cvt_pk_bf16(v[2], v[3])}; }
#pragma unroll
                    for (int m8 = 0; m8 < 8; ++m8)
#pragma unroll
                        for (int n = 0; n < 2; ++n) { const f32x4 sv = accS[m8][n];
                            *(LAS u32x2*)(lds + SST + (wid * 32 + n * 16 + fr) * 272 + (m8 * 16 + 4 * fq) * 2) = (u32x2){cvt_pk_bf16(sv[0], sv[1]), cvt_pk_bf16(sv[2], sv[3])}; }
                    __syncthreads();
                }
                bf16x8 vf[2][2];
#pragma unroll
                for (int n = 0; n < 2; ++n)
#pragma unroll
                    for (int kb2 = 0; kb2 < 2; ++kb2) {
                        const int a0 = SV + (kb2 * 32 + fq * 8 + (fr >> 2)) * 528 + (wid * 32 + n * 16 + 4 * (fr & 3)) * 2;
                        const s16x4 lo = __builtin_amdgcn_ds_read_tr16_b64_v4i16((LAS s16x4*)(lds + a0));
                        const s16x4 hi = __builtin_amdgcn_ds_read_tr16_b64_v4i16((LAS s16x4*)(lds + a0 + 4 * 528));
                        vf[n][kb2] = __builtin_shufflevector(lo, hi, 0, 1, 2, 3, 4, 5, 6, 7); }
                if (PASS2) {
#pragma unroll
                    for (int n = 0; n < 2; ++n) {
                        f32x4 accO[4];
#pragma unroll
                        for (int m = 0; m < 4; ++m) accO[m] = (f32x4){0.f, 0.f, 0.f, 0.f};
#pragma unroll
                        for (int kb = 0; kb < 4; ++kb) { const bf16x8 A = *(LAS bf16x8*)(lds + SST + (wid * 32 + n * 16 + fr) * 272 + (kb * 32 + fq * 8) * 2);
#pragma unroll
                            for (int m = 0; m < 4; ++m) { const bf16x8 B = *(LAS bf16x8*)(lds + SQ + (m * 16 + fr) * 272 + (kb * 32 + fq * 8) * 2); accO[m] = MFMA16(A, B, accO[m]); } }
#pragma unroll
                        for (int kb2 = 0; kb2 < 2; ++kb2)
#pragma unroll
                            for (int m = 0; m < 4; ++m) { const bf16x8 B = *(LAS bf16x8*)(lds + SP + (m * 16 + fr) * 144 + (kb2 * 32 + fq * 8) * 2); accO[m] = MFMA16(vf[n][kb2], B, accO[m]); }
#pragma unroll
                        for (int m = 0; m < 4; ++m) { bf16_t* dst = O + (size_t)(t0 + m * 16 + fr) * 1024 + h * 256 + wid * 32 + n * 16 + 4 * fq; f32x4 v = accO[m];
                            if (dir) { const u32x2 old = *(const u32x2*)dst; v[0] += bflo(old.x); v[1] += bfhi(old.x); v[2] += bflo(old.y); v[3] += bfhi(old.y); }
                            *(u32x2*)dst = (u32x2){cvt_pk_bf16(v[0], v[1]), cvt_pk_bf16(v[2], v[3])}; }
                        asm volatile("" ::: "memory");
                    }
                }
                if (cc < 7) GLA_ISSUE(cc + 1);
#pragma unroll
                for (int m8 = 0; m8 < 8; ++m8) { const f32x4 d = *(LAS f32x4*)(lds + SDEC + (m8 * 16 + 4 * fq) * 4);
#pragma unroll
                    for (int kb2 = 0; kb2 < 2; ++kb2) {
                        const int a0 = SK + (kb2 * 32 + fq * 8 + (fr >> 2)) * 272 + (m8 * 16 + 4 * (fr & 3)) * 2;
                        const s16x4 lo = __builtin_amdgcn_ds_read_tr16_b64_v4i16((LAS s16x4*)(lds + a0));
                        const s16x4 hi = __builtin_amdgcn_ds_read_tr16_b64_v4i16((LAS s16x4*)(lds + a0 + 4 * 272));
                        const bf16x8 A = __builtin_shufflevector(lo, hi, 0, 1, 2, 3, 4, 5, 6, 7);
#pragma unroll
                        for (int n = 0; n < 2; ++n) accS[m8][n] = MFMA16(A, vf[n][kb2], accS[m8][n]); }
#pragma unroll
                    for (int n = 0; n < 2; ++n) accS[m8][n] = accS[m8][n] * d; }
                __syncthreads();
            }
            {
                char* wsl = p.ws; asm volatile("" : "+s"(wsl));
                bf16_t* Eit = (bf16_t*)(wsl + OFF_E) + (size_t)(scan * 32 + grp) * 32768 + (size_t)(wid * 32 + fr) * 128 + 4 * fq;
                float* DL = (float*)(wsl + OFF_DLOG);
#pragma unroll
                for (int m8 = 0; m8 < 8; ++m8)
#pragma unroll
                    for (int n = 0; n < 2; ++n)
                        *(u32x2*)(Eit + n * 16 * 128 + m8 * 16) = (u32x2){cvt_pk_bf16(accS[m8][n][0], accS[m8][n][1]), cvt_pk_bf16(accS[m8][n][2], accS[m8][n][3])};
                if (wid == 0) { DL[(scan * 32 + grp) * 128 + dk0] = gtot0; DL[(scan * 32 + grp) * 128 + dk0 + 1] = gtot1; }
            }
        }
    }
}

#undef GLA_ISSUE
__device__ __forceinline__ void phase_combine(const Params& p) {
    bf16_t* E = (bf16_t*)(p.ws + OFF_E); const float* DL = (const float*)(p.ws + OFF_DLOG);
    int tid = threadIdx.x; asm volatile("" : "+v"(tid));
    for (int idx = bid_() * 512 + tid; idx < 16 * 4096; idx += nblk_() * 512) {
        const int scan = idx >> 12, e8 = idx & 4095, dk0 = (e8 & 15) * 8, dir = scan & 1;
        float R[8];
#pragma unroll
        for (int i = 0; i < 8; ++i) R[i] = 0.f;
#pragma unroll 1
        for (int q4 = 0; q4 < 4; ++q4) {
            u32x4 ev[8]; f32x4 d0[8], d1[8];
#pragma unroll
            for (int gg = 0; gg < 8; ++gg) { const int go = q4 * 8 + gg, g = dir ? 31 - go : go;
                ev[gg] = *(const u32x4*)(E + (size_t)(scan * 32 + g) * 32768 + e8 * 8);
                d0[gg] = *(const f32x4*)(DL + (scan * 32 + g) * 128 + dk0); d1[gg] = *(const f32x4*)(DL + (scan * 32 + g) * 128 + dk0 + 4); }
#pragma unroll
            for (int gg = 0; gg < 8; ++gg) { const int go = q4 * 8 + gg, g = dir ? 31 - go : go;
                *(u32x4*)(E + (size_t)(scan * 32 + g) * 32768 + e8 * 8) = (u32x4){cvt_pk_bf16(R[0], R[1]), cvt_pk_bf16(R[2], R[3]), cvt_pk_bf16(R[4], R[5]), cvt_pk_bf16(R[6], R[7])};
                const u32x4 w = ev[gg];
                R[0] = R[0] * __expf(d0[gg][0]) + bflo(w.x); R[1] = R[1] * __expf(d0[gg][1]) + bfhi(w.x); R[2] = R[2] * __expf(d0[gg][2]) + bflo(w.y); R[3] = R[3] * __expf(d0[gg][3]) + bfhi(w.y);
                R[4] = R[4] * __expf(d1[gg][0]) + bflo(w.z); R[5] = R[5] * __expf(d1[gg][1]) + bfhi(w.z); R[6] = R[6] * __expf(d1[gg][2]) + bflo(w.w); R[7] = R[7] * __expf(d1[gg][3]) + bfhi(w.w); }
        }
    }
}

__device__ __forceinline__ void gla_light(LAS unsigned char* lds, const Params& p, int layer) {
    constexpr int SSTF = 0, SSTB = 69632, SSS = 139264;
    int tid = threadIdx.x; asm volatile("" : "+v"(tid));
    const int wid = __builtin_amdgcn_readfirstlane(tid >> 6), lane = tid & 63, fr = lane & 15, fq = lane >> 4, mt = wid & 3, hv = wid >> 2;
    bf16_t* P = (bf16_t*)(p.ws + OFF_PROJ);
    const bf16_t* E = (const bf16_t*)(p.ws + OFF_E);
    const bf16_t* QT = (const bf16_t*)(p.ws + OFF_E + (size_t)32 * 1024 * 1024);
    const bf16_t* O = (const bf16_t*)(p.ws + OFF_O);
    for (int item = bid_(); item < 256; item += nblk_()) {
        const int b = item >> 7, h = (item >> 5) & 3, grp = item & 31;
        const int scanf = (b * 4 + h) * 2;
        __syncthreads();
#pragma unroll
        for (int it = 0; it < 8; ++it) { const int pi = tid + 512 * it, row = pi >> 4, seg = pi & 15;
            const u32x4 vf_ = *(const u32x4*)(E + (size_t)(scanf * 32 + grp) * 32768 + row * 128 + seg * 8);
            const u32x4 vb_ = *(const u32x4*)(E + (size_t)((scanf + 1) * 32 + grp) * 32768 + row * 128 + seg * 8);
            *(LAS u32x4*)(lds + SSTF + row * 272 + seg * 16) = vf_; *(LAS u32x4*)(lds + SSTB + row * 272 + seg * 16) = vb_; }
        __syncthreads();
        f32x4 gn[8];
#pragma unroll
        for (int n = 0; n < 8; ++n) gn[n] = *(const f32x4*)(p.gla_norm + layer * 1024 + h * 256 + hv * 128 + n * 16 + 4 * fq);
#pragma unroll 1
        for (int cc = 0; cc < 8; ++cc) {
            const size_t tok = (size_t)(b * SEQL + grp * 512 + cc * 64 + mt * 16 + fr);
            bf16x8 bq[2][4];
#pragma unroll
            for (int kb = 0; kb < 4; ++kb) { bq[0][kb] = *(const bf16x8*)(QT + tok * 512 + h * 128 + kb * 32 + fq * 8); bq[1][kb] = *(const bf16x8*)(P + tok * PW + h * 128 + kb * 32 + fq * 8); }
            u32x2 oo[8], rr[8];
#pragma unroll
            for (int n = 0; n < 8; ++n) { oo[n] = *(const u32x2*)(O + tok * 1024 + h * 256 + hv * 128 + n * 16 + 4 * fq);
                rr[n] = *(const u32x2*)(P + tok * PW + 2048 + h * 256 + hv * 128 + n * 16 + 4 * fq); }
            f32x4 accO[8];
#pragma unroll
            for (int n = 0; n < 8; ++n) accO[n] = (f32x4){0.f, 0.f, 0.f, 0.f};
#pragma unroll
            for (int dir = 0; dir < 2; ++dir)
#pragma unroll
                for (int kb = 0; kb < 4; ++kb)
#pragma unroll
                    for (int n = 0; n < 8; ++n) { const bf16x8 A = *(LAS bf16x8*)(lds + (dir ? SSTB : SSTF) + (hv * 128 + n * 16 + fr) * 272 + (kb * 32 + fq * 8) * 2);
                        accO[n] = MFMA16(A, bq[dir][kb], accO[n]); }
            float s = 0.f;
#pragma unroll
            for (int n = 0; n < 8; ++n) { f32x4 v = accO[n]; v[0] += bflo(oo[n].x); v[1] += bfhi(oo[n].x); v[2] += bflo(oo[n].y); v[3] += bfhi(oo[n].y); accO[n] = v;
                s += (v[0] * v[0] + v[1] * v[1]) + (v[2] * v[2] + v[3] * v[3]); }
            s += __shfl_xor(s, 16); s += __shfl_xor(s, 32);
            const int sb = SSS + (cc & 1) * 512;
            if (fq == 0) *(LAS float*)(lds + sb + (hv * 64 + mt * 16 + fr) * 4) = s;
            __syncthreads();
            const float tot = *(LAS float*)(lds + sb + (mt * 16 + fr) * 4) + *(LAS float*)(lds + sb + (64 + mt * 16 + fr) * 4);
            const float rn = rsqrtf(tot * (1.f / 256.f) + 1e-6f);
#pragma unroll
            for (int n = 0; n < 8; ++n) { const float r0 = bflo(rr[n].x), r1 = bfhi(rr[n].x), r2 = bflo(rr[n].y), r3 = bfhi(rr[n].y);
                const f32x4 v = accO[n] * rn * gn[n];
                *(u32x2*)(P + tok * PW + 2048 + h * 256 + hv * 128 + n * 16 + 4 * fq) =
                    (u32x2){cvt_pk_bf16(v[0] * (r0 * sigmoidf_(r0)), v[1] * (r1 * sigmoidf_(r1))), cvt_pk_bf16(v[2] * (r2 * sigmoidf_(r2)), v[3] * (r3 * sigmoidf_(r3)))}; }
        }
    }
}

__device__ __forceinline__ void phase_gating(const Params& p, int layer) {
    int tid = threadIdx.x; asm volatile("" : "+v"(tid));
    const int wid = tid >> 6, lane = tid & 63;
    bf16_t* P = (bf16_t*)(p.ws + OFF_PROJ); const bf16_t* O = (const bf16_t*)(p.ws + OFF_O);
    const float* gn = p.gla_norm + layer * 1024 + lane * 16;
    f32x4 g4[4];
#pragma unroll
    for (int i = 0; i < 4; ++i) g4[i] = *(const f32x4*)(gn + 4 * i);
    for (int t0 = bid_() * 8 + wid; t0 < T_TOK; t0 += nblk_() * 16) {
        u32x4 oo[2][2], rr[2][2]; bool ok[2];
#pragma unroll
        for (int u = 0; u < 2; ++u) { const int t = t0 + u * nblk_() * 8; ok[u] = t < T_TOK;
            if (ok[u]) { oo[u][0] = *(const u32x4*)(O + (size_t)t * 1024 + lane * 16); oo[u][1] = *(const u32x4*)(O + (size_t)t * 1024 + lane * 16 + 8);
                const bf16_t* rp = P + (size_t)t * PW + 2048 + lane * 16; rr[u][0] = *(const u32x4*)rp; rr[u][1] = *(const u32x4*)(rp + 8); } }
#pragma unroll
        for (int u = 0; u < 2; ++u) if (ok[u]) { const int t = t0 + u * nblk_() * 8;
            bf16_t* rp = P + (size_t)t * PW + 2048 + lane * 16;
            const u32x4 o0 = oo[u][0], o1 = oo[u][1], r0 = rr[u][0], r1 = rr[u][1];
            float ov[16], rv[16];
            ov[0] = bflo(o0.x); ov[1] = bfhi(o0.x); ov[2] = bflo(o0.y); ov[3] = bfhi(o0.y); ov[4] = bflo(o0.z); ov[5] = bfhi(o0.z); ov[6] = bflo(o0.w); ov[7] = bfhi(o0.w);
            ov[8] = bflo(o1.x); ov[9] = bfhi(o1.x); ov[10] = bflo(o1.y); ov[11] = bfhi(o1.y); ov[12] = bflo(o1.z); ov[13] = bfhi(o1.z); ov[14] = bflo(o1.w); ov[15] = bfhi(o1.w);
            rv[0] = bflo(r0.x); rv[1] = bfhi(r0.x); rv[2] = bflo(r0.y); rv[3] = bfhi(r0.y); rv[4] = bflo(r0.z); rv[5] = bfhi(r0.z); rv[6] = bflo(r0.w); rv[7] = bfhi(r0.w);
            rv[8] = bflo(r1.x); rv[9] = bfhi(r1.x); rv[10] = bflo(r1.y); rv[11] = bfhi(r1.y); rv[12] = bflo(r1.z); rv[13] = bfhi(r1.z); rv[14] = bflo(r1.w); rv[15] = bfhi(r1.w);
            float s = 0.f;
#pragma unroll
            for (int i = 0; i < 16; ++i) s += ov[i] * ov[i];
            s += __shfl_xor(s, 8); s += __shfl_xor(s, 4); s += __shfl_xor(s, 2); s += __shfl_xor(s, 1);
            const float rn = rsqrtf(s * (1.f / 256.f) + 1e-6f);
            float out[16];
#pragma unroll
            for (int i = 0; i < 16; ++i) { const float r = rv[i]; out[i] = ov[i] * rn * g4[i >> 2][i & 3] * (r * sigmoidf_(r)); }
            *(u32x4*)rp = (u32x4){cvt_pk_bf16(out[0], out[1]), cvt_pk_bf16(out[2], out[3]), cvt_pk_bf16(out[4], out[5]), cvt_pk_bf16(out[6], out[7])};
            *(u32x4*)(rp + 8) = (u32x4){cvt_pk_bf16(out[8], out[9]), cvt_pk_bf16(out[10], out[11]), cvt_pk_bf16(out[12], out[13]), cvt_pk_bf16(out[14], out[15])}; }
    }
}

template <int HW, int RL>
__device__ __forceinline__ void pool_run(const bf16_t* P, bf16_t* PO, int t0, int c8) {
    constexpr int NR = RL + 2 * HW - 1;
    const int pos0 = t0 & (SEQL - 1);
    const bf16_t* base = P + (size_t)t0 * PW + 3072 + c8 * 8;
    u32x4 v[NR];
#pragma unroll
    for (int k = 0; k < NR; ++k) { const int off = k - HW, tt = pos0 + off;
        v[k] = (tt >= 0 && tt < SEQL) ? *(const u32x4*)(base + (long)off * PW) : (u32x4){0u, 0u, 0u, 0u}; }
    float w[8];
#pragma unroll
    for (int i = 0; i < 8; ++i) w[i] = 0.f;
#pragma unroll
    for (int k = 0; k < 2 * HW; ++k) { w[0] += bflo(v[k].x); w[1] += bfhi(v[k].x); w[2] += bflo(v[k].y); w[3] += bfhi(v[k].y); w[4] += bflo(v[k].z); w[5] += bfhi(v[k].z); w[6] += bflo(v[k].w); w[7] += bfhi(v[k].w); }
#pragma unroll
    for (int i = 0; i < RL; ++i) {
        if (i > 0) { const u32x4 a = v[i + 2 * HW - 1], s = v[i - 1];
            w[0] += bflo(a.x) - bflo(s.x); w[1] += bfhi(a.x) - bfhi(s.x); w[2] += bflo(a.y) - bflo(s.y); w[3] += bfhi(a.y) - bfhi(s.y);
            w[4] += bflo(a.z) - bflo(s.z); w[5] += bfhi(a.z) - bfhi(s.z); w[6] += bflo(a.w) - bflo(s.w); w[7] += bfhi(a.w) - bfhi(s.w); }
        const int pos = pos0 + i, lo = pos - HW < 0 ? 0 : pos - HW, hi = pos + HW > SEQL ? SEQL : pos + HW;
        const float ic = 1.f / (float)(hi - lo);
        const u32x4 c = v[HW + i];
        *(u32x4*)(PO + (size_t)(t0 + i) * 512 + c8 * 8) = (u32x4){cvt_pk_bf16(w[0] * ic - bflo(c.x), w[1] * ic - bfhi(c.x)), cvt_pk_bf16(w[2] * ic - bflo(c.y), w[3] * ic - bfhi(c.y)),
                                                                 cvt_pk_bf16(w[4] * ic - bflo(c.z), w[5] * ic - bfhi(c.z)), cvt_pk_bf16(w[6] * ic - bflo(c.w), w[7] * ic - bfhi(c.w))};
    }
}
__device__ __forceinline__ void phase_pool(const Params& p) {
    const bf16_t* P = (const bf16_t*)(p.ws + OFF_PROJ); bf16_t* PO = (bf16_t*)(p.ws + OFF_E);
    int tid = threadIdx.x; asm volatile("" : "+v"(tid));
    const int wid = __builtin_amdgcn_readfirstlane(tid >> 6), lane = tid & 63;
    for (int wi = blockIdx.x * 8 + wid; wi < T_TOK / 16; wi += gridDim.x * 8) {
        const int grp = wi & 3, t0 = (wi >> 2) * 64 + (lane >> 4) * 16, c8 = grp * 16 + (lane & 15);
        if (grp == 0) pool_run<1, 16>(P, PO, t0, c8); else if (grp == 1) pool_run<2, 16>(P, PO, t0, c8); else if (grp == 2) pool_run<4, 16>(P, PO, t0, c8); else { pool_run<8, 8>(P, PO, t0, c8); pool_run<8, 8>(P, PO, t0 + 8, c8); }
    }
}

__device__ __forceinline__ void phase_final(const Params& p) {
    int tid = threadIdx.x; asm volatile("" : "+v"(tid));
    const int wid = tid >> 6, lane = tid & 63;
    const float* ssq = (const float*)(p.ws + OFF_SSQ); const bf16_t* xb = (const bf16_t*)(p.ws + OFF_XB);
    f32x4 g4[4];
#pragma unroll
    for (int i = 0; i < 4; ++i) g4[i] = *(const f32x4*)(p.norm_final + lane * 16 + 4 * i);
    for (int row0 = bid_() * 8 + wid; row0 < T_TOK; row0 += nblk_() * 32) {
        u32x4 v[4][2]; float rs[4]; bool ok[4];
#pragma unroll
        for (int u = 0; u < 4; ++u) { const int row = row0 + u * nblk_() * 8; ok[u] = row < T_TOK;
            if (ok[u]) { rs[u] = rowscale(ssq, row); const bf16_t* xp = xb + (size_t)row * 1024 + lane * 16; v[u][0] = *(const u32x4*)xp; v[u][1] = *(const u32x4*)(xp + 8); } }
#pragma unroll
        for (int u = 0; u < 4; ++u) if (ok[u]) { const int row = row0 + u * nblk_() * 8; float* op = p.xf + (size_t)row * 1024 + lane * 16; const float r = rs[u];
            *(f32x4*)(op) = (f32x4){bflo(v[u][0].x), bfhi(v[u][0].x), bflo(v[u][0].y), bfhi(v[u][0].y)} * r * g4[0];
            *(f32x4*)(op + 4) = (f32x4){bflo(v[u][0].z), bfhi(v[u][0].z), bflo(v[u][0].w), bfhi(v[u][0].w)} * r * g4[1];
            *(f32x4*)(op + 8) = (f32x4){bflo(v[u][1].x), bfhi(v[u][1].x), bflo(v[u][1].y), bfhi(v[u][1].y)} * r * g4[2];
            *(f32x4*)(op + 12) = (f32x4){bflo(v[u][1].z), bfhi(v[u][1].z), bflo(v[u][1].w), bfhi(v[u][1].w)} * r * g4[3]; }
    }
}

__device__ __forceinline__ void phase_rs(const Params& p) {
    int tid = threadIdx.x; asm volatile("" : "+v"(tid));
    const float* ssq = (const float*)(p.ws + OFF_SSQ); float* rs = (float*)(p.ws + OFF_RS);
    for (int row = bid_() * 512 + tid; row < T_TOK; row += nblk_() * 512) rs[row] = rowscale(ssq, row);
}
__device__ __forceinline__ void grid_barrier(unsigned* bar, unsigned k) {
    asm volatile("s_waitcnt vmcnt(0)" ::: "memory");
    __syncthreads();
    if (threadIdx.x == 0) {
        const unsigned nb = nblk_(), g = bid_() >> 4, ng = (nb + 15u) >> 4, gsz = (nb - 16u * g) < 16u ? (nb - 16u * g) : 16u;
        __builtin_amdgcn_fence(__ATOMIC_RELEASE, "agent");
        asm volatile("s_waitcnt vmcnt(0)" ::: "memory");
        const unsigned old = __hip_atomic_fetch_add(bar + 64 * g, 1u, __ATOMIC_RELAXED, __HIP_MEMORY_SCOPE_AGENT);
        if (old == k * gsz - 1u) {
            const unsigned old2 = __hip_atomic_fetch_add(bar + 64 * 32, 1u, __ATOMIC_RELAXED, __HIP_MEMORY_SCOPE_AGENT);
            if (old2 == k * ng - 1u) for (unsigned j = 0; j < ng; ++j) __hip_atomic_store(bar + 64 * (64 + j), k, __ATOMIC_RELAXED, __HIP_MEMORY_SCOPE_AGENT);
        }
        while (__hip_atomic_load(bar + 64 * (64 + g), __ATOMIC_RELAXED, __HIP_MEMORY_SCOPE_AGENT) < k) __builtin_amdgcn_s_sleep(2);
        __builtin_amdgcn_fence(__ATOMIC_ACQUIRE, "agent");
        asm volatile("s_waitcnt vmcnt(0)" ::: "memory");
    }
    __syncthreads();
}
__global__ void __launch_bounds__(512, 2) mega(const Params p_arg) {
    extern __shared__ __attribute__((aligned(16))) unsigned char shm[];
    LAS unsigned char* lds = (LAS unsigned char*)shm;
    typedef const Params __attribute__((address_space(4))) * KArgPtr;
    const int phase_lo = p_arg.phase_lo, phase_hi = p_arg.phase_hi;
    pg8::StaticOrder S;
    unsigned bar_k = 0;
    for (int ph = phase_lo; ph < phase_hi; ++ph) {
        KArgPtr kp = (KArgPtr)__builtin_amdgcn_kernarg_segment_ptr(); asm volatile("" : "+s"(kp));
        const Params& p = *(const Params*)kp;
        bf16_t* xb = (bf16_t*)(p.ws + OFF_XB); bf16_t* proj = (bf16_t*)(p.ws + OFF_PROJ); float* ssq = (float*)(p.ws + OFF_SSQ);
        if (ph > phase_lo) {
            if (phase_hi > 1000) cg::this_grid().sync();
            grid_barrier((unsigned*)(p.ws + OFF_BAR), ++bar_k);
        }
        if (ph == 0) { phase_prep(lds, p); continue; }
        if (ph == 19) { phase_final(p); continue; }
        const int layer = (ph - 1) / 9, sub = (ph - 1) % 9;
        const char* W = p.ws + OFF_W + (size_t)layer * SZ_WLAYER;
        switch (sub) {
        case 0: { if (layer > 0) { phase_rs(p); grid_barrier((unsigned*)(p.ws + OFF_BAR), ++bar_k); }
                  pg8::Gemm g{xb, (const bf16_t*)(W + WO_A), T_TOK, NA, 1024, 1024}; S.init(g.M, g.N, nblk_(), bid_());
                  EpiA e{(const float*)(p.ws + OFF_RS), proj, (bf16_t*)(p.ws + OFF_LR), ssq}; pg8::gemm_phase(lds, g, S, e); } break;
        case 1: gla_pass<true>(lds, p, layer); break;
        case 2: phase_combine(p); break;
        case 3: gla_light(lds, p, layer); break;
        case 4: { pg8::Gemm g{xb, (const bf16_t*)(W + WO_B), T_TOK, NB, 1024, 1024}; S.init(g.M, g.N, nblk_(), bid_());
                  EpiGate e{(const float*)(p.ws + OFF_RS), proj, ssq}; pg8::gemm_phase(lds, g, S, e);
                  phase_pool(p); } break;
        case 5: { { pg8::Gemm g{(const bf16_t*)(p.ws + OFF_E), (const bf16_t*)(W + WO_POOL), T_TOK, 1024, 128, 512}; S.init(g.M, g.N, nblk_(), bid_());
                    EpiPool e{proj, p.pool_scale + layer * 1024}; pg8::gemm_phase<EpiPool, 256>(lds, g, S, e); }
                  { pg8::Gemm g{proj + 2048, (const bf16_t*)(W + WO_GA), T_TOK, 1024, 1024, PW}; S.init(g.M, g.N, nblk_(), bid_());
                    EpiMerge e{proj}; pg8::gemm_phase(lds, g, S, e); } } break;
        case 6: { pg8::Gemm g{proj, (const bf16_t*)(W + WO_OUT), T_TOK, 1024, 1024, PW}; S.init(g.M, g.N, nblk_(), bid_());
                  EpiRes e{xb, ssq}; pg8::gemm_phase(lds, g, S, e); } break;
        case 7: { phase_rs(p); grid_barrier((unsigned*)(p.ws + OFF_BAR), ++bar_k);
                  pg8::Gemm g{xb, (const bf16_t*)(W + WO_F1), T_TOK, 2 * DFF, 1024, 1024}; S.init(g.M, g.N, nblk_(), bid_());
                  EpiFfn1 e{(const float*)(p.ws + OFF_RS), proj, ssq}; pg8::gemm_phase(lds, g, S, e); } break;
        case 8: { pg8::Gemm g{proj, (const bf16_t*)(W + WO_F2), T_TOK, 1024, DFF, DFF}; S.init(g.M, g.N, nblk_(), bid_());
                  if (layer == 1) { EpiResFinal e{p.ws, lds + pg8::STAGE_BYTES + 2048}; pg8::gemm_phase(lds, g, S, e); }
                  else { EpiRes e{xb, ssq}; pg8::gemm_phase(lds, g, S, e); } } break;
        }
    }
}

extern "C" void kernel_launch(void* const* d_in, const int* in_sizes, int n_in, void* d_out, int out_size, void* d_ws, size_t ws_size, hipStream_t stream) {
    (void)in_sizes; (void)n_in; (void)out_size;
    if (ws_size < WS_NEEDED) return;
    Params p{};
    p.x_in = (const float*)d_in[0]; p.norm_mix = (const float*)d_in[1]; p.w_in = (const float*)d_in[2]; p.wdu_f = (const float*)d_in[3]; p.bd_f = (const float*)d_in[4];
    p.wdu_b = (const float*)d_in[5]; p.bd_b = (const float*)d_in[6]; p.gla_norm = (const float*)d_in[7]; p.w_ga = (const float*)d_in[8]; p.w_pool = (const float*)d_in[9];
    p.pool_scale = (const float*)d_in[10]; p.w_out = (const float*)d_in[11]; p.norm_ffn = (const float*)d_in[12]; p.w_f1 = (const float*)d_in[13]; p.w_f2 = (const float*)d_in[14];
    p.norm_final = (const float*)d_in[15];
    p.xf = (float*)d_out; p.ws = (char*)d_ws;
    hipFuncSetAttribute((const void*)mega, hipFuncAttributeMaxDynamicSharedMemorySize, LDS_BYTES);
    int dev = 0, cus = 0, per = 0;
    hipGetDevice(&dev); hipDeviceGetAttribute(&cus, hipDeviceAttributeMultiprocessorCount, dev);
    hipOccupancyMaxActiveBlocksPerMultiprocessor(&per, mega, 512, LDS_BYTES);
    int grid = cus * (per > 0 ? per : 1); if (grid > 256) grid = 256; if (grid < 1) grid = 1;
#if MK_SINGLE_LAUNCH
    p.phase_lo = 0; p.phase_hi = 19;
    hipMemsetAsync((char*)d_ws + OFF_BAR, 0, 128 * 256, stream);
    void* args[] = {(void*)&p};
    hipLaunchCooperativeKernel((const void*)mega, dim3(grid), dim3(512), args, LDS_BYTES, stream);
#else
    for (int ph = 0; ph < 20; ++ph) { p.phase_lo = ph; p.phase_hi = ph + 1; hipLaunchKernelGGL(mega, dim3(grid), dim3(512), LDS_BYTES, stream, p); }
#endif
}
```

```cpp
#include <hip/hip_runtime.h>
#include <hip/hip_cooperative_groups.h>
namespace cg = cooperative_groups;

#ifndef MK_SINGLE_LAUNCH
#define MK_SINGLE_LAUNCH 1
#endif

#define LAS __attribute__((address_space(3)))
typedef unsigned short bf16_t;
typedef short bf16x8 __attribute__((ext_vector_type(8)));
typedef short s16x4 __attribute__((ext_vector_type(4)));
typedef float f32x4 __attribute__((ext_vector_type(4)));
typedef unsigned u32x4 __attribute__((ext_vector_type(4)));
typedef unsigned u32x2 __attribute__((ext_vector_type(2)));

constexpr int T_TOK = 32768, SEQL = 16384, DM = 1024, PW = 3584, NA = 3840, NB = 2048, DFF = 2816, INW = 5664;
constexpr int LDS_BYTES = 155136;

constexpr size_t SZ_WA = (size_t)NA * 1024 * 2, SZ_WB = (size_t)NB * 1024 * 2, SZ_WGA = (size_t)1024 * 1024 * 2, SZ_WPOOL = (size_t)1024 * 512 * 2,
                 SZ_WOUT = (size_t)1024 * 1024 * 2, SZ_WF1 = (size_t)2 * DFF * 1024 * 2, SZ_WF2 = (size_t)1024 * DFF * 2;
constexpr size_t WO_A = 0, WO_B = WO_A + SZ_WA, WO_GA = WO_B + SZ_WB, WO_POOL = WO_GA + SZ_WGA, WO_OUT = WO_POOL + SZ_WPOOL, WO_F1 = WO_OUT + SZ_WOUT,
                 WO_F2 = WO_F1 + SZ_WF1, SZ_WLAYER = WO_F2 + SZ_WF2;
constexpr size_t OFF_W = 0;
constexpr size_t OFF_XB = OFF_W + 2 * SZ_WLAYER;
constexpr size_t OFF_PROJ = OFF_XB + (size_t)T_TOK * 1024 * 2;
constexpr size_t OFF_LR = OFF_PROJ + (size_t)T_TOK * PW * 2;
constexpr size_t OFF_E = OFF_LR + (size_t)T_TOK * 32 * 4;
constexpr size_t OFF_DLOG = OFF_E + (size_t)16 * 32 * 32768 * 4;
constexpr size_t OFF_O = OFF_DLOG + (size_t)16 * 32 * 128 * 4;
constexpr size_t OFF_SSQ = OFF_O + (size_t)T_TOK * 1024 * 2;
constexpr size_t OFF_BAR = OFF_SSQ + (size_t)T_TOK * 16 * 4;
constexpr size_t OFF_RS = OFF_BAR + 128 * 256;
constexpr size_t OFF_XCH = OFF_RS + (size_t)T_TOK * 4;
constexpr size_t WS_NEEDED = OFF_XCH + (size_t)128 * 4 * 256 * 4;

struct Params {
    const float* x_in; const float* norm_mix; const float* w_in; const float* wdu_f; const float* bd_f; const float* wdu_b; const float* bd_b;
    const float* gla_norm; const float* w_ga; const float* w_pool; const float* pool_scale; const float* w_out; const float* norm_ffn;
    const float* w_f1; const float* w_f2; const float* norm_final;
    float* xf; char* ws;
    int phase_lo, phase_hi;
};

typedef float f32x2 __attribute__((ext_vector_type(2)));
typedef __bf16 bf16x2_t __attribute__((ext_vector_type(2)));
__device__ __forceinline__ int bid_() { int v = __builtin_amdgcn_readfirstlane((int)blockIdx.x); asm volatile("" : "+s"(v)); return v; }
__device__ __forceinline__ int nblk_() { int v = __builtin_amdgcn_readfirstlane((int)gridDim.x); asm volatile("" : "+s"(v)); return v; }
__device__ __forceinline__ unsigned cvt_pk_bf16(float lo, float hi) { const f32x2 v = {lo, hi}; const bf16x2_t b = __builtin_convertvector(v, bf16x2_t); return __builtin_bit_cast(unsigned, b); }
__device__ __forceinline__ float bf2f(unsigned short b) { return __uint_as_float(((unsigned)b) << 16); }
__device__ __forceinline__ float bflo(unsigned w) { return __uint_as_float(w << 16); }
__device__ __forceinline__ float bfhi(unsigned w) { return __uint_as_float(w & 0xffff0000u); }
__device__ __forceinline__ unsigned short f2bf(float f) { return (unsigned short)(cvt_pk_bf16(f, 0.f) & 0xffffu); }
__device__ __forceinline__ float sigmoidf_(float x) { return __builtin_amdgcn_rcpf(1.f + __expf(-x)); }

namespace pg8 {
constexpr int BM = 256, BK = 64, HALF = 128, HTB = HALF * BK * 2, STAGE_BYTES = 8 * HTB, NXCD = 8, WGM = 8;
__device__ __forceinline__ int lds_byte(int r, int c) { const int st = (r >> 4) * 2 + (c >> 5), rr = r & 15, cc = c & 31, ob = rr * 64 + cc * 2; return st * 1024 + (ob ^ (((ob >> 9) & 1) << 5)); }
__device__ __forceinline__ void stage_rc(int b, int& R, int& C) { const int st = b / 1024, sb = b % 1024, swz = sb ^ (((sb >> 9) & 1) << 5); R = (st >> 1) * 16 + swz / 64; C = (st & 1) * 32 + (swz % 64) / 2; }
__device__ __forceinline__ int perm32(int rho) { const int n = rho >> 4, i = rho & 15; return 8 * (i >> 2) + 4 * n + (i & 3); }
struct Unit { int pm, pn; };
struct Gemm { const bf16_t* A; const bf16_t* Bt; int M, N, K, lda; };
struct StaticOrder {
    int nM, nN, nwg, G, c;
    __device__ void init(int M, int N, int G_, int c_) { nM = M / BM; nN = N / BM; nwg = nM * nN; G = G_; c = c_; }
    __device__ bool next(int i, Unit& u) const {
        const long L = (long)i * G + c; if (L >= nwg) return false;
        int wgid = (int)L; { const int q = nwg / NXCD, r = nwg % NXCD, xcd = wgid % NXCD, off = wgid / NXCD; wgid = (xcd < r ? xcd * (q + 1) : r * (q + 1) + (xcd - r) * q) + off; }
        const int nig = WGM * nN, gid = wgid / nig, fm = gid * WGM, gsz = (nM - fm) < WGM ? (nM - fm) : WGM;
        u.pm = fm + ((wgid % nig) % gsz); u.pn = (wgid % nig) / gsz; return true;
    }
};

template <class Epi, int APN = 0, bool ALIGN_EPI = true, bool SP2 = true>
__device__ __forceinline__ void gemm_phase(LAS unsigned char* lds, const Gemm g, const StaticOrder& S, const Epi& E) {
    int tid = threadIdx.x; asm volatile("" : "+v"(tid));
    const int wid = __builtin_amdgcn_readfirstlane(tid >> 6), lane = tid & 63, wr = wid >> 2, wc = wid & 3, fr = lane & 15, fq = lane >> 4;
    int K = g.K; asm volatile("" : "+s"(K));
    const int nt = K / BK;
    unsigned voffA[2], voffB[2];
#pragma unroll
    for (int i = 0; i < 2; ++i) { int R, C; stage_rc(tid * 16 + i * 8192, R, C); const int Rb = Epi::PERM ? ((R & ~31) + perm32(R & 31)) : R;
        voffA[i] = (unsigned)(R * g.lda + C) * 2u; voffB[i] = (unsigned)(Rb * K + C) * 2u; }
    const size_t kstep = (size_t)(BK * 2);
    const size_t hstepA = (size_t)HALF * g.lda * 2, hstepB = (size_t)HALF * K * 2;
    const size_t tstepA = 2 * hstepA, tstepB = 2 * hstepB;
    const unsigned ldsw = (unsigned)wid * 1024u;
    const int aoff = lds_byte(wr * 64 + fr, fq * 8), boff = lds_byte(wc * 32 + fr, fq * 8);
#define PG8_SA(b, h) (((b) * 2 + (h)) * HTB)
#define PG8_SB(b, h) ((4 + (b) * 2 + (h)) * HTB)
#define PG8_STAGE(bufoff, gbase, voff) do { _Pragma("unroll") for (int _i = 0; _i < 2; ++_i) \
        __builtin_amdgcn_global_load_lds((const unsigned*)((const char*)(gbase) + (voff)[_i]), (LAS unsigned*)(lds + (bufoff) + ldsw + _i * 8192), 16, 0, 0); } while (0)
#define PG8_LDA(dst, b, h) do { _Pragma("unroll") for (int m = 0; m < 4; ++m) _Pragma("unroll") for (int k = 0; k < 2; ++k) dst[m][k] = *(const LAS bf16x8*)(lds + PG8_SA(b, h) + aoff + m * 2048 + k * 1024); } while (0)
#define PG8_LDB(dst, b, h) do { _Pragma("unroll") for (int n = 0; n < 2; ++n) _Pragma("unroll") for (int k = 0; k < 2; ++k) dst[n][k] = *(const LAS bf16x8*)(lds + PG8_SB(b, h) + boff + n * 2048 + k * 1024); } while (0)
#define PG8_MMA(ai, bj, At, Bt) do { __builtin_amdgcn_s_setprio(1); _Pragma("unroll") for (int m = 0; m < 4; ++m) _Pragma("unroll") for (int n = 0; n < 2; ++n) _Pragma("unroll") for (int k = 0; k < 2; ++k) \
        acc[ai][bj][m][n] = __builtin_amdgcn_mfma_f32_16x16x32_bf16(Bt[n][k], At[m][k], acc[ai][bj][m][n], 0, 0, 0); __builtin_amdgcn_s_setprio(0); } while (0)
#define PG8_WAIT_V(n) asm volatile("s_waitcnt vmcnt(" #n ")" ::: "memory")
#define PG8_WAIT_L(n) asm volatile("s_waitcnt lgkmcnt(" #n ")" ::: "memory")
#define PG8_BAR __builtin_amdgcn_s_barrier()
#define PG8_SCHED __builtin_amdgcn_sched_barrier(0)
    Unit cur, nxt; int ui = 0;
    if (!S.next(0, cur)) return;
    f32x4 acc[2][2][4][2];
#pragma unroll
    for (int a = 0; a < 2; ++a)
#pragma unroll
        for (int b = 0; b < 2; ++b)
#pragma unroll
            for (int m = 0; m < 4; ++m)
#pragma unroll
                for (int n = 0; n < 2; ++n) acc[a][b][m][n] = (f32x4){0.f, 0.f, 0.f, 0.f};
    bf16x8 At[4][2], B0[2][2], B1[2][2];
    const char* cA = (const char*)g.A + (size_t)cur.pm * tstepA + (size_t)cur.pn * APN; const char* cB = (const char*)g.Bt + (size_t)cur.pn * tstepB;
    if constexpr (SP2) {
        PG8_STAGE(PG8_SB(0, 0), cB, voffB); PG8_STAGE(PG8_SB(0, 1), cB + hstepB, voffB); PG8_STAGE(PG8_SA(0, 0), cA, voffA); PG8_STAGE(PG8_SA(0, 1), cA + hstepA, voffA);
        if (wr == 1) PG8_BAR;
        PG8_WAIT_V(2); PG8_BAR;
        PG8_STAGE(PG8_SB(1, 0), cB + kstep, voffB); PG8_STAGE(PG8_SA(1, 0), cA + kstep, voffA); PG8_STAGE(PG8_SB(1, 1), cB + hstepB + kstep, voffB);
        PG8_WAIT_V(6); PG8_BAR;
    } else {
        PG8_STAGE(PG8_SB(0, 0), cB, voffB); PG8_STAGE(PG8_SA(0, 0), cA, voffA); PG8_STAGE(PG8_SB(0, 1), cB + hstepB, voffB); PG8_STAGE(PG8_SA(0, 1), cA + hstepA, voffA);
        if (wr == 1) PG8_BAR;
        PG8_WAIT_V(4); PG8_BAR;
        PG8_STAGE(PG8_SB(1, 0), cB + kstep, voffB); PG8_STAGE(PG8_SA(1, 0), cA + kstep, voffA); PG8_STAGE(PG8_SB(1, 1), cB + hstepB + kstep, voffB);
        PG8_WAIT_V(6); PG8_BAR;
    }
    for (;;) {
        const bool has_next = S.next(ui + 1, nxt);
        const unsigned rsoff = (unsigned)STAGE_BYTES + (unsigned)(ui & 1) * 1024u;
        if constexpr (Epi::NEEDS_RS) { if (wid < 4) __builtin_amdgcn_global_load_lds((const unsigned*)(E.rsv + cur.pm * 256 + wid * 64 + lane), (LAS unsigned*)(lds + rsoff + wid * 256), 4, 0, 0); }
        const char* nA = has_next ? (const char*)g.A + (size_t)nxt.pm * tstepA + (size_t)nxt.pn * APN : cA; const char* nB = has_next ? (const char*)g.Bt + (size_t)nxt.pn * tstepB : cB;
        for (int t = 0; t < nt; t += 2) {
            const bool last = (t == nt - 2);
            const char* a1 = cA + (size_t)(t + 1) * kstep;
            const char* a2 = last ? nA : cA + (size_t)(t + 2) * kstep; const char* b2 = last ? nB : cB + (size_t)(t + 2) * kstep;
            const char* a3 = a2 + kstep; const char* b3 = b2 + kstep;
            if constexpr (SP2) {
            const bool b1 = !(Epi::LR_TILE && cur.pn == 14);
            PG8_LDB(B0, 0, 0); PG8_LDB(B1, 0, 1); PG8_SCHED; PG8_LDA(At, 0, 0); PG8_STAGE(PG8_SA(1, 1), a1 + hstepA, voffA);
            PG8_WAIT_V(8); PG8_WAIT_L(0); PG8_BAR; PG8_MMA(0, 0, At, B0); if (b1) PG8_MMA(0, 1, At, B1); PG8_BAR; PG8_SCHED;
            PG8_LDA(At, 0, 1); PG8_STAGE(PG8_SB(0, 0), b2, voffB); PG8_STAGE(PG8_SB(0, 1), b2 + hstepB, voffB); PG8_STAGE(PG8_SA(0, 0), a2, voffA);
            PG8_WAIT_V(8); PG8_WAIT_L(0); PG8_BAR; PG8_MMA(1, 0, At, B0); if (b1) PG8_MMA(1, 1, At, B1); PG8_BAR; PG8_SCHED;
            PG8_LDB(B0, 1, 0); PG8_LDB(B1, 1, 1); PG8_SCHED; PG8_LDA(At, 1, 0); PG8_STAGE(PG8_SA(0, 1), a2 + hstepA, voffA);
            PG8_WAIT_V(8); PG8_WAIT_L(0); PG8_BAR; PG8_MMA(0, 0, At, B0); if (b1) PG8_MMA(0, 1, At, B1); PG8_BAR; PG8_SCHED;
            PG8_LDA(At, 1, 1); PG8_STAGE(PG8_SB(1, 0), b3, voffB); PG8_STAGE(PG8_SB(1, 1), b3 + hstepB, voffB); PG8_STAGE(PG8_SA(1, 0), a3, voffA);
            PG8_WAIT_V(8); PG8_WAIT_L(0); PG8_BAR; PG8_MMA(1, 0, At, B0); if (b1) PG8_MMA(1, 1, At, B1); PG8_BAR; PG8_SCHED;
            } else {
            PG8_LDB(B0, 0, 0); PG8_SCHED; PG8_LDA(At, 0, 0); PG8_STAGE(PG8_SA(1, 1), a1 + hstepA, voffA);
            PG8_WAIT_L(8); PG8_BAR; PG8_WAIT_L(0); PG8_MMA(0, 0, At, B0); PG8_BAR; PG8_SCHED;
            PG8_LDB(B1, 0, 1); PG8_STAGE(PG8_SB(0, 0), b2, voffB);
            PG8_BAR; PG8_WAIT_L(0); PG8_MMA(0, 1, At, B1); PG8_BAR;
            PG8_LDA(At, 0, 1); PG8_STAGE(PG8_SA(0, 0), a2, voffA);
            PG8_BAR; PG8_WAIT_L(0); PG8_MMA(1, 0, At, B0); PG8_BAR; PG8_SCHED;
            PG8_STAGE(PG8_SB(0, 1), b2 + hstepB, voffB);
            PG8_WAIT_V(6); PG8_BAR; PG8_MMA(1, 1, At, B1); PG8_BAR;
            PG8_LDB(B0, 1, 0); PG8_SCHED; PG8_LDA(At, 1, 0); PG8_STAGE(PG8_SA(0, 1), a2 + hstepA, voffA);
            PG8_WAIT_L(8); PG8_BAR; PG8_WAIT_L(0); PG8_MMA(0, 0, At, B0); PG8_BAR; PG8_SCHED;
            PG8_LDB(B1, 1, 1); PG8_STAGE(PG8_SB(1, 0), b3, voffB);
            PG8_BAR; PG8_WAIT_L(0); PG8_MMA(0, 1, At, B1); PG8_BAR;
            PG8_LDA(At, 1, 1); PG8_STAGE(PG8_SA(1, 0), a3, voffA);
            PG8_BAR; PG8_WAIT_L(0); PG8_MMA(1, 0, At, B0); PG8_BAR; PG8_SCHED;
            PG8_STAGE(PG8_SB(1, 1), b3 + hstepB, voffB);
            PG8_WAIT_V(6); PG8_BAR; PG8_MMA(1, 1, At, B1); PG8_BAR;
            }
        }
        if constexpr (ALIGN_EPI) { if (wr == 0) PG8_BAR; }
        E(acc, cur, wr, wc, fr, fq, (const LAS float*)(lds + rsoff));
        if (!has_next) break;
#pragma unroll
        for (int a = 0; a < 2; ++a)
#pragma unroll
            for (int b = 0; b < 2; ++b)
#pragma unroll
                for (int m = 0; m < 4; ++m)
#pragma unroll
                    for (int n = 0; n < 2; ++n) acc[a][b][m][n] = (f32x4){0.f, 0.f, 0.f, 0.f};
        cur = nxt; cA = nA; cB = nB; ++ui;
        if constexpr (ALIGN_EPI) { if (wr == 1) PG8_BAR; }
    }
    PG8_WAIT_V(0);
    if constexpr (!ALIGN_EPI) { if (wr == 0) PG8_BAR; }
    PG8_BAR;
#undef PG8_SA
#undef PG8_SB
#undef PG8_STAGE
#undef PG8_LDA
#undef PG8_LDB
#undef PG8_MMA
#undef PG8_WAIT_V
#undef PG8_WAIT_L
#undef PG8_BAR
#undef PG8_SCHED
}
}
using pg8::Unit;

__device__ __forceinline__ float rowscale(const float* ssq, int row) {
    const f32x4* s = (const f32x4*)(ssq + (size_t)row * 16);
    const f32x4 a = s[0], b = s[1], c = s[2], d = s[3];
    const float t = ((a[0] + a[1]) + (a[2] + a[3])) + ((b[0] + b[1]) + (b[2] + b[3])) + ((c[0] + c[1]) + (c[2] + c[3])) + ((d[0] + d[1]) + (d[2] + d[3]));
    return rsqrtf(t * (1.f / 1024.f) + 1e-6f);
}
__device__ __forceinline__ u32x4 pack8(const f32x4 v0, const f32x4 v1) {
    u32x4 w; w.x = cvt_pk_bf16(v0[0], v0[1]); w.y = cvt_pk_bf16(v0[2], v0[3]); w.z = cvt_pk_bf16(v1[0], v1[1]); w.w = cvt_pk_bf16(v1[2], v1[3]); return w;
}

struct EpiA {
    static constexpr bool PERM = true;
    static constexpr bool LR_TILE = true;
    static constexpr bool NEEDS_RS = true; const float* rsv;
    bf16_t* P; bf16_t* lr; const float* ssq;
    __device__ __forceinline__ void operator()(const f32x4 (&acc)[2][2][4][2], const Unit& u, int wr, int wc, int fr, int fq, const LAS float* rsl) const {
        const int row0 = u.pm * 256 + wr * 64 + fr;
#pragma unroll
        for (int ai = 0; ai < 2; ++ai)
#pragma unroll
            for (int m = 0; m < 4; ++m) {
                const int row = row0 + ai * 128 + m * 16; const float rs = rsl[ai * 128 + wr * 64 + m * 16 + fr];
                if (u.pn < 14) {
#pragma unroll
                    for (int bj = 0; bj < 2; ++bj) {
                        const f32x4 v0 = acc[ai][bj][m][0] * rs, v1 = acc[ai][bj][m][1] * rs;
                        *(u32x4*)(P + (size_t)row * PW + u.pn * 256 + bj * 128 + wc * 32 + 8 * fq) = pack8(v0, v1);
                    }
                } else if (wc == 0) {
                    const f32x4 v0 = acc[ai][0][m][0] * rs, v1 = acc[ai][0][m][1] * rs;
                    const u32x4 hi = pack8(v0, v1);
                    const f32x4 d0 = (f32x4){v0[0] - bflo(hi.x), v0[1] - bfhi(hi.x), v0[2] - bflo(hi.y), v0[3] - bfhi(hi.y)};
                    const f32x4 d1 = (f32x4){v1[0] - bflo(hi.z), v1[1] - bfhi(hi.z), v1[2] - bflo(hi.w), v1[3] - bfhi(hi.w)};
                    bf16_t* lp = lr + (size_t)row * 64 + (fq >> 1) * 32 + (fq & 1) * 8;
                    *(u32x4*)lp = hi; *(u32x4*)(lp + 16) = pack8(d0, d1);
                }
            }
    }
};
struct EpiGate {
    static constexpr bool PERM = true;
    static constexpr bool LR_TILE = false;
    static constexpr bool NEEDS_RS = true; const float* rsv;
    bf16_t* P; const float* ssq;
    __device__ __forceinline__ void operator()(const f32x4 (&acc)[2][2][4][2], const Unit& u, int wr, int wc, int fr, int fq, const LAS float* rsl) const {
        const int row0 = u.pm * 256 + wr * 64 + fr;
#pragma unroll
        for (int ai = 0; ai < 2; ++ai)
#pragma unroll
            for (int m = 0; m < 4; ++m) {
                const int row = row0 + ai * 128 + m * 16; const float rs = rsl[ai * 128 + wr * 64 + m * 16 + fr];
#pragma unroll
                for (int bj = 0; bj < 2; ++bj) {
                    f32x4 v0 = acc[ai][bj][m][0] * rs, v1 = acc[ai][bj][m][1] * rs;
#pragma unroll
                    for (int j = 0; j < 4; ++j) { v0[j] = sigmoidf_(v0[j]); v1[j] = sigmoidf_(v1[j]); }
                    *(u32x4*)(P + (size_t)row * PW + u.pn * 256 + bj * 128 + wc * 32 + 8 * fq) = pack8(v0, v1);
                }
                asm volatile("" ::: "memory");
            }
    }
};
struct EpiPool {
    static constexpr bool PERM = true;
    static constexpr bool LR_TILE = false;
    static constexpr bool NEEDS_RS = false;
    bf16_t* P; const float* pscale;
    __device__ __forceinline__ void operator()(const f32x4 (&acc)[2][2][4][2], const Unit& u, int wr, int wc, int fr, int fq, const LAS float* rsl) const {
        const int row0 = u.pm * 256 + wr * 64 + fr;
#pragma unroll
        for (int bj = 0; bj < 2; ++bj) {
            const int col = u.pn * 256 + bj * 128 + wc * 32 + 8 * fq;
            const f32x4 p0 = *(const f32x4*)(pscale + col), p1 = *(const f32x4*)(pscale + col + 4);
#pragma unroll
            for (int ai = 0; ai < 2; ++ai)
#pragma unroll
                for (int m = 0; m < 4; ++m) {
                    const int row = row0 + ai * 128 + m * 16;
                    bf16_t* ptr = P + (size_t)row * PW + 1024 + col;
                    const u32x4 g = *(const u32x4*)ptr;
                    f32x4 v0 = acc[ai][bj][m][0] * p0, v1 = acc[ai][bj][m][1] * p1;
                    v0[0] *= bflo(g.x); v0[1] *= bfhi(g.x); v0[2] *= bflo(g.y); v0[3] *= bfhi(g.y);
                    v1[0] *= bflo(g.z); v1[1] *= bfhi(g.z); v1[2] *= bflo(g.w); v1[3] *= bfhi(g.w);
                    *(u32x4*)ptr = pack8(v0, v1);
                    if (m & 1) asm volatile("" ::: "memory");
                }
        }
    }
};
struct EpiMerge {
    static constexpr bool PERM = true;
    static constexpr bool LR_TILE = false;
    static constexpr bool NEEDS_RS = false;
    bf16_t* P;
    __device__ __forceinline__ void operator()(const f32x4 (&acc)[2][2][4][2], const Unit& u, int wr, int wc, int fr, int fq, const LAS float* rsl) const {
        const int row0 = u.pm * 256 + wr * 64 + fr;
#pragma unroll
        for (int ai = 0; ai < 2; ++ai)
#pragma unroll
            for (int m = 0; m < 4; ++m) {
                const int row = row0 + ai * 128 + m * 16;
#pragma unroll
                for (int bj = 0; bj < 2; ++bj) {
                    bf16_t* ptr = P + (size_t)row * PW + u.pn * 256 + bj * 128 + wc * 32 + 8 * fq;
                    const u32x4 g = *(const u32x4*)ptr; const u32x4 t = *(const u32x4*)(ptr + 1024);
                    f32x4 v0 = acc[ai][bj][m][0], v1 = acc[ai][bj][m][1];
                    v0[0] = v0[0] * bflo(g.x) + bflo(t.x); v0[1] = v0[1] * bfhi(g.x) + bfhi(t.x); v0[2] = v0[2] * bflo(g.y) + bflo(t.y); v0[3] = v0[3] * bfhi(g.y) + bfhi(t.y);
                    v1[0] = v1[0] * bflo(g.z) + bflo(t.z); v1[1] = v1[1] * bfhi(g.z) + bfhi(t.z); v1[2] = v1[2] * bflo(g.w) + bflo(t.w); v1[3] = v1[3] * bfhi(g.w) + bfhi(t.w);
                    *(u32x4*)ptr = pack8(v0, v1);
                }
                asm volatile("" ::: "memory");
            }
    }
};
struct EpiRes {
    static constexpr bool PERM = true;
    static constexpr bool LR_TILE = false;
    static constexpr bool NEEDS_RS = false;
    bf16_t* xb; float* ssq;
    __device__ __forceinline__ void operator()(const f32x4 (&acc)[2][2][4][2], const Unit& u, int wr, int wc, int fr, int fq, const LAS float* rsl) const {
        const int row0 = u.pm * 256 + wr * 64 + fr;
#pragma unroll
        for (int ai = 0; ai < 2; ++ai)
#pragma unroll
            for (int m = 0; m < 4; ++m) {
                const int row = row0 + ai * 128 + m * 16; float s = 0.f;
#pragma unroll
                for (int bj = 0; bj < 2; ++bj) {
                    bf16_t* ptr = xb + (size_t)row * 1024 + u.pn * 256 + bj * 128 + wc * 32 + 8 * fq;
                    const u32x4 g = *(const u32x4*)ptr;
                    f32x4 v0 = acc[ai][bj][m][0], v1 = acc[ai][bj][m][1];
                    v0[0] += bflo(g.x); v0[1] += bfhi(g.x); v0[2] += bflo(g.y); v0[3] += bfhi(g.y);
                    v1[0] += bflo(g.z); v1[1] += bfhi(g.z); v1[2] += bflo(g.w); v1[3] += bfhi(g.w);
                    *(u32x4*)ptr = pack8(v0, v1);
                    s += (v0[0] * v0[0] + v0[1] * v0[1]) + (v0[2] * v0[2] + v0[3] * v0[3]) + (v1[0] * v1[0] + v1[1] * v1[1]) + (v1[2] * v1[2] + v1[3] * v1[3]);
                }
                s += __shfl_xor(s, 16); s += __shfl_xor(s, 32);
                if (fq == 0) ssq[(size_t)row * 16 + u.pn * 4 + wc] = s;
            }
    }
};
struct EpiResFinal {
    static constexpr bool PERM = true;
    static constexpr bool LR_TILE = false;
    static constexpr bool NEEDS_RS = false;
    char* ws; LAS unsigned char* lx;
    __device__ __forceinline__ void operator()(const f32x4 (&acc)[2][2][4][2], const Unit& u, int wr, int wc, int fr, int fq, const LAS float* rsl) const {
        const int row0 = u.pm * 256 + wr * 64 + fr, tid = threadIdx.x;
        const Params __attribute__((address_space(4)))* kp = (const Params __attribute__((address_space(4)))*)__builtin_amdgcn_kernarg_segment_ptr();
        const bf16_t* xb = (const bf16_t*)(ws + OFF_XB); float* out = kp->xf; const float* gfin = kp->norm_final;
        float* xch = (float*)(ws + OFF_XCH); unsigned* cnt = (unsigned*)(ws + OFF_BAR) + 6144;
#pragma unroll
        for (int ai = 0; ai < 2; ++ai) {
#pragma unroll
            for (int m = 0; m < 4; ++m) { float s = 0.f;
                u32x4 g2[2];
#pragma unroll
                for (int bj = 0; bj < 2; ++bj) g2[bj] = *(const u32x4*)(xb + (size_t)(row0 + ai * 128 + m * 16) * 1024 + u.pn * 256 + bj * 128 + wc * 32 + 8 * fq);
#pragma unroll
                for (int bj = 0; bj < 2; ++bj) { const u32x4 gg = g2[bj]; f32x4 v0 = acc[ai][bj][m][0], v1 = acc[ai][bj][m][1];
                    v0[0] += bflo(gg.x); v0[1] += bfhi(gg.x); v0[2] += bflo(gg.y); v0[3] += bfhi(gg.y); v1[0] += bflo(gg.z); v1[1] += bfhi(gg.z); v1[2] += bflo(gg.w); v1[3] += bfhi(gg.w);
                    s += (v0[0] * v0[0] + v0[1] * v0[1]) + (v0[2] * v0[2] + v0[3] * v0[3]) + (v1[0] * v1[0] + v1[1] * v1[1]) + (v1[2] * v1[2] + v1[3] * v1[3]); }
                s += __shfl_xor(s, 16); s += __shfl_xor(s, 32);
                if (fq == 0) *(LAS float*)(lx + ((ai * 128 + wr * 64 + m * 16 + fr) * 4 + wc) * 4) = s;
                if (m & 1) asm volatile("" ::: "memory"); }
        }
        __builtin_amdgcn_s_waitcnt(0xc07f);
        __builtin_amdgcn_s_barrier();
        if (tid < 256) { const f32x4 q = *(LAS f32x4*)(lx + tid * 16);
            __hip_atomic_store(xch + (size_t)(u.pm * 4 + u.pn) * 256 + tid, (q[0] + q[1]) + (q[2] + q[3]), __ATOMIC_RELAXED, __HIP_MEMORY_SCOPE_AGENT); }
        asm volatile("s_waitcnt vmcnt(0)" ::: "memory");
        __builtin_amdgcn_s_barrier();
        if (tid == 0) { __hip_atomic_fetch_add(cnt + 16 * u.pm, 1u, __ATOMIC_RELAXED, __HIP_MEMORY_SCOPE_AGENT);
            unsigned polls = 0; while (__hip_atomic_load(cnt + 16 * u.pm, __ATOMIC_RELAXED, __HIP_MEMORY_SCOPE_AGENT) < 4u && ++polls < (1u << 22)) __builtin_amdgcn_s_sleep(1); }
        __builtin_amdgcn_s_barrier();
        if (tid < 256) { float t = 0.f;
#pragma unroll
            for (int j = 0; j < 4; ++j) t += __hip_atomic_load(xch + (size_t)(u.pm * 4 + j) * 256 + tid, __ATOMIC_RELAXED, __HIP_MEMORY_SCOPE_AGENT);
            *(LAS float*)(lx + 4096 + tid * 4) = rsqrtf(t * (1.f / 1024.f) + 1e-6f); }
        __builtin_amdgcn_s_waitcnt(0xc07f);
        __builtin_amdgcn_s_barrier();
        f32x4 wf[2][2];
#pragma unroll
        for (int bj = 0; bj < 2; ++bj) { const int col = u.pn * 256 + bj * 128 + wc * 32 + 8 * fq; wf[bj][0] = *(const f32x4*)(gfin + col); wf[bj][1] = *(const f32x4*)(gfin + col + 4); }
#pragma unroll
        for (int ai = 0; ai < 2; ++ai)
#pragma unroll
            for (int m = 0; m < 4; ++m) { const float rs = *(LAS float*)(lx + 4096 + (ai * 128 + wr * 64 + m * 16 + fr) * 4);
                u32x4 g2[2];
#pragma unroll
                for (int bj = 0; bj < 2; ++bj) g2[bj] = *(const u32x4*)(xb + (size_t)(row0 + ai * 128 + m * 16) * 1024 + u.pn * 256 + bj * 128 + wc * 32 + 8 * fq);
#pragma unroll
                for (int bj = 0; bj < 2; ++bj) { const u32x4 gg = g2[bj]; f32x4 v0 = acc[ai][bj][m][0], v1 = acc[ai][bj][m][1];
                    v0[0] += bflo(gg.x); v0[1] += bfhi(gg.x); v0[2] += bflo(gg.y); v0[3] += bfhi(gg.y); v1[0] += bflo(gg.z); v1[1] += bfhi(gg.z); v1[2] += bflo(gg.w); v1[3] += bfhi(gg.w);
                    float* op = out + (size_t)(row0 + ai * 128 + m * 16) * 1024 + u.pn * 256 + bj * 128 + wc * 32 + 8 * fq;
                    *(f32x4*)op = v0 * rs * wf[bj][0]; *(f32x4*)(op + 4) = v1 * rs * wf[bj][1]; }
                if (m & 1) asm volatile("" ::: "memory"); }
    }
};
struct EpiFfn1 {
    static constexpr bool PERM = true;
    static constexpr bool LR_TILE = false;
    static constexpr bool NEEDS_RS = true; const float* rsv;
    bf16_t* ACT; const float* ssq;
    __device__ __forceinline__ void operator()(const f32x4 (&acc)[2][2][4][2], const Unit& u, int wr, int wc, int fr, int fq, const LAS float* rsl) const {
        const int row0 = u.pm * 256 + wr * 64 + fr;
#pragma unroll
        for (int ai = 0; ai < 2; ++ai)
#pragma unroll
            for (int m = 0; m < 4; ++m) {
                const int row = row0 + ai * 128 + m * 16; const float rs = rsl[ai * 128 + wr * 64 + m * 16 + fr];
                f32x4 o[2];
#pragma unroll
                for (int n = 0; n < 2; ++n)
#pragma unroll
                    for (int j = 0; j < 4; ++j) { const float gt = acc[ai][0][m][n][j] * rs, up = acc[ai][1][m][n][j] * rs; o[n][j] = gt * sigmoidf_(gt) * up; }
                *(u32x4*)(ACT + (size_t)row * DFF + u.pn * 128 + wc * 32 + 8 * fq) = pack8(o[0], o[1]);
                asm volatile("" ::: "memory");
            }
    }
};

struct WJob { const float* src; const float* g; bf16_t* dst; int ld, ldd, vlo, vhi, kw; };
__device__ __forceinline__ WJob wjob_decode(const Params& p, int layer, int j) {
    WJob w; w.g = nullptr; w.vlo = 0; w.vhi = 256; w.kw = 256;
    bf16_t* W = (bf16_t*)(p.ws + OFF_W + (size_t)layer * SZ_WLAYER);
    if (j < 480) { const int nb = j >> 2, kb = j & 3, n0 = nb * 32; int c0;
        if (n0 < 3072) c0 = n0; else if (n0 < 3584) c0 = 3104 + (n0 - 3072); else if (n0 == 3584) c0 = 3072; else { c0 = 0; w.vhi = 0; }
        w.src = p.w_in + (size_t)layer * 1024 * INW + (size_t)kb * 256 * INW + c0; w.ld = INW; w.g = p.norm_mix + layer * 1024 + kb * 256;
        w.dst = (bf16_t*)((char*)W + WO_A) + (size_t)n0 * 1024 + kb * 256; w.ldd = 1024; return w; }
    j -= 480;
    if (j < 256) { const int nb = j >> 2, kb = j & 3, n0 = nb * 32;
        w.src = p.w_in + (size_t)layer * 1024 * INW + (size_t)kb * 256 * INW + 3616 + n0; w.ld = INW; w.g = p.norm_mix + layer * 1024 + kb * 256;
        w.dst = (bf16_t*)((char*)W + WO_B) + (size_t)n0 * 1024 + kb * 256; w.ldd = 1024; return w; }
    j -= 256;
    if (j < 128) { const int nb = j >> 2, kb = j & 3, n0 = nb * 32;
        w.src = p.w_ga + (size_t)layer * 1024 * 1024 + (size_t)kb * 256 * 1024 + n0; w.ld = 1024;
        w.dst = (bf16_t*)((char*)W + WO_GA) + (size_t)n0 * 1024 + kb * 256; w.ldd = 1024; return w; }
    j -= 128;
    if (j < 64) { const int nb = j >> 1, kb = j & 1, n0 = nb * 32, grp = n0 >> 8;
        w.src = p.w_pool + (size_t)layer * 4 * 128 * 256 + (size_t)grp * 128 * 256 + (n0 & 255); w.ld = 256;
        w.vlo = 0; w.vhi = kb == 0 ? 128 : 0; w.kw = kb == 0 ? 128 : 0;
        w.dst = (bf16_t*)((char*)W + WO_POOL) + (size_t)n0 * 128; w.ldd = 128; return w; }
    j -= 64;
    if (j < 128) { const int nb = j >> 2, kb = j & 3, n0 = nb * 32;
        w.src = p.w_out + (size_t)layer * 1024 * 1024 + (size_t)kb * 256 * 1024 + n0; w.ld = 1024;
        w.dst = (bf16_t*)((char*)W + WO_OUT) + (size_t)n0 * 1024 + kb * 256; w.ldd = 1024; return w; }
    j -= 128;
    if (j < 704) { const int nb = j >> 2, kb = j & 3, n0 = nb * 32, pn = n0 >> 8, within = n0 & 255;
        const int c0 = within < 128 ? 128 * pn + within : DFF + 128 * pn + (within - 128);
        w.src = p.w_f1 + (size_t)layer * 1024 * 2 * DFF + (size_t)kb * 256 * 2 * DFF + c0; w.ld = 2 * DFF; w.g = p.norm_ffn + layer * 1024 + kb * 256;
        w.dst = (bf16_t*)((char*)W + WO_F1) + (size_t)n0 * 1024 + kb * 256; w.ldd = 1024; return w; }
    j -= 704;
    { const int nb = j / 11, kb = j % 11, n0 = nb * 32;
        w.src = p.w_f2 + (size_t)layer * DFF * 1024 + (size_t)kb * 256 * 1024 + n0; w.ld = 1024;
        w.dst = (bf16_t*)((char*)W + WO_F2) + (size_t)n0 * DFF + kb * 256; w.ldd = DFF; return w; }
}

__device__ __forceinline__ void phase_prep(LAS unsigned char* lds, const Params& p) {
    int tid = threadIdx.x; asm volatile("" : "+v"(tid));
    const int wid = tid >> 6, lane = tid & 63;
    {
        f32x4 v[4]; WJob w, wn; int buf = 0;
#define PREP_LOAD(W_) do { _Pragma("unroll") for (int ps = 0; ps < 4; ++ps) { const int kk = (tid >> 3) + 64 * ps, c4 = (tid & 7) * 4; \
            v[ps] = (f32x4){0.f, 0.f, 0.f, 0.f}; \
            if (kk >= (W_).vlo && kk < (W_).vhi) { v[ps] = *(const f32x4*)((W_).src + (size_t)kk * (W_).ld + c4); if ((W_).g) v[ps] = v[ps] * (W_).g[kk]; } } } while (0)
        int job = bid_();
        if (job < 2 * 2112) { w = wjob_decode(p, job / 2112, job % 2112); PREP_LOAD(w); }
        for (; job < 2 * 2112; job += nblk_()) {
            const int tb = buf * 33792;
#pragma unroll
            for (int ps = 0; ps < 4; ++ps) { const int kk = (tid >> 3) + 64 * ps, c4 = (tid & 7) * 4;
#pragma unroll
                for (int e = 0; e < 4; ++e) *(LAS float*)(lds + tb + (kk * 33 + c4 + e) * 4) = v[ps][e]; }
            __syncthreads();
            const int nj = job + nblk_();
            if (nj < 2 * 2112) { wn = wjob_decode(p, nj / 2112, nj % 2112); PREP_LOAD(wn); }
            { const int n = tid & 31, s = tid >> 5; unsigned pk[8];
#pragma unroll
                for (int e = 0; e < 8; ++e) { const float a = *(LAS float*)(lds + tb + ((s * 16 + 2 * e) * 33 + n) * 4), b = *(LAS float*)(lds + tb + ((s * 16 + 2 * e + 1) * 33 + n) * 4); pk[e] = cvt_pk_bf16(a, b); }
                bf16_t* d = w.dst + (size_t)n * w.ldd + s * 16;
                if (s * 16 < w.kw) { *(u32x4*)d = (u32x4){pk[0], pk[1], pk[2], pk[3]}; *(u32x4*)(d + 8) = (u32x4){pk[4], pk[5], pk[6], pk[7]}; } }
            w = wn; buf ^= 1;
        }
#undef PREP_LOAD
        __syncthreads();
    }
    bf16_t* xb = (bf16_t*)(p.ws + OFF_XB); float* ssq = (float*)(p.ws + OFF_SSQ);
    for (int row0 = bid_() * 8 + wid; row0 < T_TOK; row0 += nblk_() * 16) {
        f32x4 v[2][4]; bool ok[2];
#pragma unroll
        for (int u = 0; u < 2; ++u) { const int row = row0 + u * nblk_() * 8; ok[u] = row < T_TOK;
            if (ok[u]) { const float* src = p.x_in + (size_t)row * 1024 + lane * 16;
#pragma unroll
                for (int i = 0; i < 4; ++i) v[u][i] = *(const f32x4*)(src + 4 * i); } }
#pragma unroll
        for (int u = 0; u < 2; ++u) if (ok[u]) { const int row = row0 + u * nblk_() * 8;
            float s = 0.f;
#pragma unroll
            for (int i = 0; i < 4; ++i) s += (v[u][i][0] * v[u][i][0] + v[u][i][1] * v[u][i][1]) + (v[u][i][2] * v[u][i][2] + v[u][i][3] * v[u][i][3]);
#pragma unroll
            for (int o = 32; o >= 1; o >>= 1) s += __shfl_xor(s, o);
            bf16_t* dst = xb + (size_t)row * 1024 + lane * 16;
            *(u32x4*)dst = pack8(v[u][0], v[u][1]); *(u32x4*)(dst + 8) = pack8(v[u][2], v[u][3]);
            if (lane < 16) ssq[(size_t)row * 16 + lane] = lane == 0 ? s : 0.f;
            if (lane == 0) ((float*)(p.ws + OFF_RS))[row] = rsqrtf(s * (1.f / 1024.f) + 1e-6f); }
    }
}

#define MFMA16(a, b, c) __builtin_amdgcn_mfma_f32_16x16x32_bf16((a), (b), (c), 0, 0, 0)
template <bool PASS2>
__device__ __forceinline__ void gla_pass(LAS unsigned char* lds, const Params& p, int layer) {
    constexpr int SQ = 0, SK = 17408, SV = 35840, SP = 69632, SLR = 78848, SDEC = 84992, SST = 85504, SX = SST, SCOL = SST + 33792;
    int tid = threadIdx.x; asm volatile("" : "+v"(tid));
    const int wid = __builtin_amdgcn_readfirstlane(tid >> 6), lane = tid & 63, fr = lane & 15, fq = lane >> 4;
    const int dk0 = (tid & 63) * 2;
    bf16_t* P = (bf16_t*)(p.ws + OFF_PROJ);
    const bf16_t* LR = (const bf16_t*)(p.ws + OFF_LR);
    bf16_t* QT = (bf16_t*)(p.ws + OFF_E + (size_t)32 * 1024 * 1024);
    bf16_t* O = (bf16_t*)(p.ws + OFF_O);
    for (int item = bid_(); item < 256; item += nblk_()) {
        const int b = item >> 7, h = (item >> 5) & 3, grp = item & 31;
#pragma unroll 1
        for (int dir = 0; dir < 2; ++dir) {
            const int scan = (b * 4 + h) * 2 + dir;
            bf16x8 wB1, wB2; float biasx;
            { const float* Wc = (dir ? p.wdu_b : p.wdu_f) + (size_t)layer * 16 * 512 + h * 128 + wid * 16 + fr;
              float wv[8]; unsigned h1[4], h2[4];
#pragma unroll
              for (int j = 0; j < 8; ++j) wv[j] = Wc[((fq & 1) * 8 + j) * 512];
#pragma unroll
              for (int jp = 0; jp < 4; ++jp) { const float a = wv[2 * jp], bq = wv[2 * jp + 1]; const unsigned hi = cvt_pk_bf16(a, bq);
                  const unsigned lo = cvt_pk_bf16(a - bflo(hi), bq - bfhi(hi)); h1[jp] = hi; h2[jp] = fq < 2 ? lo : 0u; }
              wB1 = __builtin_bit_cast(bf16x8, (u32x4){h1[0], h1[1], h1[2], h1[3]}); wB2 = __builtin_bit_cast(bf16x8, (u32x4){h2[0], h2[1], h2[2], h2[3]});
              biasx = (dir ? p.bd_b : p.bd_f)[layer * 512 + h * 128 + wid * 16 + fr]; }
            f32x4 accS[8][2];
#pragma unroll
            for (int m8 = 0; m8 < 8; ++m8)
#pragma unroll
                for (int n = 0; n < 2; ++n) accS[m8][n] = (f32x4){0.f, 0.f, 0.f, 0.f};
            float gtot0 = 0.f, gtot1 = 0.f;
            u32x4 rk[2], rq[2], rv[4]; u32x4 rl = (u32x4){0u, 0u, 0u, 0u};
#define GLA_ISSUE(CC) do { const int chunk_ = dir ? 7 - (CC) : (CC); const int t0_ = b * SEQL + grp * 512 + chunk_ * 64; \
                _Pragma("unroll") for (int it = 0; it < 2; ++it) { const int pi = tid + 512 * it, row = pi >> 4, seg = pi & 15; \
                    const bf16_t* src = P + (size_t)(t0_ + row) * PW + h * 128 + seg * 8; rk[it] = *(const u32x4*)(src + 512); } \
                if (tid < 256) { const int row = tid >> 2, seg = tid & 3; rl = *(const u32x4*)(LR + (size_t)(t0_ + row) * 64 + dir * 32 + seg * 8); } } while (0)
            GLA_ISSUE(0);
#pragma unroll 1
            for (int cc = 0; cc < 8; ++cc) {
                const int chunk = dir ? 7 - cc : cc;
                const int t0 = b * SEQL + grp * 512 + chunk * 64;
#pragma unroll
                for (int it = 0; it < 2; ++it) { const int pi = tid + 512 * it, row = pi >> 4, seg = pi & 15;
                    *(LAS u32x4*)(lds + SK + row * 272 + seg * 16) = rk[it];
                    if (PASS2) rq[it] = *(const u32x4*)(P + (size_t)(t0 + row) * PW + h * 128 + seg * 8); }
#pragma unroll
                for (int it = 0; it < 4; ++it) { const int pi = tid + 512 * it, row = pi >> 5, seg = pi & 31;
                    rv[it] = *(const u32x4*)(P + (size_t)(t0 + row) * PW + 1024 + h * 256 + seg * 8); }
                if (tid < 256) { const int row = tid >> 2, seg = tid & 3; *(LAS u32x4*)(lds + SLR + row * 64 + seg * 16) = rl; }
                __syncthreads();
#pragma unroll 1
                for (int m = 0; m < 4; ++m) {
                    const bf16x8 A = *(LAS bf16x8*)(lds + SLR + (m * 16 + fr) * 64 + fq * 16);
                    f32x4 xx = (f32x4){0.f, 0.f, 0.f, 0.f};
                    xx = MFMA16(A, wB1, xx); xx = MFMA16(A, wB2, xx);
#pragma unroll
                    for (int jj = 0; jj < 4; ++jj) { const float x = xx[jj] + biasx; const float ls = fminf(x, 0.f) - __logf(1.f + __expf(-fabsf(x)));
                        *(LAS float*)(lds + SX + ((m * 16 + 4 * fq + jj) * 132 + wid * 16 + fr) * 4) = ls * 0.0625f; }
                }
                if (PASS2) {
#pragma unroll
                    for (int it = 0; it < 2; ++it) { const int pi = tid + 512 * it, row = pi >> 4, seg = pi & 15; *(LAS u32x4*)(lds + SQ + row * 272 + seg * 16) = rq[it]; } }
                __syncthreads();
                float c0[8], c1[8];
#pragma unroll
                for (int e = 0; e < 8; ++e) { const f32x2 t2 = *(LAS f32x2*)(lds + SX + ((wid * 8 + e) * 132 + dk0) * 4); c0[e] = t2.x; c1[e] = t2.y; }
                if (dir == 0) {
#pragma unroll
                    for (int e = 1; e < 8; ++e) { c0[e] += c0[e - 1]; c1[e] += c1[e - 1]; }
                } else {
#pragma unroll
                    for (int e = 6; e >= 0; --e) { c0[e] += c0[e + 1]; c1[e] += c1[e + 1]; }
                }
                { f32x2 t2; t2.x = dir == 0 ? c0[7] : c0[0]; t2.y = dir == 0 ? c1[7] : c1[0]; *(LAS f32x2*)(lds + SCOL + (wid * 128 + dk0) * 4) = t2; }
                __syncthreads();
                float tot0 = 0.f, tot1 = 0.f, offs0 = 0.f, offs1 = 0.f;
#pragma unroll
                for (int s = 0; s < 8; ++s) { const f32x2 t2 = *(LAS f32x2*)(lds + SCOL + (s * 128 + dk0) * 4); tot0 += t2.x; tot1 += t2.y;
                    const bool inc = dir == 0 ? (s < wid) : (s > wid); offs0 += inc ? t2.x : 0.f; offs1 += inc ? t2.y : 0.f; }
                const float etot0 = __expf(tot0), etot1 = __expf(tot1), eg0 = __expf(gtot0), eg1 = __expf(gtot1);
#pragma unroll
                for (int e = 0; e < 8; ++e) { const int i = wid * 8 + e;
                    const float ec0 = __expf(c0[e] + offs0), ec1 = __expf(c1[e] + offs1), inv0 = __builtin_amdgcn_rcpf(ec0), inv1 = __builtin_amdgcn_rcpf(ec1);
                    const unsigned kw = *(LAS unsigned*)(lds + SK + i * 272 + dk0 * 2);
                    const float k0 = bflo(kw), k1 = bfhi(kw);
                    if (PASS2) { const unsigned qw = *(LAS unsigned*)(lds + SQ + i * 272 + dk0 * 2);
                        const float qe0 = bflo(qw) * 0.08838834764831845f * ec0, qe1 = bfhi(qw) * 0.08838834764831845f * ec1;
                        *(LAS unsigned*)(lds + SQ + i * 272 + dk0 * 2) = cvt_pk_bf16(qe0, qe1);
                        const unsigned qt = cvt_pk_bf16(qe0 * eg0, qe1 * eg1);
                        if (dir == 0) *(unsigned*)(QT + (size_t)(t0 + i) * 512 + h * 128 + dk0) = qt; else *(unsigned*)(P + (size_t)(t0 + i) * PW + h * 128 + dk0) = qt;
                        *(LAS unsigned*)(lds + SK + i * 272 + dk0 * 2) = cvt_pk_bf16(k0 * inv0, k1 * inv1); }
                }
                if (wid == 0) { f32x2 t2; t2.x = etot0; t2.y = etot1; *(LAS f32x2*)(lds + SDEC + dk0 * 4) = t2; }
                gtot0 += tot0; gtot1 += tot1;
#pragma unroll
                for (int it = 0; it < 4; ++it) { const int pi = tid + 512 * it, row = pi >> 5, seg = pi & 31;
                    *(LAS u32x4*)(lds + SV + row * 528 + seg * 16) = rv[it]; }
                __syncthreads();
                if (PASS2) {
                    f32x4 accP[2];
#pragma unroll
                    for (int s = 0; s < 2; ++s) { const int tt = wid * 2 + s, ib = tt >> 2, jb = tt & 3; f32x4 a = (f32x4){0.f, 0.f, 0.f, 0.f};
#pragma unroll
                        for (int kb = 0; kb < 4; ++kb) { const bf16x8 A = *(LAS bf16x8*)(lds + SK + (jb * 16 + fr) * 272 + (kb * 32 + fq * 8) * 2);
                            const bf16x8 B = *(LAS bf16x8*)(lds + SQ + (ib * 16 + fr) * 272 + (kb * 32 + fq * 8) * 2); a = MFMA16(A, B, a); }
                        accP[s] = a; }
#pragma unroll
                    for (int s = 0; s < 2; ++s) { const int tt = wid * 2 + s, ib = tt >> 2, jb = tt & 3; const int i = ib * 16 + fr, jbase = jb * 16 + 4 * fq; float v[4];
#pragma unroll
                        for (int jj = 0; jj < 4; ++jj) { const int j = jbase + jj; const bool keep = dir == 0 ? (j <= i) : (j > i); v[jj] = keep ? accP[s][jj] : 0.f; }
                        *(LAS u32x2*)(lds + SP + i * 144 + jbase * 2) = (u32x2){cvt_pk_bf16(v[0], v[1]), cvt_pk_bf16(v[2], v[3])}; }
#pragma unroll
                    for (int m8 = 0; m8 < 8; ++m8)
#pragma unroll
                        for (int n = 0; n < 2; ++n) { const f32x4 sv = accS[m8][n];
                            *(LAS u32x2*)(lds + SST + (wid * 32 + n * 16 + fr) * 272 + (m8 * 16 + 4 * fq) * 2) = (u32x2){cvt_pk_bf16(sv[0], sv[1]), cvt_pk_bf16(sv[2], sv[3])}; }
                    __syncthreads();
                }
                bf16x8 vf[2][2];
#pragma unroll
                for (int n = 0; n < 2; ++n)
#pragma unroll
                    for (int kb2 = 0; kb2 < 2; ++kb2) {
                        const int a0 = SV + (kb2 * 32 + fq * 8 + (fr >> 2)) * 528 + (wid * 32 + n * 16 + 4 * (fr & 3)) * 2;
                        const s16x4 lo = __builtin_amdgcn_ds_read_tr16_b64_v4i16((LAS s16x4*)(lds + a0));
                        const s16x4 hi = __builtin_amdgcn_ds_read_tr16_b64_v4i16((LAS s16x4*)(lds + a0 + 4 * 528));
                        vf[n][kb2] = __builtin_shufflevector(lo, hi, 0, 1, 2, 3, 4, 5, 6, 7); }
                if (PASS2) {
#pragma unroll
                    for (int n = 0; n < 2; ++n) {
                        f32x4 accO[4];
#pragma unroll
                        for (int m = 0; m < 4; ++m) accO[m] = (f32x4){0.f, 0.f, 0.f, 0.f};
#pragma unroll
                        for (int kb = 0; kb < 4; ++kb) { const bf16x8 A = *(LAS bf16x8*)(lds + SST + (wid * 32 + n * 16 + fr) * 272 + (kb * 32 + fq * 8) * 2);
#pragma unroll
                            for (int m = 0; m < 4; ++m) { const bf16x8 B = *(LAS bf16x8*)(lds + SQ + (m * 16 + fr) * 272 + (kb * 32 + fq * 8) * 2); accO[m] = MFMA16(A, B, accO[m]); } }
#pragma unroll
                        for (int kb2 = 0; kb2 < 2; ++kb2)
#pragma unroll
                            for (int m = 0; m < 4; ++m) { const bf16x8 B = *(LAS bf16x8*)(lds + SP + (m * 16 + fr) * 144 + (kb2 * 32 + fq * 8) * 2); accO[m] = MFMA16(vf[n][kb2], B, accO[m]); }
#pragma unroll
                        for (int m = 0; m < 4; ++m) { bf16_t* dst = O + (size_t)(t0 + m * 16 + fr) * 1024 + h * 256 + wid * 32 + n * 16 + 4 * fq; f32x4 v = accO[m];
                            if (dir) { const u32x2 old = *(const u32x2*)dst; v[0] += bflo(old.x); v[1] += bfhi(old.x); v[2] += bflo(old.y); v[3] += bfhi(old.y); }
                            *(u32x2*)dst = (u32x2){cvt_pk_bf16(v[0], v[1]), cvt_pk_bf16(v[2], v[3])}; }
                        asm volatile("" ::: "memory");
                    }
                }
                if (cc < 7) GLA_ISSUE(cc + 1);
#pragma unroll
                for (int m8 = 0; m8 < 8; ++m8) { const f32x4 d = *(LAS f32x4*)(lds + SDEC + (m8 * 16 + 4 * fq) * 4);
#pragma unroll
                    for (int kb2 = 0; kb2 < 2; ++kb2) {
                        const int a0 = SK + (kb2 * 32 + fq * 8 + (fr >> 2)) * 272 + (m8 * 16 + 4 * (fr & 3)) * 2;
                        const s16x4 lo = __builtin_amdgcn_ds_read_tr16_b64_v4i16((LAS s16x4*)(lds + a0));
                        const s16x4 hi = __builtin_amdgcn_ds_read_tr16_b64_v4i16((LAS s16x4*)(lds + a0 + 4 * 272));
                        const bf16x8 A = __builtin_shufflevector(lo, hi, 0, 1, 2, 3, 4, 5, 6, 7);
#pragma unroll
                        for (int n = 0; n < 2; ++n) accS[m8][n] = MFMA16(A, vf[n][kb2], accS[m8][n]); }
#pragma unroll
                    for (int n = 0; n < 2; ++n) accS[m8][n] = accS[m8][n] * d; }
                __syncthreads();
            }
            {
                char* wsl = p.ws; asm volatile("" : "+s"(wsl));
                bf16_t* Eit = (bf16_t*)(wsl + OFF_E) + (size_t)(scan * 32 + grp) * 32768 + (size_t)(wid * 32 + fr) * 128 + 4 * fq;
                float* DL = (float*)(wsl + OFF_DLOG);
#pragma unroll
                for (int m8 = 0; m8 < 8; ++m8)
#pragma unroll
                    for (int n = 0; n < 2; ++n)
                        *(u32x2*)(Eit + n * 16 * 128 + m8 * 16) = (u32x2){cvt_pk_bf16(accS[m8][n][0], accS[m8][n][1]), cvt_pk_bf16(accS[m8][n][2], accS[m8][n][3])};
                if (wid == 0) { DL[(scan * 32 + grp) * 128 + dk0] = gtot0; DL[(scan * 32 + grp) * 128 + dk0 + 1] = gtot1; }
            }
        }
    }
}

#undef GLA_ISSUE
__device__ __forceinline__ void phase_combine(const Params& p) {
    bf16_t* E = (bf16_t*)(p.ws + OFF_E); const float* DL = (const float*)(p.ws + OFF_DLOG);
    int tid = threadIdx.x; asm volatile("" : "+v"(tid));
    for (int idx = bid_() * 512 + tid; idx < 16 * 4096; idx += nblk_() * 512) {
        const int scan = idx >> 12, e8 = idx & 4095, dk0 = (e8 & 15) * 8, dir = scan & 1;
        float R[8];
#pragma unroll
        for (int i = 0; i < 8; ++i) R[i] = 0.f;
#pragma unroll 1
        for (int q4 = 0; q4 < 4; ++q4) {
            u32x4 ev[8]; f32x4 d0[8], d1[8];
#pragma unroll
            for (int gg = 0; gg < 8; ++gg) { const int go = q4 * 8 + gg, g = dir ? 31 - go : go;
                ev[gg] = *(const u32x4*)(E + (size_t)(scan * 32 + g) * 32768 + e8 * 8);
                d0[gg] = *(const f32x4*)(DL + (scan * 32 + g) * 128 + dk0); d1[gg] = *(const f32x4*)(DL + (scan * 32 + g) * 128 + dk0 + 4); }
#pragma unroll
            for (int gg = 0; gg < 8; ++gg) { const int go = q4 * 8 + gg, g = dir ? 31 - go : go;
                *(u32x4*)(E + (size_t)(scan * 32 + g) * 32768 + e8 * 8) = (u32x4){cvt_pk_bf16(R[0], R[1]), cvt_pk_bf16(R[2], R[3]), cvt_pk_bf16(R[4], R[5]), cvt_pk_bf16(R[6], R[7])};
                const u32x4 w = ev[gg];
                R[0] = R[0] * __expf(d0[gg][0]) + bflo(w.x); R[1] = R[1] * __expf(d0[gg][1]) + bfhi(w.x); R[2] = R[2] * __expf(d0[gg][2]) + bflo(w.y); R[3] = R[3] * __expf(d0[gg][3]) + bfhi(w.y);
                R[4] = R[4] * __expf(d1[gg][0]) + bflo(w.z); R[5] = R[5] * __expf(d1[gg][1]) + bfhi(w.z); R[6] = R[6] * __expf(d1[gg][2]) + bflo(w.w); R[7] = R[7] * __expf(d1[gg][3]) + bfhi(w.w); }
        }
    }
}

__device__ __forceinline__ void gla_light(LAS unsigned char* lds, const Params& p, int layer) {
    constexpr int SSTF = 0, SSTB = 69632, SSS = 139264;
    int tid = threadIdx.x; asm volatile("" : "+v"(tid));
    const int wid = __builtin_amdgcn_readfirstlane(tid >> 6), lane = tid & 63, fr = lane & 15, fq = lane >> 4, mt = wid & 3, hv = wid >> 2;
    bf16_t* P = (bf16_t*)(p.ws + OFF_PROJ);
    const bf16_t* E = (const bf16_t*)(p.ws + OFF_E);
    const bf16_t* QT = (const bf16_t*)(p.ws + OFF_E + (size_t)32 * 1024 * 1024);
    const bf16_t* O = (const bf16_t*)(p.ws + OFF_O);
    for (int item = bid_(); item < 256; item += nblk_()) {
        const int b = item >> 7, h = (item >> 5) & 3, grp = item & 31;
        const int scanf = (b * 4 + h) * 2;
        __syncthreads();
#pragma unroll
        for (int it = 0; it < 8; ++it) { const int pi = tid + 512 * it, row = pi >> 4, seg = pi & 15;
            const u32x4 vf_ = *(const u32x4*)(E + (size_t)(scanf * 32 + grp) * 32768 + row * 128 + seg * 8);
            const u32x4 vb_ = *(const u32x4*)(E + (size_t)((scanf + 1) * 32 + grp) * 32768 + row * 128 + seg * 8);
            *(LAS u32x4*)(lds + SSTF + row * 272 + seg * 16) = vf_; *(LAS u32x4*)(lds + SSTB + row * 272 + seg * 16) = vb_; }
        __syncthreads();
        f32x4 gn[8];
#pragma unroll
        for (int n = 0; n < 8; ++n) gn[n] = *(const f32x4*)(p.gla_norm + layer * 1024 + h * 256 + hv * 128 + n * 16 + 4 * fq);
#pragma unroll 1
        for (int cc = 0; cc < 8; ++cc) {
            const size_t tok = (size_t)(b * SEQL + grp * 512 + cc * 64 + mt * 16 + fr);
            bf16x8 bq[2][4];
#pragma unroll
            for (int kb = 0; kb < 4; ++kb) { bq[0][kb] = *(const bf16x8*)(QT + tok * 512 + h * 128 + kb * 32 + fq * 8); bq[1][kb] = *(const bf16x8*)(P + tok * PW + h * 128 + kb * 32 + fq * 8); }
            u32x2 oo[8], rr[8];
#pragma unroll
            for (int n = 0; n < 8; ++n) { oo[n] = *(const u32x2*)(O + tok * 1024 + h * 256 + hv * 128 + n * 16 + 4 * fq);
                rr[n] = *(const u32x2*)(P + tok * PW + 2048 + h * 256 + hv * 128 + n * 16 + 4 * fq); }
            f32x4 accO[8];
#pragma unroll
            for (int n = 0; n < 8; ++n) accO[n] = (f32x4){0.f, 0.f, 0.f, 0.f};
#pragma unroll
            for (int dir = 0; dir < 2; ++dir)
#pragma unroll
                for (int kb = 0; kb < 4; ++kb)
#pragma unroll
                    for (int n = 0; n < 8; ++n) { const bf16x8 A = *(LAS bf16x8*)(lds + (dir ? SSTB : SSTF) + (hv * 128 + n * 16 + fr) * 272 + (kb * 32 + fq * 8) * 2);
                        accO[n] = MFMA16(A, bq[dir][kb], accO[n]); }
            float s = 0.f;
#pragma unroll
            for (int n = 0; n < 8; ++n) { f32x4 v = accO[n]; v[0] += bflo(oo[n].x); v[1] += bfhi(oo[n].x); v[2] += bflo(oo[n].y); v[3] += bfhi(oo[n].y); accO[n] = v;
                s += (v[0] * v[0] + v[1] * v[1]) + (v[2] * v[2] + v[3] * v[3]); }
            s += __shfl_xor(s, 16); s += __shfl_xor(s, 32);
            const int sb = SSS + (cc & 1) * 512;
            if (fq == 0) *(LAS float*)(lds + sb + (hv * 64 + mt * 16 + fr) * 4) = s;
            __syncthreads();
            const float tot = *(LAS float*)(lds + sb + (mt * 16 + fr) * 4) + *(LAS float*)(lds + sb + (64 + mt * 16 + fr) * 4);
            const float rn = rsqrtf(tot * (1.f / 256.f) + 1e-6f);
#pragma unroll
            for (int n = 0; n < 8; ++n) { const float r0 = bflo(rr[n].x), r1 = bfhi(rr[n].x), r2 = bflo(rr[n].y), r3 = bfhi(rr[n].y);
                const f32x4 v = accO[n] * rn * gn[n];
                *(u32x2*)(P + tok * PW + 2048 + h * 256 + hv * 128 + n * 16 + 4 * fq) =
                    (u32x2){cvt_pk_bf16(v[0] * (r0 * sigmoidf_(r0)), v[1] * (r1 * sigmoidf_(r1))), cvt_pk_bf16(v[2] * (r2 * sigmoidf_(r2)), v[3] * (r3 * sigmoidf_(r3)))}; }
        }
    }
}

__device__ __forceinline__ void phase_gating(const Params& p, int layer) {
    int tid = threadIdx.x; asm volatile("" : "+v"(tid));
    const int wid = tid >> 6, lane = tid & 63;
    bf16_t* P = (bf16_t*)(p.ws + OFF_PROJ); const bf16_t* O = (const bf16_t*)(p.ws + OFF_O);
    const float* gn = p.gla_norm + layer * 1024 + lane * 16;
    f32x4 g4[4];
#pragma unroll
    for (int i = 0; i < 4; ++i) g4[i] = *(const f32x4*)(gn + 4 * i);
    for (int t0 = bid_() * 8 + wid; t0 < T_TOK; t0 += nblk_() * 16) {
        u32x4 oo[2][2], rr[2][2]; bool ok[2];
#pragma unroll
        for (int u = 0; u < 2; ++u) { const int t = t0 + u * nblk_() * 8; ok[u] = t < T_TOK;
            if (ok[u]) { oo[u][0] = *(const u32x4*)(O + (size_t)t * 1024 + lane * 16); oo[u][1] = *(const u32x4*)(O + (size_t)t * 1024 + lane * 16 + 8);
                const bf16_t* rp = P + (size_t)t * PW + 2048 + lane * 16; rr[u][0] = *(const u32x4*)rp; rr[u][1] = *(const u32x4*)(rp + 8); } }
#pragma unroll
        for (int u = 0; u < 2; ++u) if (ok[u]) { const int t = t0 + u * nblk_() * 8;
            bf16_t* rp = P + (size_t)t * PW + 2048 + lane * 16;
            const u32x4 o0 = oo[u][0], o1 = oo[u][1], r0 = rr[u][0], r1 = rr[u][1];
            float ov[16], rv[16];
            ov[0] = bflo(o0.x); ov[1] = bfhi(o0.x); ov[2] = bflo(o0.y); ov[3] = bfhi(o0.y); ov[4] = bflo(o0.z); ov[5] = bfhi(o0.z); ov[6] = bflo(o0.w); ov[7] = bfhi(o0.w);
            ov[8] = bflo(o1.x); ov[9] = bfhi(o1.x); ov[10] = bflo(o1.y); ov[11] = bfhi(o1.y); ov[12] = bflo(o1.z); ov[13] = bfhi(o1.z); ov[14] = bflo(o1.w); ov[15] = bfhi(o1.w);
            rv[0] = bflo(r0.x); rv[1] = bfhi(r0.x); rv[2] = bflo(r0.y); rv[3] = bfhi(r0.y); rv[4] = bflo(r0.z); rv[5] = bfhi(r0.z); rv[6] = bflo(r0.w); rv[7] = bfhi(r0.w);
            rv[8] = bflo(r1.x); rv[9] = bfhi(r1.x); rv[10] = bflo(r1.y); rv[11] = bfhi(r1.y); rv[12] = bflo(r1.z); rv[13] = bfhi(r1.z); rv[14] = bflo(r1.w); rv[15] = bfhi(r1.w);
            float s = 0.f;
#pragma unroll
            for (int i = 0; i < 16; ++i) s += ov[i] * ov[i];
            s += __shfl_xor(s, 8); s += __shfl_xor(s, 4); s += __shfl_xor(s, 2); s += __shfl_xor(s, 1);
            const float rn = rsqrtf(s * (1.f / 256.f) + 1e-6f);
            float out[16];
#pragma unroll
            for (int i = 0; i < 16; ++i) { const float r = rv[i]; out[i] = ov[i] * rn * g4[i >> 2][i & 3] * (r * sigmoidf_(r)); }
            *(u32x4*)rp = (u32x4){cvt_pk_bf16(out[0], out[1]), cvt_pk_bf16(out[2], out[3]), cvt_pk_bf16(out[4], out[5]), cvt_pk_bf16(out[6], out[7])};
            *(u32x4*)(rp + 8) = (u32x4){cvt_pk_bf16(out[8], out[9]), cvt_pk_bf16(out[10], out[11]), cvt_pk_bf16(out[12], out[13]), cvt_pk_bf16(out[14], out[15])}; }
    }
}

template <int HW, int RL>
__device__ __forceinline__ void pool_run(const bf16_t* P, bf16_t* PO, int t0, int c8) {
    constexpr int NR = RL + 2 * HW - 1;
    const int pos0 = t0 & (SEQL - 1);
    const bf16_t* base = P + (size_t)t0 * PW + 3072 + c8 * 8;
    u32x4 v[NR];
#pragma unroll
    for (int k = 0; k < NR; ++k) { const int off = k - HW, tt = pos0 + off;
        v[k] = (tt >= 0 && tt < SEQL) ? *(const u32x4*)(base + (long)off * PW) : (u32x4){0u, 0u, 0u, 0u}; }
    float w[8];
#pragma unroll
    for (int i = 0; i < 8; ++i) w[i] = 0.f;
#pragma unroll
    for (int k = 0; k < 2 * HW; ++k) { w[0] += bflo(v[k].x); w[1] += bfhi(v[k].x); w[2] += bflo(v[k].y); w[3] += bfhi(v[k].y); w[4] += bflo(v[k].z); w[5] += bfhi(v[k].z); w[6] += bflo(v[k].w); w[7] += bfhi(v[k].w); }
#pragma unroll
    for (int i = 0; i < RL; ++i) {
        if (i > 0) { const u32x4 a = v[i + 2 * HW - 1], s = v[i - 1];
            w[0] += bflo(a.x) - bflo(s.x); w[1] += bfhi(a.x) - bfhi(s.x); w[2] += bflo(a.y) - bflo(s.y); w[3] += bfhi(a.y) - bfhi(s.y);
            w[4] += bflo(a.z) - bflo(s.z); w[5] += bfhi(a.z) - bfhi(s.z); w[6] += bflo(a.w) - bflo(s.w); w[7] += bfhi(a.w) - bfhi(s.w); }
        const int pos = pos0 + i, lo = pos - HW < 0 ? 0 : pos - HW, hi = pos + HW > SEQL ? SEQL : pos + HW;
        const float ic = 1.f / (float)(hi - lo);
        const u32x4 c = v[HW + i];
        *(u32x4*)(PO + (size_t)(t0 + i) * 512 + c8 * 8) = (u32x4){cvt_pk_bf16(w[0] * ic - bflo(c.x), w[1] * ic - bfhi(c.x)), cvt_pk_bf16(w[2] * ic - bflo(c.y), w[3] * ic - bfhi(c.y)),
                                                                 cvt_pk_bf16(w[4] * ic - bflo(c.z), w[5] * ic - bfhi(c.z)), cvt_pk_bf16(w[6] * ic - bflo(c.w), w[7] * ic - bfhi(c.w))};
    }
}
__device__ __forceinline__ void phase_pool(const Params& p) {
    const bf16_t* P = (const bf16_t*)(p.ws + OFF_PROJ); bf16_t* PO = (bf16_t*)(p.ws + OFF_E);
    int tid = threadIdx.x; asm volatile("" : "+v"(tid));
    const int wid = __builtin_amdgcn_readfirstlane(tid >> 6), lane = tid & 63;
    for (int wi = blockIdx.x * 8 + wid; wi < T_TOK / 16; wi += gridDim.x * 8) {
        const int grp = wi & 3, t0 = (wi >> 2) * 64 + (lane >> 4) * 16, c8 = grp * 16 + (lane & 15);
        if (grp == 0) pool_run<1, 16>(P, PO, t0, c8); else if (grp == 1) pool_run<2, 16>(P, PO, t0, c8); else if (grp == 2) pool_run<4, 16>(P, PO, t0, c8); else { pool_run<8, 8>(P, PO, t0, c8); pool_run<8, 8>(P, PO, t0 + 8, c8); }
    }
}

__device__ __forceinline__ void phase_final(const Params& p) {
    int tid = threadIdx.x; asm volatile("" : "+v"(tid));
    const int wid = tid >> 6, lane = tid & 63;
    const float* ssq = (const float*)(p.ws + OFF_SSQ); const bf16_t* xb = (const bf16_t*)(p.ws + OFF_XB);
    f32x4 g4[4];
#pragma unroll
    for (int i = 0; i < 4; ++i) g4[i] = *(const f32x4*)(p.norm_final + lane * 16 + 4 * i);
    for (int row0 = bid_() * 8 + wid; row0 < T_TOK; row0 += nblk_() * 32) {
        u32x4 v[4][2]; float rs[4]; bool ok[4];
#pragma unroll
        for (int u = 0; u < 4; ++u) { const int row = row0 + u * nblk_() * 8; ok[u] = row < T_TOK;
            if (ok[u]) { rs[u] = rowscale(ssq, row); const bf16_t* xp = xb + (size_t)row * 1024 + lane * 16; v[u][0] = *(const u32x4*)xp; v[u][1] = *(const u32x4*)(xp + 8); } }
#pragma unroll
        for (int u = 0; u < 4; ++u) if (ok[u]) { const int row = row0 + u * nblk_() * 8; float* op = p.xf + (size_t)row * 1024 + lane * 16; const float r = rs[u];
            *(f32x4*)(op) = (f32x4){bflo(v[u][0].x), bfhi(v[u][0].x), bflo(v[u][0].y), bfhi(v[u][0].y)} * r * g4[0];
            *(f32x4*)(op + 4) = (f32x4){bflo(v[u][0].z), bfhi(v[u][0].z), bflo(v[u][0].w), bfhi(v[u][0].w)} * r * g4[1];
            *(f32x4*)(op + 8) = (f32x4){bflo(v[u][1].x), bfhi(v[u][1].x), bflo(v[u][1].y), bfhi(v[u][1].y)} * r * g4[2];
            *(f32x4*)(op + 12) = (f32x4){bflo(v[u][1].z), bfhi(v[u][1].z), bflo(v[u][1].w), bfhi(v[u][1].w)} * r * g4[3]; }
    }
}

__device__ __forceinline__ void phase_rs(const Params& p) {
    int tid = threadIdx.x; asm volatile("" : "+v"(tid));
    const float* ssq = (const float*)(p.ws + OFF_SSQ); float* rs = (float*)(p.ws + OFF_RS);
    for (int row = bid_() * 512 + tid; row < T_TOK; row += nblk_() * 512) rs[row] = rowscale(ssq, row);
}
__device__ __forceinline__ void grid_barrier(unsigned* bar, unsigned k) {
    asm volatile("s_waitcnt vmcnt(0)" ::: "memory");
    __syncthreads();
    if (threadIdx.x == 0) {
        const unsigned nb = nblk_(), g = bid_() >> 4, ng = (nb + 15u) >> 4, gsz = (nb - 16u * g) < 16u ? (nb - 16u * g) : 16u;
        __builtin_amdgcn_fence(__ATOMIC_RELEASE, "agent");
        asm volatile("s_waitcnt vmcnt(0)" ::: "memory");
        const unsigned old = __hip_atomic_fetch_add(bar + 64 * g, 1u, __ATOMIC_RELAXED, __HIP_MEMORY_SCOPE_AGENT);
        if (old == k * gsz - 1u) {
            const unsigned old2 = __hip_atomic_fetch_add(bar + 64 * 32, 1u, __ATOMIC_RELAXED, __HIP_MEMORY_SCOPE_AGENT);
            if (old2 == k * ng - 1u) for (unsigned j = 0; j < ng; ++j) __hip_atomic_store(bar + 64 * (64 + j), k, __ATOMIC_RELAXED, __HIP_MEMORY_SCOPE_AGENT);
        }
        while (__hip_atomic_load(bar + 64 * (64 + g), __ATOMIC_RELAXED, __HIP_MEMORY_SCOPE_AGENT) < k) __builtin_amdgcn_s_sleep(2);
        __builtin_amdgcn_fence(__ATOMIC_ACQUIRE, "agent");
        asm volatile("s_waitcnt vmcnt(0)" ::: "memory");
    }
    __syncthreads();
}
__global__ void __launch_bounds__(512, 2) mega(const Params p_arg) {
    extern __shared__ __attribute__((aligned(16))) unsigned char shm[];
    LAS unsigned char* lds = (LAS unsigned char*)shm;
    typedef const Params __attribute__((address_space(4))) * KArgPtr;
    const int phase_lo = p_arg.phase_lo, phase_hi = p_arg.phase_hi;
    pg8::StaticOrder S;
    unsigned bar_k = 0;
    for (int ph = phase_lo; ph < phase_hi; ++ph) {
        KArgPtr kp = (KArgPtr)__builtin_amdgcn_kernarg_segment_ptr(); asm volatile("" : "+s"(kp));
        const Params& p = *(const Params*)kp;
        bf16_t* xb = (bf16_t*)(p.ws + OFF_XB); bf16_t* proj = (bf16_t*)(p.ws + OFF_PROJ); float* ssq = (float*)(p.ws + OFF_SSQ);
        if (ph > phase_lo) {
            if (phase_hi > 1000) cg::this_grid().sync();
            grid_barrier((unsigned*)(p.ws + OFF_BAR), ++bar_k);
        }
        if (ph == 0) { phase_prep(lds, p); continue; }
        if (ph == 19) { phase_final(p); continue; }
        const int layer = (ph - 1) / 9, sub = (ph - 1) % 9;
        const char* W = p.ws + OFF_W + (size_t)layer * SZ_WLAYER;
        switch (sub) {
        case 0: { if (layer > 0) { phase_rs(p); grid_barrier((unsigned*)(p.ws + OFF_BAR), ++bar_k); }
                  pg8::Gemm g{xb, (const bf16_t*)(W + WO_A), T_TOK, NA, 1024, 1024}; S.init(g.M, g.N, nblk_(), bid_());
                  EpiA e{(const float*)(p.ws + OFF_RS), proj, (bf16_t*)(p.ws + OFF_LR), ssq}; pg8::gemm_phase(lds, g, S, e); } break;
        case 1: gla_pass<true>(lds, p, layer); break;
        case 2: phase_combine(p); break;
        case 3: gla_light(lds, p, layer); break;
        case 4: { pg8::Gemm g{xb, (const bf16_t*)(W + WO_B), T_TOK, NB, 1024, 1024}; S.init(g.M, g.N, nblk_(), bid_());
                  EpiGate e{(const float*)(p.ws + OFF_RS), proj, ssq}; pg8::gemm_phase(lds, g, S, e);
                  phase_pool(p); } break;
        case 5: { { pg8::Gemm g{(const bf16_t*)(p.ws + OFF_E), (const bf16_t*)(W + WO_POOL), T_TOK, 1024, 128, 512}; S.init(g.M, g.N, nblk_(), bid_());
                    EpiPool e{proj, p.pool_scale + layer * 1024}; pg8::gemm_phase<EpiPool, 256>(lds, g, S, e); }
                  { pg8::Gemm g{proj + 2048, (const bf16_t*)(W + WO_GA), T_TOK, 1024, 1024, PW}; S.init(g.M, g.N, nblk_(), bid_());
                    EpiMerge e{proj}; pg8::gemm_phase(lds, g, S, e); } } break;
        case 6: { pg8::Gemm g{proj, (const bf16_t*)(W + WO_OUT), T_TOK, 1024, 1024, PW}; S.init(g.M, g.N, nblk_(), bid_());
                  EpiRes e{xb, ssq}; pg8::gemm_phase(lds, g, S, e); } break;
        case 7: { phase_rs(p); grid_barrier((unsigned*)(p.ws + OFF_BAR), ++bar_k);
                  pg8::Gemm g{xb, (const bf16_t*)(W + WO_F1), T_TOK, 2 * DFF, 1024, 1024}; S.init(g.M, g.N, nblk_(), bid_());
                  EpiFfn1 e{(const float*)(p.ws + OFF_RS), proj, ssq}; pg8::gemm_phase(lds, g, S, e); } break;
        case 8: { pg8::Gemm g{proj, (const bf16_t*)(W + WO_F2), T_TOK, 1024, DFF, DFF}; S.init(g.M, g.N, nblk_(), bid_());
                  if (layer == 1) { EpiResFinal e{p.ws, lds + pg8::STAGE_BYTES + 2048}; pg8::gemm_phase(lds, g, S, e); }
                  else { EpiRes e{xb, ssq}; pg8::gemm_phase(lds, g, S, e); } } break;
        }
    }
}

extern "C" void kernel_launch(void* const* d_in, const int* in_sizes, int n_in, void* d_out, int out_size, void* d_ws, size_t ws_size, hipStream_t stream) {
    (void)in_sizes; (void)n_in; (void)out_size;
    if (ws_size < WS_NEEDED) return;
    Params p{};
    p.x_in = (const float*)d_in[0]; p.norm_mix = (const float*)d_in[1]; p.w_in = (const float*)d_in[2]; p.wdu_f = (const float*)d_in[3]; p.bd_f = (const float*)d_in[4];
    p.wdu_b = (const float*)d_in[5]; p.bd_b = (const float*)d_in[6]; p.gla_norm = (const float*)d_in[7]; p.w_ga = (const float*)d_in[8]; p.w_pool = (const float*)d_in[9];
    p.pool_scale = (const float*)d_in[10]; p.w_out = (const float*)d_in[11]; p.norm_ffn = (const float*)d_in[12]; p.w_f1 = (const float*)d_in[13]; p.w_f2 = (const float*)d_in[14];
    p.norm_final = (const float*)d_in[15];
    p.xf = (float*)d_out; p.ws = (char*)d_ws;
    hipFuncSetAttribute((const void*)mega, hipFuncAttributeMaxDynamicSharedMemorySize, LDS_BYTES);
    int dev = 0, cus = 0, per = 0;
    hipGetDevice(&dev); hipDeviceGetAttribute(&cus, hipDeviceAttributeMultiprocessorCount, dev);
    hipOccupancyMaxActiveBlocksPerMultiprocessor(&per, mega, 512, LDS_BYTES);
    int grid = cus * (per > 0 ? per : 1); if (grid > 256) grid = 256; if (grid < 1) grid = 1;
#if MK_SINGLE_LAUNCH
    p.phase_lo = 0; p.phase_hi = 19;
    hipMemsetAsync((char*)d_ws + OFF_BAR, 0, 128 * 256, stream);
    void* args[] = {(void*)&p};
    hipLaunchCooperativeKernel((const void*)mega, dim3(grid), dim3(512), args, LDS_BYTES, stream);
#else
    for (int ph = 0; ph < 20; ++ph) { p.phase_lo = ph; p.phase_hi = ph + 1; hipLaunchKernelGGL(mega, dim3(grid), dim3(512), LDS_BYTES, stream, p); }
#endif
}
```
